# Optimizing an MI355X kernel written in HIP

```python
import math
import jax, jax.numpy as jnp
from jax import lax
import numpy as np

D_MODEL = 2048
BATCH = 2
SEQ = 4096
DEPTH = 1

HEAD_DIM = 128
N_HEADS_SB = (D_MODEL // HEAD_DIM) // 2
N_HEADS_DSA = (D_MODEL // HEAD_DIM) - N_HEADS_SB
SB_WIDTH = N_HEADS_SB * HEAD_DIM
DSA_WIDTH = N_HEADS_DSA * HEAD_DIM
IDX_HEADS = 16
IDX_DIM = 64
TOPK_MAX = 256
ROPE_THETA = 500000.0
ROPE_FRACTION = 4
D_FF = 5504
CONV_WIDTH = 3
Q_BLOCK = 128
EPS = 1e-6
NEG_BIG = -1e30

COL_SIZES = (
    SB_WIDTH, SB_WIDTH, SB_WIDTH,
    DSA_WIDTH, HEAD_DIM, HEAD_DIM,
    IDX_HEADS * IDX_DIM, IDX_DIM,
    IDX_HEADS,
)
IN_COLS = sum(COL_SIZES)
SPLIT_POINTS = tuple(int(v) for v in np.cumsum(COL_SIZES)[:-1])

kernel_name = "hybrid_sb_dsa_convffn_adaln"


def rmsnorm(x, g):
    x32 = x.astype(jnp.float32)
    y = x32 * lax.rsqrt(jnp.mean(x32 * x32, axis=-1, keepdims=True) + EPS)
    return (y * g.astype(jnp.float32)).astype(x.dtype)


def rope_partial(x, pos):
    d = x.shape[-1]
    rd = d // ROPE_FRACTION
    half = rd // 2
    inv_freq = ROPE_THETA ** (-jnp.arange(half, dtype=jnp.float32) / half)
    ang = pos.astype(jnp.float32)[..., None] * inv_freq
    cos = jnp.cos(ang)[:, :, None, :]
    sin = jnp.sin(ang)[:, :, None, :]
    x32 = x.astype(jnp.float32)
    x1, x2, rest = x32[..., :half], x32[..., half:rd], x32[..., rd:]
    out = jnp.concatenate([x1 * cos - x2 * sin, x2 * cos + x1 * sin, rest], axis=-1)
    return out.astype(x.dtype)


def stick_breaking_attention(q, k, v):
    S = q.shape[1]
    scale = q.shape[-1] ** -0.5
    outs = []
    for start in range(0, S, Q_BLOCK):
        end = start + Q_BLOCK
        qb, kb, vb = q[:, start:end], k[:, :end], v[:, :end]
        z = jnp.einsum('bqhd,bkhd->bhqk', qb, kb).astype(jnp.float32) * scale
        t_idx = start + jnp.arange(Q_BLOCK)[:, None]
        s_idx = jnp.arange(end)[None, :]
        strict = s_idx < t_idx
        log_1m = jnp.where(strict, jax.nn.log_sigmoid(-z), 0.0)
        key_axis = log_1m.ndim - 1
        suffix = lax.cumsum(log_1m, axis=key_axis, reverse=True) - log_1m
        w = jnp.where(strict, jnp.exp(jax.nn.log_sigmoid(z) + suffix), 0.0)
        outs.append(jnp.einsum('bhqk,bkhd->bqhd', w.astype(vb.dtype), vb))
    return jnp.concatenate(outs, axis=1)


def dsa_attention(q, k, v, q_idx, k_idx, w_idx):
    S = q.shape[1]
    topk = min(TOPK_MAX, S // 4)
    scale = q.shape[-1] ** -0.5
    gather = jax.vmap(lambda arr, idx: arr[idx])
    outs = []
    for start in range(0, S, Q_BLOCK):
        end = start + Q_BLOCK
        L = max(end, topk)
        rel = jax.nn.relu(jnp.einsum('bqhd,bkd->bqhk', q_idx[:, start:end],
                                     k_idx[:, :L]).astype(jnp.float32))
        score = jnp.einsum('bqh,bqhk->bqk', w_idx[:, start:end].astype(jnp.float32), rel)
        t_idx = start + jnp.arange(Q_BLOCK)[:, None]
        causal = jnp.arange(L)[None, :] <= t_idx
        score = jnp.where(causal, score, NEG_BIG)
        _, sel = lax.top_k(score, topk)
        valid = sel <= t_idx[None]
        k_sel = gather(k, sel)
        v_sel = gather(v, sel)
        logits = jnp.einsum('bqhd,bqkd->bhqk', q[:, start:end], k_sel).astype(jnp.float32) * scale
        logits = jnp.where(valid[:, None], logits, NEG_BIG)
        p = jax.nn.softmax(logits, axis=-1)
        outs.append(jnp.einsum('bhqk,bqkd->bqhd', p.astype(v_sel.dtype), v_sel))
    return jnp.concatenate(outs, axis=1)


def conv_ffn(h, w_up, conv_w, conv_b, w_down):
    S = h.shape[1]
    u = h @ w_up
    up = jnp.pad(u, ((0, 0), (CONV_WIDTH - 1, 0), (0, 0)))
    uc = conv_b
    for i in range(CONV_WIDTH):
        uc = uc + up[:, i:i + S] * conv_w[i]
    gate, val = jnp.split(uc, 2, axis=-1)
    return (jax.nn.silu(gate) * val) @ w_down


def setup_inputs(seed: int = 0) -> dict:
    key = jax.random.key(seed)
    ks = jax.random.split(key, 20)
    D = D_MODEL
    f32 = jnp.float32
    nrm = lambda k, shape, s: jax.random.normal(k, shape, f32) * s
    x = nrm(ks[0], (BATCH, SEQ, D), 1.0)
    c = nrm(ks[1], (BATCH, D), 1.0)
    offset = jax.random.randint(ks[2], (BATCH, 1), 0, 1024, dtype=jnp.int32)
    positions = (offset + jnp.arange(SEQ, dtype=jnp.int32)[None, :]).astype(jnp.int32)
    return {
        "x": x,
        "c": c,
        "positions": positions,
        "w_ada": nrm(ks[3], (DEPTH, D, 6 * D), 0.5 * D ** -0.5),
        "b_ada": nrm(ks[4], (DEPTH, 6 * D), 0.01),
        "norm1_g": 1.0 + nrm(ks[5], (DEPTH, D), 0.01),
        "w_in": nrm(ks[6], (DEPTH, D, IN_COLS), D ** -0.5),
        "sb_norm_g": 1.0 + nrm(ks[7], (DEPTH, SB_WIDTH), 0.01),
        "dsa_norm_g": 1.0 + nrm(ks[8], (DEPTH, DSA_WIDTH), 0.01),
        "w_out": nrm(ks[9], (DEPTH, SB_WIDTH + DSA_WIDTH, D), (SB_WIDTH + DSA_WIDTH) ** -0.5),
        "norm2_g": 1.0 + nrm(ks[10], (DEPTH, D), 0.01),
        "w_up": nrm(ks[11], (DEPTH, D, 2 * D_FF), D ** -0.5),
        "conv_w": nrm(ks[12], (DEPTH, CONV_WIDTH, 2 * D_FF), CONV_WIDTH ** -0.5),
        "conv_b": nrm(ks[13], (DEPTH, 2 * D_FF), 0.01),
        "w_down": nrm(ks[14], (DEPTH, D_FF, D), D_FF ** -0.5),
        "final_norm_g": 1.0 + nrm(ks[15], (D,), 0.01),
    }


def reference(x, c, positions, w_ada, b_ada, norm1_g, w_in, sb_norm_g, dsa_norm_g,
              w_out, norm2_g, w_up, conv_w, conv_b, w_down, final_norm_g):
    B, S, D = x.shape
    idx_scale = (IDX_HEADS ** -0.5) * (IDX_DIM ** -0.5)
    for l in range(DEPTH):
        mod = jax.nn.silu(c) @ w_ada[l] + b_ada[l]
        sh1, sc1, g1, sh2, sc2, g2 = jnp.split(mod[:, None, :], 6, axis=-1)

        h = rmsnorm(x, norm1_g[l]) * (1.0 + sc1) + sh1
        proj = h @ w_in[l]
        q_sb, k_sb, v_sb, q_ds, k_ds, v_ds, q_ix, k_ix, w_ix = jnp.split(proj, SPLIT_POINTS, axis=-1)

        q_sb = q_sb.reshape(B, S, N_HEADS_SB, HEAD_DIM)
        k_sb = k_sb.reshape(B, S, N_HEADS_SB, HEAD_DIM)
        v_sb = v_sb.reshape(B, S, N_HEADS_SB, HEAD_DIM)
        o_sb = stick_breaking_attention(q_sb, k_sb, v_sb).reshape(B, S, SB_WIDTH)

        q_ds = rope_partial(q_ds.reshape(B, S, N_HEADS_DSA, HEAD_DIM), positions)
        k_ds = rope_partial(k_ds[:, :, None, :], positions)[:, :, 0, :]
        q_ix = rope_partial(q_ix.reshape(B, S, IDX_HEADS, IDX_DIM), positions)
        k_ix = rope_partial(k_ix[:, :, None, :], positions)[:, :, 0, :]
        o_ds = dsa_attention(q_ds, k_ds, v_ds, q_ix, k_ix, w_ix * idx_scale).reshape(B, S, DSA_WIDTH)

        merged = jnp.concatenate([rmsnorm(o_sb, sb_norm_g[l]), rmsnorm(o_ds, dsa_norm_g[l])], axis=-1)
        x = x + g1 * (merged @ w_out[l])

        h2 = rmsnorm(x, norm2_g[l]) * (1.0 + sc2) + sh2
        x = x + g2 * conv_ffn(h2, w_up[l], conv_w[l], conv_b[l], w_down[l])
    return rmsnorm(x, final_norm_g)
```

```cpp
#include <hip/hip_runtime.h>
#include <cstdio>

typedef _Float16 f16;

constexpr int BATCH = 2, SEQ = 4096, DM = 2048, MTOK = BATCH * SEQ;
constexpr int HD = 128, NH = 8, IXH = 16, IXD = 64, TOPK = 256;
constexpr int DFF = 5504, NUP = 2 * DFF;
constexpr int NIN = 5456, NINP = 5632;
constexpr int C_QSB = 0, C_KSB = 1024, C_VSB = 2048, C_QDS = 3072, C_KDS = 4096, C_VDS = 4224, C_QIX = 4352, C_KIX = 5376, C_WIX = 5440;
constexpr int MODW = 6 * DM;
constexpr float EPS = 1e-6f;
constexpr float QSCALE = 0.08838834764831845f;
constexpr float IDX_SCALE = 0.03125f;

__constant__ float INV128[16] = {1.0f, 0.44036659598350525f, 0.1939227432012558f, 0.08539710193872452f, 0.03760603070259094f, 0.01656043902039528f, 0.007292664609849453f, 0.0032114458736032248f,
                                 0.0014142135623842478f, 0.000622772378847003f, 0.00027424818836152554f, 0.00012076973507646471f, 5.318296098266728e-05f, 2.34199997066753e-05f, 1.0313386155758053e-05f, 4.541670477919979e-06f};
__constant__ float INV64[8] = {1.0f, 0.1939227432012558f, 0.03760603070259094f, 0.007292664609849453f, 0.0014142135623842478f, 0.00027424818836152554f, 5.318296098266728e-05f, 1.0313386155758053e-05f};

constexpr size_t MiB = 1u << 20;
constexpr size_t WS_CTL = 0;
constexpr size_t WS_MOD = 1 * MiB;
constexpr size_t WS_MODP = 380 * MiB;
constexpr size_t WS_ROPE = 4 * MiB;
constexpr size_t WS_XCH = 3 * MiB + 512 * 1024;
constexpr size_t WS_SA = 6 * MiB + 768 * 1024;
constexpr size_t WS_SBW = WS_SA + 64 * 1024;
constexpr size_t WS_MAXSH = WS_SA + 128 * 1024;
constexpr size_t WS_XCH2 = 383 * MiB;
constexpr size_t WS_SSQ = 6 * MiB + 512 * 1024;
constexpr size_t WS_WIX = 6 * MiB;
constexpr size_t WS_KIX = 7 * MiB;
constexpr size_t WS_WTIN = 8 * MiB;
constexpr size_t WS_WTOUT = 30 * MiB;
constexpr size_t WS_WTUP = 38 * MiB;
constexpr size_t WS_WTDN = 81 * MiB;
constexpr size_t WS_H = 103 * MiB;
constexpr size_t WS_X1 = 135 * MiB;
constexpr size_t WS_PROJ = 199 * MiB;
constexpr size_t WS_ACT = WS_PROJ;
constexpr size_t WS_MERGED = 287 * MiB;
constexpr size_t WS_FREE = 319 * MiB;
constexpr size_t WS_OSB32 = 319 * MiB;
constexpr size_t WS_ODS32 = 351 * MiB;
constexpr size_t WS_U16 = 287 * MiB;
constexpr size_t WS_UH = 319 * MiB;
constexpr size_t WS_KSBC = 342 * MiB;
constexpr size_t WS_VSBC = 358 * MiB;
constexpr size_t WS_KDSC = 374 * MiB;
constexpr size_t WS_VDSC = 376 * MiB;
constexpr size_t WS_END = 384 * MiB;

__device__ __forceinline__ float wave_sum(float v) {
#pragma unroll
    for (int o = 1; o < 64; o <<= 1) v += __shfl_xor(v, o);
    return v;
}
__device__ __forceinline__ float block_sum256(float v, float* red) {
    v = wave_sum(v);
    __syncthreads();
    if ((threadIdx.x & 63) == 0) red[threadIdx.x >> 6] = v;
    __syncthreads();
    return red[0] + red[1] + red[2] + red[3];
}
__device__ __forceinline__ float silu_f(float v) { return v / (1.f + expf(-v)); }
__device__ __forceinline__ float softplus_f(float z) { return fmaxf(z, 0.f) + log1pf(expf(-fabsf(z))); }

#define LAS __attribute__((address_space(3)))
typedef _Float16 half8 __attribute__((ext_vector_type(8)));
typedef _Float16 half4 __attribute__((ext_vector_type(4)));
typedef _Float16 half2v __attribute__((ext_vector_type(2)));
typedef float f32x4 __attribute__((ext_vector_type(4)));
typedef float f32x16 __attribute__((ext_vector_type(16)));
typedef unsigned u32x4 __attribute__((ext_vector_type(4)));
typedef unsigned u32x2 __attribute__((ext_vector_type(2)));
typedef int i32x4 __attribute__((ext_vector_type(4)));
__device__ __forceinline__ unsigned q8x4(float a, float b, float c, float d) {
    a = __builtin_amdgcn_fmed3f(__builtin_rintf(a), -127.f, 127.f); b = __builtin_amdgcn_fmed3f(__builtin_rintf(b), -127.f, 127.f);
    c = __builtin_amdgcn_fmed3f(__builtin_rintf(c), -127.f, 127.f); d = __builtin_amdgcn_fmed3f(__builtin_rintf(d), -127.f, 127.f);
    const unsigned p01 = __builtin_bit_cast(unsigned, __builtin_amdgcn_cvt_pk_i16((int)a, (int)b)), p23 = __builtin_bit_cast(unsigned, __builtin_amdgcn_cvt_pk_i16((int)c, (int)d));
    return __builtin_amdgcn_perm(p23, p01, 0x06040200u);
}
__device__ __forceinline__ unsigned pk_h2(float lo, float hi) { half2v h = {(f16)lo, (f16)hi}; return __builtin_bit_cast(unsigned, h); }

constexpr int NWAVES = 8;
constexpr int LDS_BYTES = 159744;
constexpr int RING_BYTES = 131072;
constexpr int XTRA_OFF = RING_BYTES;
constexpr int MISC_OFF = LDS_BYTES - 256;
constexpr int CW_TMO = 0, CW_BAR = 4096, CW_XCNT = 32768, CW_ADA = 40960, CW_SBMAX = 49152;

namespace pg8 {
constexpr int BM = 256, BK = 64, HALF = 128, HTB = HALF * BK * 2, STAGE_BYTES = 8 * HTB, NXCD = 8, WGM = 8;
__host__ __device__ __forceinline__ int lds_byte(int r, int c) { const int st = (r >> 4) * 2 + (c >> 5), rr = r & 15, cc = c & 31, ob = rr * 64 + cc * 2; return st * 1024 + (ob ^ (((ob >> 9) & 1) << 5)); }
__host__ __device__ __forceinline__ void stage_rc(int b, int& R, int& C) { const int st = b / 1024, sb = b % 1024, swz = sb ^ (((sb >> 9) & 1) << 5); R = (st >> 1) * 16 + swz / 64; C = (st & 1) * 32 + (swz % 64) / 2; }
__host__ __device__ __forceinline__ int perm32(int rho) { const int n = rho >> 4, i = rho & 15; return 8 * (i >> 2) + 4 * n + (i & 3); }
struct Unit { int pm, pn; };
struct Gemm { const f16* A; const f16* Bt; int M, N, K; };
struct StaticOrder {
    int nM, nN, nwg, G, c;
    __host__ __device__ __forceinline__ void init(int M, int N, int G_, int c_) { nM = M / BM; nN = N / BM; nwg = nM * nN; G = G_; c = c_; }
    __host__ __device__ __forceinline__ bool next(int i, Unit& u) const {
        const long L = (long)i * G + c; if (L >= nwg) return false;
        int wgid = (int)L; { const int q = nwg / NXCD, r = nwg % NXCD, xcd = wgid % NXCD, off = wgid / NXCD; wgid = (xcd < r ? xcd * (q + 1) : r * (q + 1) + (xcd - r) * q) + off; }
        const int nig = WGM * nN, gid = wgid / nig, fm = gid * WGM, gsz = (nM - fm) < WGM ? (nM - fm) : WGM;
        u.pm = fm + ((wgid % nig) % gsz); u.pn = (wgid % nig) / gsz; return true;
    }
    __device__ __forceinline__ void a_ready(const Unit&) const {}
    __device__ __forceinline__ void done(const Unit&) const {}
};
__device__ __forceinline__ void mma16(f32x4& c, const half8& b, const half8& a) { c = __builtin_amdgcn_mfma_f32_16x16x32_f16(b, a, c, 0, 0, 0); }
__device__ __forceinline__ void mma16(i32x4& c, const half8& b, const half8& a) { c = __builtin_amdgcn_mfma_i32_16x16x64_i8(__builtin_bit_cast(i32x4, b), __builtin_bit_cast(i32x4, a), c, 0, 0, 0); }
template <class Epi, class Sched, bool ALIGN_EPI, bool SP2>
__device__ __forceinline__ void gemm_phase(LAS unsigned char* lds, const Gemm g, const Sched& S, const Epi& E) {
    int tid = threadIdx.x; asm volatile("" : "+v"(tid));
    const int wid = __builtin_amdgcn_readfirstlane(tid >> 6), lane = tid & 63, wr = wid >> 2, wc = wid & 3, fr = lane & 15, fq = lane >> 4;
    const int K = g.K, nt = K / BK;
    unsigned voffA[2], voffB[2];
#pragma unroll
    for (int i = 0; i < 2; ++i) { int R, C; stage_rc(tid * 16 + i * 8192, R, C); const int Rb = Epi::PERM ? ((R & ~31) + perm32(R & 31)) : R;
        voffA[i] = (unsigned)(R * K + C) * 2u; voffB[i] = (unsigned)(Rb * K + C) * 2u; }
    const size_t kstep = (size_t)(BK * 2);
    const size_t hstep = (size_t)HALF * K * 2;
    const size_t tstep = 2 * hstep;
    const unsigned ldsw = (unsigned)wid * 1024u;
    const int aoff = lds_byte(wr * 64 + fr, fq * 8), boff = lds_byte(wc * 32 + fr, fq * 8);
#define PG8_SA(b, h) (((b) * 2 + (h)) * HTB)
#define PG8_SB(b, h) ((4 + (b) * 2 + (h)) * HTB)
#define PG8_STAGE(bufoff, gbase, voff) do { _Pragma("unroll") for (int _i = 0; _i < 2; ++_i) \
        __builtin_amdgcn_global_load_lds((const unsigned*)((const char*)(gbase) + (voff)[_i]), (LAS unsigned*)(lds + (bufoff) + ldsw + _i * 8192), 16, 0, 0); } while (0)
#define PG8_LDA(dst, b, h) do { _Pragma("unroll") for (int m = 0; m < 4; ++m) _Pragma("unroll") for (int k = 0; k < 2; ++k) dst[m][k] = *(const LAS half8*)(lds + PG8_SA(b, h) + aoff + m * 2048 + k * 1024); } while (0)
#define PG8_LDB(dst, b, h) do { _Pragma("unroll") for (int n = 0; n < 2; ++n) _Pragma("unroll") for (int k = 0; k < 2; ++k) dst[n][k] = *(const LAS half8*)(lds + PG8_SB(b, h) + boff + n * 2048 + k * 1024); } while (0)
#define PG8_MMA(ai, bj, At, Bt) do { __builtin_amdgcn_s_setprio(1); _Pragma("unroll") for (int m = 0; m < 4; ++m) _Pragma("unroll") for (int n = 0; n < 2; ++n) _Pragma("unroll") for (int k = 0; k < 2; ++k) \
        mma16(acc[ai][bj][m][n], Bt[n][k], At[m][k]); __builtin_amdgcn_s_setprio(0); } while (0)
#define PG8_WAIT_V(n) asm volatile("s_waitcnt vmcnt(" #n ")" ::: "memory")
#define PG8_WAIT_L(n) asm volatile("s_waitcnt lgkmcnt(" #n ")" ::: "memory")
#define PG8_BAR __builtin_amdgcn_s_barrier()
#define PG8_SCHED __builtin_amdgcn_sched_barrier(0)
    Unit cur, nxt; int ui = 0;
    if (!S.next(0, cur)) return;
    typedef typename Epi::acc_t acc_t;
    acc_t acc[2][2][4][2];
#pragma unroll
    for (int a = 0; a < 2; ++a)
#pragma unroll
        for (int b = 0; b < 2; ++b)
#pragma unroll
            for (int m = 0; m < 4; ++m)
#pragma unroll
                for (int n = 0; n < 2; ++n) acc[a][b][m][n] = (acc_t){0, 0, 0, 0};
    half8 At[4][2], B0[2][2], B1[2][2];
    const char* cA = (const char*)g.A + (size_t)cur.pm * tstep; const char* cB = (const char*)g.Bt + (size_t)cur.pn * tstep;
    S.a_ready(cur);
    if constexpr (SP2) {
        PG8_STAGE(PG8_SB(0, 0), cB, voffB); PG8_STAGE(PG8_SB(0, 1), cB + hstep, voffB); PG8_STAGE(PG8_SA(0, 0), cA, voffA); PG8_STAGE(PG8_SA(0, 1), cA + hstep, voffA);
        if (wr == 1) PG8_BAR;
        PG8_WAIT_V(2); PG8_BAR;
        PG8_STAGE(PG8_SB(1, 0), cB + kstep, voffB); PG8_STAGE(PG8_SA(1, 0), cA + kstep, voffA); PG8_STAGE(PG8_SB(1, 1), cB + hstep + kstep, voffB);
        PG8_WAIT_V(6); PG8_BAR;
    } else {
        PG8_STAGE(PG8_SB(0, 0), cB, voffB); PG8_STAGE(PG8_SA(0, 0), cA, voffA); PG8_STAGE(PG8_SB(0, 1), cB + hstep, voffB); PG8_STAGE(PG8_SA(0, 1), cA + hstep, voffA);
        if (wr == 1) PG8_BAR;
        PG8_WAIT_V(4); PG8_BAR;
        PG8_STAGE(PG8_SB(1, 0), cB + kstep, voffB); PG8_STAGE(PG8_SA(1, 0), cA + kstep, voffA); PG8_STAGE(PG8_SB(1, 1), cB + hstep + kstep, voffB);
        PG8_WAIT_V(6); PG8_BAR;
    }
    for (;;) {
        const bool has_next = S.next(ui + 1, nxt);
        const char* nA = has_next ? (const char*)g.A + (size_t)nxt.pm * tstep : cA; const char* nB = has_next ? (const char*)g.Bt + (size_t)nxt.pn * tstep : cB;
        for (int t = 0; t < nt; t += 2) {
            const bool last = (t == nt - 2);
            const char* a1 = cA + (size_t)(t + 1) * kstep;
            const char* a2 = last ? nA : cA + (size_t)(t + 2) * kstep; const char* b2 = last ? nB : cB + (size_t)(t + 2) * kstep;
            const char* a3 = a2 + kstep; const char* b3 = b2 + kstep;
            if (last && has_next) S.a_ready(nxt);
            if constexpr (Epi::MIDK) { if (t == nt / 2) E.midk(acc, cur, wr, fr); }
            if constexpr (SP2) {
            PG8_LDB(B0, 0, 0); PG8_LDB(B1, 0, 1); PG8_SCHED; PG8_LDA(At, 0, 0); PG8_STAGE(PG8_SA(1, 1), a1 + hstep, voffA);
            PG8_WAIT_V(8); PG8_WAIT_L(0); PG8_BAR; PG8_MMA(0, 0, At, B0); PG8_MMA(0, 1, At, B1); PG8_BAR; PG8_SCHED;
            PG8_LDA(At, 0, 1); PG8_STAGE(PG8_SB(0, 0), b2, voffB); PG8_STAGE(PG8_SB(0, 1), b2 + hstep, voffB); PG8_STAGE(PG8_SA(0, 0), a2, voffA);
            PG8_WAIT_V(8); PG8_WAIT_L(0); PG8_BAR; PG8_MMA(1, 0, At, B0); PG8_MMA(1, 1, At, B1); PG8_BAR; PG8_SCHED;
            PG8_LDB(B0, 1, 0); PG8_LDB(B1, 1, 1); PG8_SCHED; PG8_LDA(At, 1, 0); PG8_STAGE(PG8_SA(0, 1), a2 + hstep, voffA);
            PG8_WAIT_V(8); PG8_WAIT_L(0); PG8_BAR; PG8_MMA(0, 0, At, B0); PG8_MMA(0, 1, At, B1); PG8_BAR; PG8_SCHED;
            PG8_LDA(At, 1, 1); PG8_STAGE(PG8_SB(1, 0), b3, voffB); PG8_STAGE(PG8_SB(1, 1), b3 + hstep, voffB); PG8_STAGE(PG8_SA(1, 0), a3, voffA);
            PG8_WAIT_V(8); PG8_WAIT_L(0); PG8_BAR; PG8_MMA(1, 0, At, B0); PG8_MMA(1, 1, At, B1); PG8_BAR; PG8_SCHED;
            } else {
            PG8_LDB(B0, 0, 0); PG8_SCHED; PG8_LDA(At, 0, 0); PG8_STAGE(PG8_SA(1, 1), a1 + hstep, voffA);
            PG8_WAIT_L(8); PG8_BAR; PG8_WAIT_L(0); PG8_MMA(0, 0, At, B0); PG8_BAR; PG8_SCHED;
            PG8_LDB(B1, 0, 1); PG8_STAGE(PG8_SB(0, 0), b2, voffB);
            PG8_BAR; PG8_WAIT_L(0); PG8_MMA(0, 1, At, B1); PG8_BAR;
            PG8_LDA(At, 0, 1); PG8_STAGE(PG8_SA(0, 0), a2, voffA);
            PG8_BAR; PG8_WAIT_L(0); PG8_MMA(1, 0, At, B0); PG8_BAR; PG8_SCHED;
            PG8_STAGE(PG8_SB(0, 1), b2 + hstep, voffB);
            PG8_WAIT_V(6); PG8_BAR; PG8_MMA(1, 1, At, B1); PG8_BAR;
            PG8_LDB(B0, 1, 0); PG8_SCHED; PG8_LDA(At, 1, 0); PG8_STAGE(PG8_SA(0, 1), a2 + hstep, voffA);
            PG8_WAIT_L(8); PG8_BAR; PG8_WAIT_L(0); PG8_MMA(0, 0, At, B0); PG8_BAR; PG8_SCHED;
            PG8_LDB(B1, 1, 1); PG8_STAGE(PG8_SB(1, 0), b3, voffB);
            PG8_BAR; PG8_WAIT_L(0); PG8_MMA(0, 1, At, B1); PG8_BAR;
            PG8_LDA(At, 1, 1); PG8_STAGE(PG8_SA(1, 0), a3, voffA);
            PG8_BAR; PG8_WAIT_L(0); PG8_MMA(1, 0, At, B0); PG8_BAR; PG8_SCHED;
            PG8_STAGE(PG8_SB(1, 1), b3 + hstep, voffB);
            PG8_WAIT_V(6); PG8_BAR; PG8_MMA(1, 1, At, B1); PG8_BAR;
            }
        }
        if constexpr (ALIGN_EPI) { if (wr == 0) PG8_BAR; }
        if constexpr (!Epi::AFTER_DRAIN) { E(acc, cur, wr, wc, fr, fq); S.done(cur); }
        if (!has_next) break;
#pragma unroll
        for (int a = 0; a < 2; ++a)
#pragma unroll
            for (int b = 0; b < 2; ++b)
#pragma unroll
                for (int m = 0; m < 4; ++m)
#pragma unroll
                    for (int n = 0; n < 2; ++n) acc[a][b][m][n] = (acc_t){0, 0, 0, 0};
        cur = nxt; cA = nA; cB = nB; ++ui;
        if constexpr (ALIGN_EPI) { if (wr == 1) PG8_BAR; }
    }
    PG8_WAIT_V(0);
    if constexpr (!ALIGN_EPI) { if (wr == 0) PG8_BAR; }
    PG8_BAR;
    if constexpr (Epi::AFTER_DRAIN) { E.fused(acc, cur, wr, wc, fr, fq, lds); S.done(cur); }
#undef PG8_SA
#undef PG8_SB
#undef PG8_STAGE
#undef PG8_LDA
#undef PG8_LDB
#undef PG8_MMA
#undef PG8_WAIT_V
#undef PG8_WAIT_L
#undef PG8_BAR
#undef PG8_SCHED
}

struct EpiProjF {
    static constexpr bool PERM = true, AFTER_DRAIN = false, MIDK = false; typedef f32x4 acc_t;
    f16* P; f16* kix; float* wix; const float* rope; f16* ksbc; f16* vsbc; f16* kdsc; f16* vdsc;
    __device__ __forceinline__ void operator()(const f32x4 (&acc)[2][2][4][2], const Unit& u, int wr, int wc, int fr, int fq) const {
        const int row0 = u.pm * BM + wr * 64 + fr;
#pragma unroll
        for (int bj = 0; bj < 2; ++bj) {
            const int cbase = u.pn * BM + bj * HALF;
            if (cbase >= 5504) continue;
            const bool r128 = (cbase >= C_QDS && cbase < C_VDS) && (wc == 0);
            const bool r64 = (cbase >= C_QIX) && ((wc & 1) == 0) && (cbase != C_KIX || wc == 0);
            const float sc = (cbase < 1024 || (cbase >= C_QDS && cbase < C_KDS)) ? QSCALE : 1.f;
#pragma unroll
            for (int ai = 0; ai < 2; ++ai)
#pragma unroll
                for (int m = 0; m < 4; ++m) {
                    const int row = row0 + ai * HALF + m * 16;
                    float v[8];
#pragma unroll
                    for (int n = 0; n < 2; ++n)
#pragma unroll
                        for (int j = 0; j < 4; ++j) v[n * 4 + j] = acc[ai][bj][m][n][j];
                    if (r128) {
                        const float* rp = rope + (size_t)row * 48 + 2 * (8 * (fq & 1));
#pragma unroll
                        for (int e = 0; e < 8; ++e) { const float o = __shfl_xor(v[e], 32); const float cs = rp[2 * e], sn = rp[2 * e + 1];
                            v[e] = fq < 2 ? v[e] * cs - o * sn : v[e] * cs + o * sn; }
                    }
                    if (r64) {
                        const float* rp = rope + (size_t)row * 48 + 32;
#pragma unroll
                        for (int e = 0; e < 8; ++e) { const float o = __shfl_xor(v[e], 16); const float cs = rp[2 * e], sn = rp[2 * e + 1];
                            const float r = fq == 0 ? v[e] * cs - o * sn : v[e] * cs + o * sn; v[e] = fq < 2 ? r : v[e]; }
                    }
                    u32x4 w; w.x = pk_h2(v[0] * sc, v[1] * sc); w.y = pk_h2(v[2] * sc, v[3] * sc); w.z = pk_h2(v[4] * sc, v[5] * sc); w.w = pk_h2(v[6] * sc, v[7] * sc);
                    {
                        f16* dst = P + (size_t)row * NINP + cbase;
                        const int bb = row / SEQ, ss = row % SEQ;
                        if (cbase >= C_KSB && cbase < C_VSB) dst = ksbc + ((size_t)(bb * NH + (cbase - C_KSB) / HD) * SEQ + ss) * HD;
                        else if (cbase >= C_VSB && cbase < C_QDS) dst = vsbc + ((size_t)(bb * NH + (cbase - C_VSB) / HD) * SEQ + ss) * HD;
                        else if (cbase == C_KDS) dst = kdsc + (size_t)row * HD;
                        else if (cbase == C_VDS) dst = vdsc + (size_t)row * HD;
                        *(u32x4*)(dst + wc * 32 + 8 * fq) = w; }
                    if (cbase == C_KIX) {
                        if (wc < 2) *(u32x4*)(kix + (size_t)row * 64 + wc * 32 + 8 * fq) = w;
                        if (wc == 2 && fq < 2) { float* wp = wix + (size_t)row * 16 + 8 * fq;
                            *(f32x4*)wp = (f32x4){v[0] * IDX_SCALE, v[1] * IDX_SCALE, v[2] * IDX_SCALE, v[3] * IDX_SCALE};
                            *(f32x4*)(wp + 4) = (f32x4){v[4] * IDX_SCALE, v[5] * IDX_SCALE, v[6] * IDX_SCALE, v[7] * IDX_SCALE}; }
                    }
                }
        }
    }
};
struct EpiResidF {
    static constexpr bool PERM = false, AFTER_DRAIN = false, MIDK = false; typedef f32x4 acc_t;
    const float* base; const float* gate; float* out;
    __device__ __forceinline__ void operator()(const f32x4 (&acc)[2][2][4][2], const Unit& u, int wr, int wc, int fr, int fq) const {
        const int row0 = u.pm * BM + wr * 64 + fr, col0 = u.pn * BM + wc * 32 + 4 * fq;
        const float* gp = gate + (size_t)(u.pm / (SEQ / BM)) * MODW + col0;
        f32x4 gv[2][2];
#pragma unroll
        for (int bj = 0; bj < 2; ++bj)
#pragma unroll
            for (int n = 0; n < 2; ++n) gv[bj][n] = *(const f32x4*)(gp + bj * HALF + n * 16);
#pragma unroll
        for (int ai = 0; ai < 2; ++ai)
#pragma unroll
            for (int m = 0; m < 4; ++m) { const size_t off = (size_t)(row0 + ai * HALF + m * 16) * DM + col0;
#pragma unroll
                for (int bj = 0; bj < 2; ++bj)
#pragma unroll
                    for (int n = 0; n < 2; ++n) { const f32x4 bs = *(const f32x4*)(base + off + bj * HALF + n * 16);
                        *(f32x4*)(out + off + bj * HALF + n * 16) = bs + gv[bj][n] * acc[ai][bj][m][n]; }
                asm volatile("" ::: "memory"); }
    }
};
__device__ __forceinline__ float silu_fast(float v) { return v * __builtin_amdgcn_rcpf(1.f + __expf(-v)); }
struct EpiUpConv {
    static constexpr bool PERM = true, AFTER_DRAIN = false, MIDK = false; typedef i32x4 acc_t;
    const float* cw; const float* cb; f16* act; float* uh; const float* sa; const float* sbw;
    __device__ __forceinline__ void operator()(i32x4 (&acc)[2][2][4][2], const Unit& u, int wr, int wc, int fr_in, int fq_in) const {
        int tix = threadIdx.x; asm volatile("" : "+v"(tix));
        const int fr = tix & 15, fq = (tix >> 4) & 3; (void)fr_in; (void)fq_in;
        const int lane = fr + 16 * fq;
        int ch0 = u.pn * HALF + wc * 32 + 8 * fq;
        {
            f32x4 sbv[2][2];
#pragma unroll
            for (int gv = 0; gv < 2; ++gv)
#pragma unroll
                for (int n = 0; n < 2; ++n) sbv[gv][n] = *(const f32x4*)(sbw + gv * DFF + ch0 + 4 * n) * (2.f / 127.f);
#pragma unroll
            for (int ai = 0; ai < 2; ++ai)
#pragma unroll
                for (int m = 0; m < 4; ++m) { const float rs = sa[u.pm * BM + ai * HALF + wr * 64 + m * 16 + fr];
#pragma unroll
                    for (int gv = 0; gv < 2; ++gv)
#pragma unroll
                        for (int n = 0; n < 2; ++n) { const i32x4 t = acc[ai][gv][m][n];
                            const f32x4 f = (f32x4){(float)t.x, (float)t.y, (float)t.z, (float)t.w} * rs * sbv[gv][n]; acc[ai][gv][m][n] = __builtin_bit_cast(i32x4, f); } }
        }
#define UF(ai, gv, m, n) __builtin_bit_cast(f32x4, acc[ai][gv][m][n])
        const int src1 = (lane & 48) | ((fr - 1) & 15), src2 = (lane & 48) | ((fr - 2) & 15);
#pragma unroll
        for (int n = 0; n < 2; ++n) {
            asm volatile("" : "+v"(ch0));
            f32x4 w0[2], w1[2], w2[2], bb[2];
#pragma unroll
            for (int gv = 0; gv < 2; ++gv) { const int c = gv * DFF + ch0 + 4 * n;
                w0[gv] = *(const f32x4*)(cw + c); w1[gv] = *(const f32x4*)(cw + NUP + c); w2[gv] = *(const f32x4*)(cw + 2 * NUP + c); bb[gv] = *(const f32x4*)(cb + c); }
#pragma unroll
            for (int ai = 0; ai < 2; ++ai) {
                const int chunk = u.pm * 4 + ai * 2 + wr;
#pragma unroll
                for (int m = 0; m < 4; ++m) {
                    const int row = u.pm * BM + ai * HALF + wr * 64 + m * 16 + fr;
                    f32x4 uc[2];
#pragma unroll
                    for (int gv = 0; gv < 2; ++gv) {
                        const f32x4 cur = UF(ai, gv, m, n); const f32x4 prv = UF(ai, gv, m > 0 ? m - 1 : 0, n);
                        f32x4 p1, p2;
#pragma unroll
                        for (int j = 0; j < 4; ++j) { const float t1 = fr == 15 ? prv[j] : cur[j], t2 = fr >= 14 ? prv[j] : cur[j]; p1[j] = __shfl(t1, src1); p2[j] = __shfl(t2, src2); }
                        uc[gv] = bb[gv] + w0[gv] * p2 + w1[gv] * p1 + w2[gv] * cur;
                    }
                    if (m > 0 || fr >= 2) { u32x2 w; w.x = pk_h2(silu_fast(uc[0].x) * uc[1].x, silu_fast(uc[0].y) * uc[1].y); w.y = pk_h2(silu_fast(uc[0].z) * uc[1].z, silu_fast(uc[0].w) * uc[1].w);
                        *(u32x2*)(act + (size_t)row * DFF + ch0 + 4 * n) = w; }
                    if ((m == 0 && fr < 2) || (m == 3 && fr >= 14)) { const int slot = m == 0 ? fr : fr - 12; float* up = uh + (size_t)(chunk * 4 + slot) * NUP + ch0 + 4 * n;
#pragma unroll
                        for (int gv = 0; gv < 2; ++gv) *(f32x4*)(up + gv * DFF) = UF(ai, gv, m, n); }
                }
            }
        }
    }
#undef UF
};
template <int MODE> struct EpiResidNorm {
    static constexpr bool PERM = true, AFTER_DRAIN = true, MIDK = (MODE == 1); typedef f32x4 acc_t;
    const float* base; const float* gate; const float* g; const float* shsc; float* xout; f16* h; float* xch; unsigned* cnt; const float* ssq; float* xch2; float* sa; const float* maxsh;
    __device__ __forceinline__ void midk(f32x4 (&acc)[2][2][4][2], const Unit& u, int wr, int fr) const {
#pragma unroll
        for (int ai = 0; ai < 2; ++ai)
#pragma unroll
            for (int m = 0; m < 4; ++m) { const float* sp = ssq + (size_t)(u.pm * BM + ai * HALF + wr * 64 + m * 16 + fr) * NH;
                const f32x4 s0 = *(const f32x4*)sp, s1 = *(const f32x4*)(sp + 4);
                const float rs = rsqrtf((((s0.x + s0.y) + (s0.z + s0.w)) + ((s1.x + s1.y) + (s1.z + s1.w))) * (1.f / 1024.f) + EPS);
#pragma unroll
                for (int bj = 0; bj < 2; ++bj)
#pragma unroll
                    for (int n = 0; n < 2; ++n) acc[ai][bj][m][n] *= rs; }
    }
    __device__ __forceinline__ void fused(f32x4 (&acc)[2][2][4][2], const Unit& u, int wr, int wc, int fr_in, int fq_in, LAS unsigned char* lds) const {
        int tix = threadIdx.x; asm volatile("" : "+v"(tix));
        const int fr = tix & 15, fq = (tix >> 4) & 3; (void)fr_in; (void)fq_in;
        LAS float* PT = (LAS float*)(lds + XTRA_OFF);
        LAS float* ST = (LAS float*)(lds + XTRA_OFF + 4096);
        const int bt = u.pm / (SEQ / BM);
        const int row0 = u.pm * BM + wr * 64 + fr, col0 = u.pn * BM + wc * 32 + 8 * fq;
        {   const float* gp = gate + (size_t)bt * MODW + col0;
            f32x4 gv[2][2];
#pragma unroll
            for (int bj = 0; bj < 2; ++bj)
#pragma unroll
                for (int n = 0; n < 2; ++n) gv[bj][n] = *(const f32x4*)(gp + bj * HALF + 4 * n);
            int tok = 0;
#pragma unroll
            for (int ai = 0; ai < 2; ++ai)
#pragma unroll
                for (int m = 0; m < 4; ++m) { const size_t off = (size_t)(row0 + ai * HALF + m * 16 + tok) * DM + col0;
#pragma unroll
                    for (int bj = 0; bj < 2; ++bj) {
                        if (MODE == 1) {
#pragma unroll
                            for (int n = 0; n < 2; ++n) acc[ai][bj][m][n] = *(const f32x4*)(base + off + bj * HALF + 4 * n) + gv[bj][n] * acc[ai][bj][m][n];
                        } else {
                            const half8 b8 = *(const half8*)((const f16*)base + off + bj * HALF);
                            acc[ai][bj][m][0] = (f32x4){(float)b8[0], (float)b8[1], (float)b8[2], (float)b8[3]} + gv[bj][0] * acc[ai][bj][m][0];
                            acc[ai][bj][m][1] = (f32x4){(float)b8[4], (float)b8[5], (float)b8[6], (float)b8[7]} + gv[bj][1] * acc[ai][bj][m][1];
                        } }
                    asm volatile("" : "+v"(tok) : "v"(acc[ai][0][m][0].x), "v"(acc[ai][0][m][1].x), "v"(acc[ai][1][m][0].x), "v"(acc[ai][1][m][1].x) : "memory"); }
        }
#pragma unroll
        for (int ai = 0; ai < 2; ++ai)
#pragma unroll
            for (int m = 0; m < 4; ++m) { float q = 0.f;
#pragma unroll
                for (int bj = 0; bj < 2; ++bj)
#pragma unroll
                    for (int n = 0; n < 2; ++n) { const f32x4 x = acc[ai][bj][m][n]; q += (x.x * x.x + x.y * x.y) + (x.z * x.z + x.w * x.w); }
                q += __shfl_xor(q, 16); q += __shfl_xor(q, 32);
                if (fq == 0) PT[(ai * HALF + wr * 64 + m * 16 + fr) * 4 + wc] = q; }
        if (MODE == 1) {
            LAS float* PT2 = (LAS float*)(lds + XTRA_OFF + 8192);
            float mxa[2][4];
#pragma unroll
            for (int ai = 0; ai < 2; ++ai)
#pragma unroll
                for (int m = 0; m < 4; ++m) mxa[ai][m] = 0.f;
#pragma unroll
            for (int bj = 0; bj < 2; ++bj) {
                f32x4 av[2];
#pragma unroll
                for (int n = 0; n < 2; ++n) { const int c = col0 + bj * HALF + 4 * n; av[n] = *(const f32x4*)(g + c) * (*(const f32x4*)(shsc + (size_t)bt * MODW + DM + c) + 1.f); }
#pragma unroll
                for (int ai = 0; ai < 2; ++ai)
#pragma unroll
                    for (int m = 0; m < 4; ++m)
#pragma unroll
                        for (int n = 0; n < 2; ++n) { const f32x4 t = __builtin_elementwise_abs(acc[ai][bj][m][n] * av[n]); mxa[ai][m] = fmaxf(mxa[ai][m], fmaxf(fmaxf(t.x, t.y), fmaxf(t.z, t.w))); }
            }
#pragma unroll
            for (int ai = 0; ai < 2; ++ai)
#pragma unroll
                for (int m = 0; m < 4; ++m) { float q = mxa[ai][m]; q = fmaxf(q, __shfl_xor(q, 16)); q = fmaxf(q, __shfl_xor(q, 32));
                    if (fq == 0) PT2[(ai * HALF + wr * 64 + m * 16 + fr) * 4 + wc] = q; }
        }
        __syncthreads();
        const int tid = threadIdx.x;
        float* slot = xch + ((size_t)u.pm * 8 + u.pn) * BM;
        if (tid < BM) { const f32x4 p4 = *(const LAS f32x4*)(PT + tid * 4); __hip_atomic_store(slot + tid, (p4.x + p4.y) + (p4.z + p4.w), __ATOMIC_RELAXED, __HIP_MEMORY_SCOPE_AGENT);
            if (MODE == 1) { const f32x4 m4 = *(const LAS f32x4*)((LAS float*)(lds + XTRA_OFF + 8192) + tid * 4);
                __hip_atomic_store(xch2 + ((size_t)u.pm * 8 + u.pn) * BM + tid, fmaxf(fmaxf(m4.x, m4.y), fmaxf(m4.z, m4.w)), __ATOMIC_RELAXED, __HIP_MEMORY_SCOPE_AGENT); } }
        asm volatile("s_waitcnt vmcnt(0)" ::: "memory");
        __syncthreads();
        if (tid == 0) {
            __hip_atomic_fetch_add(cnt + 64 * u.pm, 1u, __ATOMIC_RELAXED, __HIP_MEMORY_SCOPE_AGENT);
            unsigned sp = 0;
            while (__hip_atomic_load(cnt + 64 * u.pm, __ATOMIC_RELAXED, __HIP_MEMORY_SCOPE_AGENT) < 8u) { __builtin_amdgcn_s_sleep(1); if (++sp > (1u << 22)) break; }
        }
        __syncthreads();
        if (tid < BM) { const float* sp = xch + (size_t)u.pm * 8 * BM + tid; float tot = 0.f;
#pragma unroll
            for (int j = 0; j < 8; ++j) tot += __hip_atomic_load(sp + j * BM, __ATOMIC_RELAXED, __HIP_MEMORY_SCOPE_AGENT);
            const float rstd = rsqrtf(tot * (1.f / DM) + EPS); ST[tid] = rstd;
            if (MODE == 1) { const float* mp = xch2 + (size_t)u.pm * 8 * BM + tid; float mxr = 0.f;
#pragma unroll
                for (int j = 0; j < 8; ++j) mxr = fmaxf(mxr, __hip_atomic_load(mp + j * BM, __ATOMIC_RELAXED, __HIP_MEMORY_SCOPE_AGENT));
                const float bound = fmaxf(rstd * mxr + maxsh[bt], 1e-20f);
                ST[BM + tid] = 127.f / bound; if (u.pn == 0) sa[u.pm * BM + tid] = bound * (1.f / 127.f); } }
        __syncthreads();
#pragma unroll
        for (int bj = 0; bj < 2; ++bj) {
            f32x4 gg[2], sh[2], sc[2];
#pragma unroll
            for (int n = 0; n < 2; ++n) { const int c = col0 + bj * HALF + 4 * n; gg[n] = *(const f32x4*)(g + c);
                if (MODE == 1) { sh[n] = *(const f32x4*)(shsc + (size_t)bt * MODW + c); sc[n] = *(const f32x4*)(shsc + (size_t)bt * MODW + DM + c) + 1.f; } }
#pragma unroll
            for (int ai = 0; ai < 2; ++ai)
#pragma unroll
                for (int m = 0; m < 4; ++m) { const int rl = ai * HALF + wr * 64 + m * 16 + fr; const float rs = ST[rl]; const size_t off = (size_t)(u.pm * BM + rl) * DM + col0 + bj * HALF;
                    if (MODE == 0) {
#pragma unroll
                        for (int n = 0; n < 2; ++n) *(f32x4*)(xout + off + 4 * n) = (acc[ai][bj][m][n] * rs) * gg[n];
                    } else {
                        const f32x4 y0 = ((acc[ai][bj][m][0] * rs) * gg[0]) * sc[0] + sh[0], y1 = ((acc[ai][bj][m][1] * rs) * gg[1]) * sc[1] + sh[1];
                        { const f32x4 x0 = acc[ai][bj][m][0], x1 = acc[ai][bj][m][1]; u32x4 xw; xw.x = pk_h2(x0.x, x0.y); xw.y = pk_h2(x0.z, x0.w); xw.z = pk_h2(x1.x, x1.y); xw.w = pk_h2(x1.z, x1.w);
                          *(u32x4*)((f16*)xout + off) = xw; }
                        {   const float qs = ST[BM + rl];
                            u32x2 w8; w8.x = q8x4(y0.x * qs, y0.y * qs, y0.z * qs, y0.w * qs); w8.y = q8x4(y1.x * qs, y1.y * qs, y1.z * qs, y1.w * qs);
                            *(u32x2*)((signed char*)h + off) = w8; }
                    }
                    asm volatile("" ::: "memory"); }
        }
    }
};
}


namespace att {
typedef short v4i16_t __attribute__((ext_vector_type(4)));
__device__ __forceinline__ int sw16(int row) { return ((row & 3) << 2) | ((row >> 2) & 3); }
__device__ __forceinline__ int crow(int i, int h) { return (i & 3) + 8 * (i >> 2) + 4 * h; }
__device__ __forceinline__ half4 tr_read(LAS unsigned char* p) { return __builtin_bit_cast(half4, __builtin_amdgcn_ds_read_tr16_b64_v4i16((LAS v4i16_t*)p)); }
__device__ __forceinline__ half8 cat8(half4 a, half4 b) { return __builtin_shufflevector(a, b, 0, 1, 2, 3, 4, 5, 6, 7); }
__device__ __forceinline__ half8 cvt8(const f32x16& x, int s) {
    half8 r;
#pragma unroll
    for (int j = 0; j < 8; ++j) r[j] = (f16)x[8 * s + j];
    return r;
}
struct TileRegs { u32x4 v[8]; };
template <class RowOff> __device__ __forceinline__ void tile_fetch(TileRegs& t, const unsigned char* base, RowOff roff, int lane) {
#pragma unroll
    for (int i = 0; i < 8; ++i) { const int row = (lane >> 4) + 4 * i; const unsigned off = (unsigned)roff(row) + 16u * (unsigned)(lane & 15); t.v[i] = *(const u32x4*)(base + off); }
}
__device__ __forceinline__ void tile_put(const TileRegs& t, LAS unsigned char* tile, int lane) {
#pragma unroll
    for (int i = 0; i < 8; ++i) { const int row = (lane >> 4) + 4 * i; *(LAS u32x4*)(tile + 256 * row + 16 * ((lane & 15) ^ sw16(row))) = t.v[i]; }
}
__device__ __forceinline__ void fetch_rows8(TileRegs& t, const unsigned char* base, const unsigned (&offs)[8], int lane) {
#pragma unroll
    for (int i = 0; i < 8; ++i) t.v[i] = *(const u32x4*)(base + (offs[i] + 16u * (unsigned)(lane & 15)));
}
__device__ __forceinline__ void put_rows8(const TileRegs& t, LAS unsigned char* tile, int lane) {
#pragma unroll
    for (int i = 0; i < 8; ++i) { const int row = 8 * (lane >> 4) + i; *(LAS u32x4*)(tile + 256 * row + 16 * ((lane & 15) ^ sw16(row))) = t.v[i]; }
}
__device__ __forceinline__ void sel_offs8(unsigned (&offs)[8], const LAS unsigned short* sel, int j0, int cnt) {
    const u32x4 w = *(const LAS u32x4*)(sel + j0);
    const unsigned e[8] = {w.x & 0xffffu, w.x >> 16, w.y & 0xffffu, w.y >> 16, w.z & 0xffffu, w.z >> 16, w.w & 0xffffu, w.w >> 16};
#pragma unroll
    for (int i = 0; i < 8; ++i) offs[i] = (j0 + i < cnt ? e[i] : 0u) << 8;
}
__device__ __forceinline__ f32x16 qk_tile(LAS unsigned char* ktile, const half8 (&qf)[8], int lane) {
    const int r = lane & 31, h = lane >> 5, swr = sw16(r);
    f32x16 z;
#pragma unroll
    for (int i = 0; i < 16; ++i) z[i] = 0.f;
#pragma unroll
    for (int st = 0; st < 8; ++st) { const half8 kf = *(const LAS half8*)(ktile + 256 * r + 16 * ((2 * st + h) ^ swr)); z = __builtin_amdgcn_mfma_f32_32x32x16_f16(kf, qf[st], z, 0, 0, 0); }
    return z;
}
__device__ __forceinline__ void tr_addrs(int (&va)[4][2], int lane) {
    const int q = (lane & 15) >> 2, p = lane & 3, g = lane >> 4, h = g >> 1, g1 = g & 1;
#pragma unroll
    for (int mt = 0; mt < 4; ++mt)
#pragma unroll
        for (int sec = 0; sec < 2; ++sec) { const int key = 8 * sec + 4 * h + q, sw = (q << 2) | (2 * sec + h), ch = 4 * mt + 2 * g1 + (p >> 1);
            va[mt][sec] = 256 * key + 16 * (ch ^ sw) + 8 * (p & 1); }
}
__device__ __forceinline__ void pv_tile(f32x16 (&o)[4], LAS unsigned char* vtile, const int (&va)[4][2], const half8 (&wf)[2]) {
#pragma unroll
    for (int ks = 0; ks < 2; ++ks)
#pragma unroll
        for (int mt = 0; mt < 4; ++mt) { const half8 vf = cat8(tr_read(vtile + va[mt][0] + 4096 * ks), tr_read(vtile + va[mt][1] + 4096 * ks));
            o[mt] = __builtin_amdgcn_mfma_f32_32x32x16_f16(vf, wf[ks], o[mt], 0, 0, 0); }
}

__device__ __forceinline__ void sb_item(const f16* __restrict__ P, const f16* __restrict__ ksbc, const f16* __restrict__ vsbc, f16* __restrict__ merged, float* __restrict__ ssq, LAS unsigned char* reg, int b, int hd, int qb, int lane) {
    const int c = lane & 31, h = lane >> 5, t0 = 32 * qb;
    LAS unsigned char* ktile = reg; LAS unsigned char* vtile = reg + 8192;
    half8 qf[8];
    { const f16* qp = P + (size_t)(b * SEQ + t0 + c) * NINP + C_QSB + hd * HD + 8 * h;
#pragma unroll
      for (int st = 0; st < 8; ++st) qf[st] = *(const half8*)(qp + 16 * st); }
    half8 uf[2];
#pragma unroll
    for (int ks = 0; ks < 2; ++ks)
#pragma unroll
        for (int j = 0; j < 8; ++j) uf[ks][j] = (16 * ks + 8 * (j >> 2) + 4 * h + (j & 3)) > c ? (f16)1.f : (f16)0.f;
    int va[4][2]; tr_addrs(va, lane);
    f32x16 o[4];
#pragma unroll
    for (int mt = 0; mt < 4; ++mt)
#pragma unroll
        for (int i = 0; i < 16; ++i) o[mt][i] = 0.f;
    float R = 0.f;
    const unsigned char* kbase = (const unsigned char*)(ksbc + (size_t)(b * NH + hd) * SEQ * HD);
    const unsigned char* vbase = (const unsigned char*)(vsbc + (size_t)(b * NH + hd) * SEQ * HD);
    TileRegs tk, tv;
    tile_fetch(tk, kbase, [&](int row) { return (size_t)(32 * qb + row) * (HD * 2); }, lane);
    for (int kt = qb; kt >= 0; --kt) {
        const int s0 = 32 * kt;
        tile_put(tk, ktile, lane);
        tile_fetch(tv, vbase, [&](int row) { return (size_t)(s0 + row) * (HD * 2); }, lane);
        f32x16 z = qk_tile(ktile, qf, lane);
        f32x16 l, a;
        float lsum = 0.f;
        const bool diag = (kt == qb);
#pragma unroll
        for (int i = 0; i < 16; ++i) { const float zi = z[i]; const float sp = fmaxf(zi, 0.f) + __logf(1.f + __expf(-fabsf(zi)));
            const bool ok = !diag || crow(i, h) < c;
            l[i] = ok ? -sp : 0.f; a[i] = zi - sp; lsum += l[i]; z[i] = ok ? 1.f : 0.f; }
        half8 lf[2] = {cvt8(l, 0), cvt8(l, 1)};
        f32x16 cs;
#pragma unroll
        for (int i = 0; i < 16; ++i) cs[i] = 0.f;
        cs = __builtin_amdgcn_mfma_f32_32x32x16_f16(uf[0], lf[0], cs, 0, 0, 0);
        cs = __builtin_amdgcn_mfma_f32_32x32x16_f16(uf[1], lf[1], cs, 0, 0, 0);
        f32x16 w;
#pragma unroll
        for (int i = 0; i < 16; ++i) w[i] = z[i] != 0.f ? __expf((a[i] + cs[i]) + R) : 0.f;
        half8 wf[2] = {cvt8(w, 0), cvt8(w, 1)};
        tile_put(tv, vtile, lane);
        { const int sn = 32 * (kt > 0 ? kt - 1 : 0); tile_fetch(tk, kbase, [&](int row) { return (size_t)(sn + row) * (HD * 2); }, lane); }
        pv_tile(o, vtile, va, wf);
        R += lsum + __shfl_xor(lsum, 32);
        if (__all(R < -104.f)) break;
    }
    float sq = 0.f;
#pragma unroll
    for (int mt = 0; mt < 4; ++mt)
#pragma unroll
        for (int gI = 0; gI < 4; ++gI) { const f32x16& x = o[mt]; const int i0 = 4 * gI;
            sq += (x[i0] * x[i0] + x[i0 + 1] * x[i0 + 1]) + (x[i0 + 2] * x[i0 + 2] + x[i0 + 3] * x[i0 + 3]);
            u32x2 w2; w2.x = pk_h2(x[i0], x[i0 + 1]); w2.y = pk_h2(x[i0 + 2], x[i0 + 3]);
            *(LAS u32x2*)(reg + 272 * c + 2 * (32 * mt + 8 * gI + 4 * h)) = w2; }
    sq += __shfl_xor(sq, 32);
    if (lane < 32) ssq[(size_t)(b * SEQ + t0 + c) * NH + hd] = sq;
#pragma unroll
    for (int it = 0; it < 8; ++it) { const int row = (lane >> 4) + 4 * it;
        const u32x4 v = *(const LAS u32x4*)(reg + 272 * row + 16 * (lane & 15));
        *(u32x4*)(merged + (size_t)(b * SEQ + t0 + row) * DM + hd * HD + 8 * (lane & 15)) = v; }
}

constexpr int X_HIST = 0, X_SEL = 16384, X_CVAL = 20480, X_CIDX = 22528, X_MM = 24576, X_WSM = 25600;
__device__ __forceinline__ int mbcnt64(unsigned long long m) { return __builtin_amdgcn_mbcnt_hi((unsigned)(m >> 32), __builtin_amdgcn_mbcnt_lo((unsigned)m, 0u)); }
__device__ __forceinline__ float wave_min(float v) {
#pragma unroll
    for (int o = 1; o < 64; o <<= 1) v = fminf(v, __shfl_xor(v, o));
    return v; }
__device__ __forceinline__ float wave_max(float v) {
#pragma unroll
    for (int o = 1; o < 64; o <<= 1) v = fmaxf(v, __shfl_xor(v, o));
    return v; }
__device__ __forceinline__ int binof(float v, float lo, float scale) { const int bq = (int)((v - lo) * scale); return bq > 1023 ? 1023 : bq; }
__device__ __forceinline__ bool topk_fast(const LAS float* sc, int n, float lo, float hi, LAS unsigned* hist, LAS unsigned short* sel, LAS float* cval, LAS unsigned short* cidx, LAS unsigned* ctr, int lane) {
    const float range = hi - lo;
    if (!(range > 1e-30f)) return false;
    const float scale = 512.f / range;
#pragma unroll
    for (int k = 0; k < 8; ++k) hist[lane * 8 + k] = 0u;
    if (lane < 2) ctr[lane] = 0u;
    const int nfull = n >> 8;
    for (int j = 0; j < nfull; ++j) { const f32x4 v4 = *(const LAS f32x4*)(sc + 256 * j + 4 * lane);
#pragma unroll
        for (int e = 0; e < 4; ++e) { int bq = (int)((v4[e] - lo) * scale); bq = bq > 511 ? 511 : bq; (void)__hip_atomic_fetch_add(hist + bq, 1u, __ATOMIC_RELAXED, __HIP_MEMORY_SCOPE_WORKGROUP); } }
    if ((nfull << 8) < n) { const int i0 = 256 * nfull + 4 * lane; const f32x4 v4 = *(const LAS f32x4*)(sc + i0);
#pragma unroll
        for (int e = 0; e < 4; ++e) if (i0 + e < n) { int bq = (int)((v4[e] - lo) * scale); bq = bq > 511 ? 511 : bq; (void)__hip_atomic_fetch_add(hist + bq, 1u, __ATOMIC_RELAXED, __HIP_MEMORY_SCOPE_WORKGROUP); } }
    unsigned wd[8]; int lsum = 0;
#pragma unroll
    for (int k = 0; k < 8; ++k) { wd[k] = hist[lane * 8 + k]; lsum += (int)wd[k]; }
    int incl = lsum;
#pragma unroll
    for (int d = 1; d < 64; d <<= 1) { const int t = __shfl_down(incl, d); if (lane + d < 64) incl += t; }
    const int excl = incl - lsum;
    const bool mine = (excl < TOPK) && (incl >= TOPK);
    int fb = 0, fabove = 0, fcnt = 0, run = excl; bool found = false;
#pragma unroll
    for (int k = 7; k >= 0; --k) { const int cb = (int)wd[k]; const bool hit = !found && (run + cb >= TOPK);
        if (hit) { fb = 8 * lane + k; fabove = run; fcnt = cb; found = true; } if (!found) run += cb; }
    const unsigned long long bm = __ballot(mine);
    const int src = bm ? __builtin_ctzll(bm) : 0;
    const int bstar = __shfl(fb, src), above = __shfl(fabove, src), cntb = __shfl(fcnt, src);
    const int need = TOPK - above;
    const bool all = (cntb == need);
    if (!all && cntb > 64) return false;
    const float T0 = (float)bstar, T1 = all ? T0 : (bstar == 511 ? 3.0e38f : (float)(bstar + 1));
    const unsigned selb = (unsigned)(size_t)sel, trash = (unsigned)(size_t)(cidx + 64 + lane);
    const int nblk = (n + 255) >> 8; int nsel = 0;
    for (int j = 0; j < nblk; ++j) { const int i0 = 256 * j + 4 * lane; const f32x4 v4 = *(const LAS f32x4*)(sc + i0);
        float x[4]; unsigned tk[4]; bool cd[4]; bool anyc = false;
#pragma unroll
        for (int e = 0; e < 4; ++e) { x[e] = (v4[e] - lo) * scale; const bool in = i0 + e < n; tk[e] = (in && x[e] >= T1) ? 1u : 0u; cd[e] = in && !(x[e] >= T1) && x[e] >= T0; anyc = anyc || cd[e]; }
#pragma unroll
        for (int e = 0; e < 4; ++e) { const unsigned long long bt = __ballot(tk[e] != 0u);
            const unsigned addr = tk[e] ? selb + 2u * (unsigned)(nsel + mbcnt64(bt)) : trash; *(LAS unsigned short*)(size_t)addr = (unsigned short)(i0 + e); nsel += __builtin_popcountll(bt); }
        if (__any(anyc)) {
#pragma unroll
            for (int e = 0; e < 4; ++e) if (cd[e]) { const unsigned k = __hip_atomic_fetch_add(ctr + 1, 1u, __ATOMIC_RELAXED, __HIP_MEMORY_SCOPE_WORKGROUP); cval[k] = v4[e]; cidx[k] = (unsigned short)(i0 + e); } }
    }
    if (!all) {
        const float my = lane < cntb ? cval[lane] : 0.f; const int myi = lane < cntb ? (int)cidx[lane] : 0; int rank = 0;
        for (int k = 0; k < cntb; ++k) { const float o = cval[k]; const int oi = (int)cidx[k]; rank += (o > my || (o == my && oi < myi)) ? 1 : 0; }
        const bool take = lane < cntb && rank < need;
        const unsigned long long bt = __ballot(take);
        if (take) sel[above + mbcnt64(bt)] = (unsigned short)myi;
    }
    return true;
}
__device__ __forceinline__ void topk_select(const LAS float* sc, int n, float lo, float hi, LAS unsigned* hist, LAS unsigned short* sel, LAS float* cval, LAS unsigned short* cidx, int lane) {
    int need = TOPK, mode = 2, bstar = 0; float scale = 0.f;
    const int nit = (n + 255) >> 8;
    for (int level = 0; level < 8; ++level) {
        const float range = hi - lo;
        if (!(range > 1e-30f)) { mode = 2; bstar = 0; scale = 0.f; break; }
        scale = 1024.f / range;
#pragma unroll
        for (int k = 0; k < 8; ++k) hist[lane * 8 + k] = 0u;
        for (int j = 0; j < nit; ++j) { const int i0 = 256 * j + 4 * lane; const f32x4 v4 = *(const LAS f32x4*)(sc + i0);
#pragma unroll
            for (int e = 0; e < 4; ++e) { const float v = v4[e];
                if (i0 + e < n && v >= lo && v <= hi) { const int bq = binof(v, lo, scale); (void)__hip_atomic_fetch_add(hist + (bq >> 1), 1u << (16 * (bq & 1)), __ATOMIC_RELAXED, __HIP_MEMORY_SCOPE_WORKGROUP); } } }
        unsigned wd[8]; int lsum = 0;
#pragma unroll
        for (int k = 0; k < 8; ++k) { wd[k] = hist[lane * 8 + k]; lsum += (int)(wd[k] & 0xffffu) + (int)(wd[k] >> 16); }
        int incl = lsum;
#pragma unroll
        for (int d = 1; d < 64; d <<= 1) { const int t = __shfl_down(incl, d); if (lane + d < 64) incl += t; }
        const int excl = incl - lsum;
        const bool mine = (excl < need) && (incl >= need);
        int fb = 0, fabove = 0, fcnt = 0, run = excl; bool found = false;
#pragma unroll
        for (int k = 15; k >= 0; --k) { const int cb = (int)((wd[k >> 1] >> (16 * (k & 1))) & 0xffffu); const bool hit = !found && (run + cb >= need);
            if (hit) { fb = 16 * lane + k; fabove = run; fcnt = cb; found = true; } if (!found) run += cb; }
        const unsigned long long bm = __ballot(mine);
        const int src = bm ? __builtin_ctzll(bm) : 0;
        bstar = __shfl(fb, src); const int above = __shfl(fabove, src), cntb = __shfl(fcnt, src);
        need -= above;
        if (cntb == need) { mode = 1; break; }
        if (cntb <= 64) { mode = 0; break; }
        float cl = 3.0e38f, chh = -3.0e38f;
        for (int i = lane; i < n; i += 64) { const float v = sc[i]; if (v >= lo && v <= hi && binof(v, lo, scale) == bstar) { cl = fminf(cl, v); chh = fmaxf(chh, v); } }
        lo = wave_min(cl); hi = wave_max(chh); mode = 2; bstar = 0; scale = 0.f;
    }
    int nsel = 0, ncand = 0;
    if (mode == 2) {
        for (int i0 = 0; i0 < n; i0 += 64) {
            const int i = i0 + lane; const bool in = i < n; const float v = in ? sc[i] : 0.f;
            const bool inr = in && v >= lo && v <= hi; const int bq = binof(v, lo, scale);
            const bool cand = inr && bq == bstar;
            const unsigned long long bc = __ballot(cand);
            const bool take = (in && (v > hi || (inr && bq > bstar))) || (cand && (ncand + mbcnt64(bc)) < need);
            const unsigned long long bt = __ballot(take);
            if (take) sel[nsel + mbcnt64(bt)] = (unsigned short)i;
            nsel += __builtin_popcountll(bt); ncand += __builtin_popcountll(bc);
        }
        return;
    }
    for (int j = 0; j < nit; ++j) { const int i0 = 256 * j + 4 * lane; const f32x4 v4 = *(const LAS f32x4*)(sc + i0);
#pragma unroll
        for (int e = 0; e < 4; ++e) { const float v = v4[e]; const int i = i0 + e; const bool in = i < n;
            const bool inr = in && v >= lo && v <= hi; const int bq = binof(v, lo, scale);
            const bool cand = inr && bq == bstar;
            const bool take = (in && (v > hi || (inr && bq > bstar))) || (mode == 1 && cand);
            const unsigned long long bt = __ballot(take);
            if (take) sel[nsel + mbcnt64(bt)] = (unsigned short)i;
            nsel += __builtin_popcountll(bt);
            if (mode == 0) { const unsigned long long bc = __ballot(cand);
                if (cand) { const int k = ncand + mbcnt64(bc); cval[k] = v; cidx[k] = (unsigned short)i; }
                ncand += __builtin_popcountll(bc); } } }
    if (mode == 0) {
        const float my = lane < ncand ? cval[lane] : 0.f; const int myi = lane < ncand ? (int)cidx[lane] : 0; int rank = 0;
        for (int k = 0; k < ncand; ++k) { const float o = cval[k]; const int oi = (int)cidx[k]; rank += (o > my || (o == my && oi < myi)) ? 1 : 0; }
        const bool take = lane < ncand && rank < need;
        const unsigned long long bt = __ballot(take);
        if (take) sel[nsel + mbcnt64(bt)] = (unsigned short)myi;
    }
}
template <int VAR> __device__ __forceinline__ void dsa_round(const f16* __restrict__ P, const f16* __restrict__ kdsc, const f16* __restrict__ vdsc, const f16* __restrict__ kix, const float* __restrict__ wix, const float* __restrict__ dsg, f16* __restrict__ merged,
                                          LAS unsigned char* lds, int b, int t0, int nb, int nt0, int wave, int lane_in, int flags) {
    int lane = lane_in; asm volatile("" : "+v"(lane));
    int c = lane & 31, h = lane >> 5;
    LAS float* MM = (LAS float*)(lds + XTRA_OFF + X_MM);
    LAS float* WSM = (LAS float*)(lds + XTRA_OFF + X_WSM);
    {
        half8 aix[4][4];
#pragma unroll
        for (int p = 0; p < 4; ++p) {
            const int query = t0 + 2 * p + ((c >> 2) & 1), head = (c & 3) + 4 * (c >> 3);
            const f16* ap = P + (size_t)(b * SEQ + query) * NINP + C_QIX + head * IXD + 8 * h;
#pragma unroll
            for (int st = 0; st < 4; ++st) aix[p][st] = *(const half8*)(ap + 16 * st);
        }
        float wv[4][16];
#pragma unroll
        for (int p = 0; p < 4; ++p) { const float* wp = wix + (size_t)(b * SEQ + t0 + 2 * p + h) * 16;
#pragma unroll
            for (int i4 = 0; i4 < 4; ++i4) { const f32x4 w4 = *(const f32x4*)(wp + 4 * i4); wv[p][4 * i4] = 0.5f * w4.x; wv[p][4 * i4 + 1] = 0.5f * w4.y; wv[p][4 * i4 + 2] = 0.5f * w4.z; wv[p][4 * i4 + 3] = 0.5f * w4.w; } }
        float mn[4], mx[4];
#pragma unroll
        for (int p = 0; p < 4; ++p) { mn[p] = 3.0e38f; mx[p] = -3.0e38f; }
        const int ntile = (t0 + 8 + 31) >> 5;
        half8 kf[4], kn[4];
        const f16* kp0 = kix + (size_t)(b * SEQ + c) * IXD + 8 * h;
        auto kload = [&](half8 (&dst)[4], int jt) {
#pragma unroll
            for (int st = 0; st < 4; ++st) dst[st] = *(const half8*)(kp0 + (unsigned)(32 * jt * IXD + 16 * st)); };
        auto body = [&](const half8 (&kk)[4], int jt) {
            f32x16 acc[4];
#pragma unroll
            for (int p = 0; p < 4; ++p)
#pragma unroll
                for (int i = 0; i < 16; ++i) acc[p][i] = 0.f;
#pragma unroll
            for (int st = 0; st < 4; ++st)
#pragma unroll
                for (int p = 0; p < 4; ++p) acc[p] = __builtin_amdgcn_mfma_f32_32x32x16_f16(aix[p][st], kk[st], acc[p], 0, 0, 0);
#pragma unroll
            for (int p = 0; p < 4; ++p) {
                float scv = 0.f;
#pragma unroll
                for (int i = 0; i < 16; ++i) scv = __builtin_fmaf(wv[p][i], acc[p][i] + __builtin_fabsf(acc[p][i]), scv);
                *(LAS float*)(lds + (2 * p + h) * 16384 + 4 * (32 * jt + c)) = scv;
                mn[p] = fminf(mn[p], scv); mx[p] = fmaxf(mx[p], scv);
            } };
        const int jlast = ntile - 1;
        kload(kf, wave < jlast ? wave : jlast);
        if (!(flags & 16)) for (int jt = wave; jt < ntile; jt += 2 * NWAVES) {
            const int j1 = jt + NWAVES < jlast ? jt + NWAVES : jlast, j2 = jt + 2 * NWAVES < jlast ? jt + 2 * NWAVES : jlast;
            kload(kn, j1);
            __builtin_amdgcn_sched_barrier(0);
            body(kf, jt);
            kload(kf, j2);
            __builtin_amdgcn_sched_barrier(0);
            body(kn, j1);

        }
#pragma unroll
        for (int p = 0; p < 4; ++p) {
#pragma unroll
            for (int o = 1; o < 32; o <<= 1) { mn[p] = fminf(mn[p], __shfl_xor(mn[p], o)); mx[p] = fmaxf(mx[p], __shfl_xor(mx[p], o)); }
            if (c == 0) { MM[(wave * 8 + 2 * p + h) * 2] = mn[p]; MM[(wave * 8 + 2 * p + h) * 2 + 1] = mx[p]; }
        }
    }
    __syncthreads();
    if (flags & 8) { __syncthreads(); return; }
    const int t = t0 + wave, n = t + 1;
    LAS unsigned char* reg = lds + wave * 16384;
    LAS unsigned short* sel = (LAS unsigned short*)(lds + XTRA_OFF + X_SEL + wave * 512);
    int cnt;
    if (n <= TOPK) { for (int i = lane; i < n; i += 64) sel[i] = (unsigned short)i; cnt = n; }
    else { cnt = TOPK;
        float lo = 3.0e38f, hi = -3.0e38f;
#pragma unroll
        for (int w = 0; w < NWAVES; ++w) { lo = fminf(lo, MM[(w * 8 + wave) * 2]); hi = fmaxf(hi, MM[(w * 8 + wave) * 2 + 1]); }
        LAS unsigned* hist = (LAS unsigned*)(lds + XTRA_OFF + X_HIST + wave * 2048); LAS float* cval = (LAS float*)(lds + XTRA_OFF + X_CVAL + wave * 256);
        LAS unsigned short* cidx = (LAS unsigned short*)(lds + XTRA_OFF + X_CIDX + wave * 256);
        if (!topk_fast((const LAS float*)reg, n, lo, hi, hist, sel, cval, cidx, (LAS unsigned*)(lds + XTRA_OFF + X_WSM + wave * 8), lane))
            topk_select((const LAS float*)reg, n, lo, hi, hist, sel, cval, cidx, lane); }
    if (flags & 4) { __syncthreads(); return; }
    asm volatile("" : "+v"(lane));
    const int cc = lane & 15, g = lane >> 4;
    LAS unsigned char* ktile = reg; LAS unsigned char* vtile = reg + 8192;
    half8 qf[4];
    { const f16* qp = P + (size_t)(b * SEQ + t) * NINP + C_QDS + (cc & 7) * HD + 8 * g;
#pragma unroll
      for (int st = 0; st < 4; ++st) { half8 v = *(const half8*)(qp + 32 * st);
#pragma unroll
          for (int j = 0; j < 8; ++j) v[j] = cc < 8 ? v[j] : (f16)0.f;
          qf[st] = v; } }
    int ka[4], va[8];
    { const int swr = sw16(cc);
#pragma unroll
      for (int st = 0; st < 4; ++st) ka[st] = 256 * cc + 16 * ((4 * st + g) ^ swr);
      const int q = cc >> 2, p = cc & 3, swk = (q << 2) | g;
#pragma unroll
      for (int mt = 0; mt < 8; ++mt) va[mt] = 256 * (4 * g + q) + 16 * ((2 * mt + (p >> 1)) ^ swk) + 8 * (p & 1); }
    f32x4 o[8];
#pragma unroll
    for (int mt = 0; mt < 8; ++mt) o[mt] = (f32x4){0.f, 0.f, 0.f, 0.f};
    float mrun = -1.0e30f, lrun = 0.f;
    const unsigned char* kbase = (const unsigned char*)(kdsc + (size_t)(b * SEQ) * HD);
    const unsigned char* vbase = (const unsigned char*)(vdsc + (size_t)(b * SEQ) * HD);
    const int nch = (cnt + 31) >> 5;
    TileRegs tk, tv;
    unsigned offs[8];
    sel_offs8(offs, sel, 8 * g, cnt);
    fetch_rows8(tk, kbase, offs, lane);
    for (int ch = 0; ch < nch; ++ch) {
        put_rows8(tk, ktile, lane);
        fetch_rows8(tv, vbase, offs, lane);
        f32x4 z0 = {0.f, 0.f, 0.f, 0.f}, z1 = z0;
#pragma unroll
        for (int st = 0; st < 4; ++st) {
            const half8 k0 = *(const LAS half8*)(ktile + ka[st]), k1 = *(const LAS half8*)(ktile + ka[st] + 4096);
            z0 = __builtin_amdgcn_mfma_f32_16x16x32_f16(k0, qf[st], z0, 0, 0, 0);
            z1 = __builtin_amdgcn_mfma_f32_16x16x32_f16(k1, qf[st], z1, 0, 0, 0); }
        float mx = -1.0e30f;
#pragma unroll
        for (int r = 0; r < 4; ++r) { if (32 * ch + 4 * g + r >= cnt) z0[r] = -1.0e30f; if (32 * ch + 16 + 4 * g + r >= cnt) z1[r] = -1.0e30f; mx = fmaxf(mx, fmaxf(z0[r], z1[r])); }
        if (__any(mx > mrun + 8.f)) {
            mx = fmaxf(mx, __shfl_xor(mx, 16)); mx = fmaxf(mx, __shfl_xor(mx, 32));
            const float mnew = fmaxf(mrun, mx), alpha = __expf(mrun - mnew);
            lrun *= alpha; mrun = mnew;
#pragma unroll
            for (int mt = 0; mt < 8; ++mt) o[mt] *= alpha;
        }
        half8 pf;
#pragma unroll
        for (int r = 0; r < 4; ++r) { const float p0 = __expf(z0[r] - mrun), p1 = __expf(z1[r] - mrun); lrun += p0 + p1; pf[r] = (f16)p0; pf[4 + r] = (f16)p1; }
        put_rows8(tv, vtile, lane);
        { const int chn = ch + 1 < nch ? ch + 1 : ch; sel_offs8(offs, sel, 32 * chn + 8 * g, cnt); fetch_rows8(tk, kbase, offs, lane); }
#pragma unroll
        for (int mt = 0; mt < 8; ++mt) { const half8 vf = cat8(tr_read(vtile + va[mt]), tr_read(vtile + va[mt] + 4096));
            o[mt] = __builtin_amdgcn_mfma_f32_16x16x32_f16(vf, pf, o[mt], 0, 0, 0); }
    }
    lrun += __shfl_xor(lrun, 16); lrun += __shfl_xor(lrun, 32);
    const float inv = 1.f / lrun;
    float sq = 0.f;
#pragma unroll
    for (int mt = 0; mt < 8; ++mt) { o[mt] *= inv; sq += (o[mt].x * o[mt].x + o[mt].y * o[mt].y) + (o[mt].z * o[mt].z + o[mt].w * o[mt].w); }
    sq = cc < 8 ? sq : 0.f;
    const float rstd = rsqrtf(wave_sum(sq) * (1.f / 1024.f) + EPS);
    if (cc < 8) {
#pragma unroll
        for (int mt = 0; mt < 8; ++mt) { const int d = 16 * mt + 4 * g; const f32x4 gg = *(const f32x4*)(dsg + cc * HD + d);
            u32x2 w2; w2.x = pk_h2(o[mt].x * rstd * gg.x, o[mt].y * rstd * gg.y); w2.y = pk_h2(o[mt].z * rstd * gg.z, o[mt].w * rstd * gg.w);
            *(u32x2*)(merged + (size_t)(b * SEQ + t) * DM + 1024 + cc * HD + d) = w2; }
    }
    if (nt0 >= 0) {
        int nb2 = nb, nt2 = nt0; asm volatile("" : "+s"(nb2), "+s"(nt2));
        int tid2 = threadIdx.x; asm volatile("" : "+v"(tid2)); const f16* rowp = P + (size_t)(nb2 * SEQ + nt2 + (tid2 >> 5 & 7)) * NINP;
        const void* src = tid2 < 256 ? (const void*)(rowp + C_QIX + (tid2 & 31) * 32) : (const void*)(rowp + C_QDS + (tid2 & 31) * 32);
        __builtin_amdgcn_global_load_lds((const unsigned*)src, (LAS unsigned*)(lds + XTRA_OFF + 26624 + (tid2 >> 6) * 0), 4, 0, 0);
        if (tid2 < 32) __builtin_amdgcn_global_load_lds((const unsigned*)(wix + (size_t)(nb2 * SEQ + nt2) * 16 + tid2 * 4), (LAS unsigned*)(lds + XTRA_OFF + 26624 + 256), 4, 0, 0);
    }
    __syncthreads();
}
}

#define XB_TMO      128
#define XB_XCNT(j)  (256  + 64 * (j))
#define XB_XSUB(j)  (1280 + 64 * (j))
#define XB_XGEN(j)  (2304 + 64 * (j))
#define XB_TOP      3328
#define XB_TOPGEN   3392
#define XCD_BAR_WORDS 3456
#define XB_SPIN_CAP (1u << 18)
__device__ __forceinline__ unsigned xb_ld(unsigned* p)              { return __hip_atomic_load(p, __ATOMIC_RELAXED, __HIP_MEMORY_SCOPE_AGENT); }
__device__ __forceinline__ unsigned xb_add(unsigned* p, unsigned v) { return __hip_atomic_fetch_add(p, v, __ATOMIC_RELAXED, __HIP_MEMORY_SCOPE_AGENT); }
__device__ __forceinline__ unsigned xb_xcc_id() { return (unsigned)__builtin_amdgcn_s_getreg((3 << 11) | 20) & 0xFu; }
#define XB_SPIN(cond, bar) do { unsigned _sp = 0; while (cond) { __builtin_amdgcn_s_sleep(1); \
    if ((++_sp & 255u) == 0u) { if (xb_ld(&(bar)[XB_TMO])) break; if (_sp > XB_SPIN_CAP) { atomicAdd(&(bar)[XB_TMO], 1u); break; } } } } while (0)
struct XcdBarrier { unsigned* bar; unsigned x; volatile LAS unsigned* st; };
__device__ __forceinline__ XcdBarrier xcd_barrier_post(unsigned* bar, volatile LAS unsigned* st) {
    XcdBarrier b; b.bar = bar; b.x = xb_xcc_id(); b.st = st;
    if (threadIdx.x == 0) (void)xb_add(&bar[XB_XCNT(b.x)], 1u);
    return b;
}
__device__ __forceinline__ void xcd_barrier_complete(unsigned* bar, unsigned x, unsigned& nloc, unsigned& nx) {
    const unsigned G = gridDim.x * gridDim.y * gridDim.z;
    unsigned sum, cnt, mine, sp = 0u;
    for (;;) {
        sum = 0u; cnt = 0u; mine = 0u;
#pragma unroll
        for (unsigned j = 0; j < 16; ++j) { const unsigned c = xb_ld(&bar[XB_XCNT(j)]); sum += c; cnt += (c > 0u) ? 1u : 0u; mine = (j == x) ? c : mine; }
        if (sum == G) break;
        __builtin_amdgcn_s_sleep(1);
        if ((++sp & 255u) == 0u) { if (xb_ld(&bar[XB_TMO])) break; if (sp > XB_SPIN_CAP) { atomicAdd(&bar[XB_TMO], 1u); break; } }
    }
    nloc = mine > 0u ? mine : 1u; nx = cnt > 0u ? cnt : 1u;
}
__device__ __forceinline__ void xcd_barrier(const XcdBarrier& b) {
    asm volatile("s_waitcnt vmcnt(0)" ::: "memory");
    __syncthreads();
    if (threadIdx.x == 0) {
        unsigned* bar = b.bar;
        __builtin_amdgcn_s_waitcnt(0);
        unsigned nloc = b.st[0], nx = b.st[1];
        if (nloc == 0u) { xcd_barrier_complete(bar, b.x, nloc, nx); b.st[0] = nloc; b.st[1] = nx; }
        const unsigned old = xb_add(&bar[XB_XSUB(b.x)], 1u);
        const unsigned gen = old / nloc;
        if (old + 1u == (gen + 1u) * nloc) {
            __builtin_amdgcn_fence(__ATOMIC_RELEASE, "agent");
            asm volatile("s_waitcnt vmcnt(0)" ::: "memory");
            const unsigned og = xb_add(&bar[XB_TOP], 1u);
            const unsigned tg = og / nx;
            if (og + 1u == (tg + 1u) * nx) xb_add(&bar[XB_TOPGEN], 1u);
            else XB_SPIN(xb_ld(&bar[XB_TOPGEN]) == tg, bar);
            __builtin_amdgcn_fence(__ATOMIC_ACQUIRE, "agent");
            xb_add(&bar[XB_XGEN(b.x)], 1u);
            asm volatile("s_waitcnt vmcnt(0)" ::: "memory");
        } else {
            XB_SPIN(xb_ld(&bar[XB_XGEN(b.x)]) == gen, bar);
            __builtin_amdgcn_fence(__ATOMIC_ACQUIRE, "agent");
            asm volatile("s_waitcnt vmcnt(0)" ::: "memory");
        }
    }
    __syncthreads();
}

struct Args {
    const float* x; const float* c; const int* pos; const float* w_ada; const float* b_ada; const float* n1g; const float* w_in; const float* sbg; const float* dsg;
    const float* w_out; const float* n2g; const float* w_up; const float* conv_w; const float* conv_b; const float* w_down; const float* fng;
    float* out; unsigned char* ws; int ph_lo, ph_hi, region, pad;
};

struct TrItem { const float* W; f16* WT; const float* gk; const float* q8; int K, N, k0, n0, up; };
__device__ __forceinline__ TrItem tr_decode(const Args& a, int r, bool fold) {
    constexpr int NB_IN = NINP / 32, I_IN = (DM / 64) * (NINP / 32), I_OUT = (DM / 64) * (DM / 32), I_UP = (DM / 64) * (NUP / 32);
    TrItem t; int nblk;
    t.gk = nullptr; t.q8 = nullptr;
    if (r < I_IN) { t.W = a.w_in; t.WT = (f16*)(a.ws + WS_WTIN); t.K = DM; t.N = NIN; nblk = NB_IN; t.up = 0; }
    else if ((r -= I_IN) < I_OUT) { t.W = a.w_out; t.WT = (f16*)(a.ws + WS_WTOUT); t.K = DM; t.N = DM; nblk = DM / 32; t.up = 0; t.gk = fold ? a.sbg : nullptr; }
    else if ((r -= I_OUT) < I_UP) { t.W = a.w_up; t.WT = (f16*)(a.ws + WS_WTUP); t.K = DM; t.N = NUP; nblk = NUP / 32; t.up = 1; t.q8 = (const float*)((const unsigned*)(a.ws + WS_CTL) + CW_SBMAX); }
    else { r -= I_UP; t.W = a.w_down; t.WT = (f16*)(a.ws + WS_WTDN); t.K = DFF; t.N = DM; nblk = DM / 32; t.up = 0; }
    t.k0 = 64 * (r / nblk); t.n0 = 32 * (r % nblk); return t;
}
__device__ __forceinline__ void tr_load(const TrItem& t, f32x4 (&v)[8], int lane) {
    const int n = t.n0 + 4 * (lane & 7); const bool ok = n < t.N;
    const float* p = t.W + (size_t)(t.k0 + (lane >> 3)) * t.N + (ok ? n : 0);
#pragma unroll
    for (int i = 0; i < 8; ++i) { const f32x4 x = __builtin_nontemporal_load((const f32x4*)(p + (size_t)(8 * i) * t.N)); v[i] = ok ? x : (f32x4){0.f, 0.f, 0.f, 0.f}; }
}
__device__ __forceinline__ void tr_store(const TrItem& t, const f32x4 (&v)[8], LAS float* scr, int lane) {
#pragma unroll
    for (int i = 0; i < 8; ++i) { LAS float* d = scr + ((lane >> 3) + 8 * i) * 33 + 4 * (lane & 7); d[0] = v[i].x; d[1] = v[i].y; d[2] = v[i].z; d[3] = v[i].w; }
    asm volatile("s_waitcnt lgkmcnt(0)" ::: "memory");
    const int c = lane & 7;
    f32x4 g0 = {1.f, 1.f, 1.f, 1.f}, g1 = g0;
    if (t.gk && t.k0 < 1024) { g0 = *(const f32x4*)(t.gk + t.k0 + 8 * c); g1 = *(const f32x4*)(t.gk + t.k0 + 8 * c + 4); }
#pragma unroll
    for (int j = 0; j < 4; ++j) { const int nn = (lane >> 3) + 8 * j; const LAS float* sp = scr + (8 * c) * 33 + nn;
        int n = t.n0 + nn;
        if (t.q8) {
            const float inv = 63.5f * __builtin_amdgcn_rcpf(fmaxf(t.q8[n], 1e-20f));
            u32x2 o; o.x = q8x4(sp[0 * 33] * inv, sp[1 * 33] * inv, sp[2 * 33] * inv, sp[3 * 33] * inv); o.y = q8x4(sp[4 * 33] * inv, sp[5 * 33] * inv, sp[6 * 33] * inv, sp[7 * 33] * inv);
            if (t.up) n = n < DFF ? (n / 128) * 256 + (n % 128) : ((n - DFF) / 128) * 256 + 128 + ((n - DFF) % 128);
            *(u32x2*)((unsigned char*)t.WT + (size_t)n * t.K + t.k0 + 8 * c) = o;
        } else {
        u32x4 o; o.x = pk_h2(sp[0 * 33] * g0.x, sp[1 * 33] * g0.y); o.y = pk_h2(sp[2 * 33] * g0.z, sp[3 * 33] * g0.w); o.z = pk_h2(sp[4 * 33] * g1.x, sp[5 * 33] * g1.y); o.w = pk_h2(sp[6 * 33] * g1.z, sp[7 * 33] * g1.w);
        if (t.up) n = n < DFF ? (n / 128) * 256 + (n % 128) : ((n - DFF) / 128) * 256 + 128 + ((n - DFF) % 128);
        *(u32x4*)(t.WT + (size_t)n * t.K + t.k0 + 8 * c) = o; } }
    asm volatile("s_waitcnt lgkmcnt(0)" ::: "memory");
}
constexpr int ADA_KC = 32, ADA_ROWS = DM / ADA_KC;
__device__ __forceinline__ void p0_ada_item(const float* __restrict__ w_ada, const float* __restrict__ b_ada, const LAS float* sil, float* __restrict__ modp, float* __restrict__ mod, unsigned* cnt, int item, int lane) {
    const int kc = item / 48, jc = item % 48, j0 = jc * 256 + lane * 4;
    f32x4 a0 = {0.f, 0.f, 0.f, 0.f}, a1 = {0.f, 0.f, 0.f, 0.f};
    const float* wp = w_ada + (size_t)(kc * ADA_ROWS) * MODW + j0;
#pragma unroll 32
    for (int k = 0; k < ADA_ROWS; ++k) { const f32x4 w = __builtin_nontemporal_load((const f32x4*)(wp + (size_t)k * MODW)); const float s0 = sil[kc * ADA_ROWS + k], s1 = sil[DM + kc * ADA_ROWS + k]; a0 += w * s0; a1 += w * s1; }
    { float* p0 = modp + (size_t)(kc * 2 + 0) * MODW + j0; float* p1 = modp + (size_t)(kc * 2 + 1) * MODW + j0;
#pragma unroll
      for (int e = 0; e < 4; ++e) { __hip_atomic_store(p0 + e, a0[e], __ATOMIC_RELAXED, __HIP_MEMORY_SCOPE_AGENT); __hip_atomic_store(p1 + e, a1[e], __ATOMIC_RELAXED, __HIP_MEMORY_SCOPE_AGENT); } }
    asm volatile("s_waitcnt vmcnt(0)" ::: "memory");
    unsigned old = 0u;
    if (lane == 0) old = __hip_atomic_fetch_add(cnt + 64 * jc, 1u, __ATOMIC_RELAXED, __HIP_MEMORY_SCOPE_AGENT);
    old = (unsigned)__builtin_amdgcn_readfirstlane((int)old);
    if (old == (unsigned)(ADA_KC - 1)) {
        const f32x4 bias = *(const f32x4*)(b_ada + j0);
        f32x4 s0 = bias, s1 = bias;
#pragma unroll 4
        for (int k2 = 0; k2 < ADA_KC; ++k2) { const float* p0 = modp + (size_t)(k2 * 2 + 0) * MODW + j0; const float* p1 = modp + (size_t)(k2 * 2 + 1) * MODW + j0;
#pragma unroll
            for (int e = 0; e < 4; ++e) { s0[e] += __hip_atomic_load(p0 + e, __ATOMIC_RELAXED, __HIP_MEMORY_SCOPE_AGENT); s1[e] += __hip_atomic_load(p1 + e, __ATOMIC_RELAXED, __HIP_MEMORY_SCOPE_AGENT); } }
        *(f32x4*)(mod + j0) = s0; *(f32x4*)(mod + MODW + j0) = s1;
    }
}
__device__ __forceinline__ void tr_run(const Args& a, LAS float* scr, int base, int it0, int stride, int cnt, int lane, bool fold) {
    if (cnt <= 0) return;
    f32x4 v0[8], v1[8], v2[8];
    TrItem c0 = tr_decode(a, base + it0, fold), c1 = c0, c2 = c0;
    tr_load(c0, v0, lane);
    if (cnt > 1) { c1 = tr_decode(a, base + it0 + stride, fold); tr_load(c1, v1, lane); }
    for (int q = 0; q < cnt; ++q) {
        if (q + 2 < cnt) { c2 = tr_decode(a, base + it0 + (q + 2) * stride, fold); tr_load(c2, v2, lane); }
        tr_store(c0, v0, scr, lane);
        c0 = c1; c1 = c2;
#pragma unroll
        for (int i = 0; i < 8; ++i) { v0[i] = v1[i]; v1[i] = v2[i]; }
    }
}
constexpr int UP_DEFER = 4992;
constexpr int TR_I_IN = (DM / 64) * (NINP / 32), TR_I_OUT = (DM / 64) * (DM / 32), TR_I_UP = (DM / 64) * (NUP / 32), TR_I_DN = (DFF / 64) * (DM / 32);
__device__ __forceinline__ void tr_deferred(const Args& a, LAS unsigned char* lds, int base, int nitems, int nwg, int G, int wave, int lane) {
    const int busy = nwg % G;
    const int nidle = busy ? G - busy : G, me = busy ? (int)blockIdx.x - busy : (int)blockIdx.x;
    if (me < 0) return;
    const int it0 = me * NWAVES + wave, stride = nidle * NWAVES;
    tr_run(a, (LAS float*)(lds + wave * 16384), base, it0, stride, (nitems - it0 + stride - 1) / stride, lane, false);
}
__device__ __forceinline__ void phase0(const Args& a, LAS unsigned char* lds, int vcu, int G, int wave, int lane, bool fold) {
    unsigned char* ws = a.ws;
    LAS float* sil = (LAS float*)(lds + XTRA_OFF);
    for (int e = threadIdx.x; e < BATCH * DM; e += NWAVES * 64) sil[e] = silu_f(a.c[e]);
    __syncthreads();
    LAS float* scr = (LAS float*)(lds + wave * 16384);
    const int gw = vcu * NWAVES + wave, NGW = G * NWAVES;
    float* modp = (float*)(ws + WS_MODP);
    constexpr int NADA = ADA_KC * 48, HW = 6, HS = 2, NITEMS = TR_I_IN + TR_I_OUT;
    if (wave < HW) for (int it = vcu * HW + wave; it < NADA; it += G * HW) p0_ada_item(a.w_ada, a.b_ada, sil, modp, (float*)(ws + WS_MOD), (unsigned*)(ws + WS_CTL) + CW_ADA, it, lane);
    const int nheavy = G * HW, nlight = G * (NWAVES - HW);
    const int nh_items = nheavy * HS < NITEMS ? nheavy * HS : NITEMS;
    int it0, stride, cnt;
    if (wave < HW) { it0 = (NITEMS - nh_items) + (vcu * HW + wave) * HS; stride = 1; cnt = HS; if (it0 + cnt > NITEMS) cnt = NITEMS - it0 > 0 ? NITEMS - it0 : 0; }
    else { it0 = vcu * (NWAVES - HW) + (wave - HW); stride = nlight; cnt = (NITEMS - nh_items - it0 + stride - 1) / stride; if (cnt < 0) cnt = 0; }
    tr_run(a, scr, 0, it0, stride, cnt, lane, fold);
    { unsigned* sbmax = (unsigned*)(ws + WS_CTL) + CW_SBMAX;
      for (int e = (vcu * NWAVES + wave) * 64 + lane; e < NUP * 16; e += NGW * 64) { const int n = e % NUP, rg = e / NUP; float mx = 0.f;
#pragma unroll
          for (int k = 0; k < 8; ++k) mx = fmaxf(mx, fabsf(a.w_up[(size_t)(rg * 8 + k) * NUP + n]));
          (void)__hip_atomic_fetch_max(sbmax + n, __builtin_bit_cast(unsigned, mx), __ATOMIC_RELAXED, __HIP_MEMORY_SCOPE_AGENT); } }
    float* rope = (float*)(ws + WS_ROPE);
    for (int idx = (vcu * NWAVES + wave) * 64 + lane; idx < MTOK * 24; idx += NGW * 64) {
        const int m = idx / 24, i = idx % 24;
        const float inv = i < 16 ? INV128[i] : INV64[i - 16];
        const float ang = (float)a.pos[m] * inv;
        const double rev = (double)ang * 0.15915494309189535;
        const float r = (float)((rev - floor(rev)) * 6.283185307179586);
        *(float2*)(rope + (size_t)idx * 2) = make_float2(cosf(r), sinf(r));
    }
}
__device__ __forceinline__ void hrows(const float* __restrict__ x, const float* __restrict__ g, const LAS float* S1, f16* __restrict__ H, int gw, int NGW, int lane) {
    for (int m0 = gw; m0 < MTOK; m0 += 2 * NGW) {
        const int m1 = m0 + NGW < MTOK ? m0 + NGW : m0;
        f32x4 v[2][8];
#pragma unroll
        for (int r = 0; r < 2; ++r) { const f32x4* xr = (const f32x4*)(x + (size_t)(r ? m1 : m0) * DM) + lane;
#pragma unroll
            for (int j = 0; j < 8; ++j) v[r][j] = __builtin_nontemporal_load(xr + 64 * j); }
#pragma unroll
        for (int r = 0; r < 2; ++r) {
            const int m = r ? m1 : m0; const int b = m / SEQ;
            float ss = 0.f;
#pragma unroll
            for (int j = 0; j < 8; ++j) ss += (v[r][j].x * v[r][j].x + v[r][j].y * v[r][j].y) + (v[r][j].z * v[r][j].z + v[r][j].w * v[r][j].w);
            const float rstd = rsqrtf(wave_sum(ss) * (1.f / DM) + EPS);
            u32x2* o8 = (u32x2*)(H + (size_t)m * DM) + lane;
#pragma unroll
            for (int j = 0; j < 8; ++j) { const int k = 4 * (lane + 64 * j);
                const f32x4 gg = *(const f32x4*)(g + k); const f32x4 sh = *(const LAS f32x4*)(S1 + b * 4096 + k), sc = *(const LAS f32x4*)(S1 + b * 4096 + 2048 + k);
                const f32x4 y = ((v[r][j] * rstd) * gg) * (sc + 1.f) + sh;
                u32x2 w; w.x = pk_h2(y.x, y.y); w.y = pk_h2(y.z, y.w); o8[64 * j] = w; }
        }
    }
}
__device__ __forceinline__ void hrows1(const float* __restrict__ x, const float* __restrict__ g, const LAS float* S1, f16* __restrict__ H, int gw, int NGW, int lane) {
    for (int m = gw; m < MTOK; m += NGW) {
        const int b = m / SEQ;
        const f32x4* xr = (const f32x4*)(x + (size_t)m * DM) + lane;
        f32x4 v[8]; float ss = 0.f;
#pragma unroll
        for (int j = 0; j < 8; ++j) { v[j] = xr[64 * j]; ss += (v[j].x * v[j].x + v[j].y * v[j].y) + (v[j].z * v[j].z + v[j].w * v[j].w); }
        const float rstd = rsqrtf(wave_sum(ss) * (1.f / DM) + EPS);
        u32x2* o8 = (u32x2*)(H + (size_t)m * DM) + lane;
#pragma unroll
        for (int j = 0; j < 8; ++j) { const int k = 4 * (lane + 64 * j);
            const f32x4 gg = *(const f32x4*)(g + k); const f32x4 sh = *(const LAS f32x4*)(S1 + b * 4096 + k), sc = *(const LAS f32x4*)(S1 + b * 4096 + 2048 + k);
            const f32x4 y = ((v[j] * rstd) * gg) * (sc + 1.f) + sh;
            u32x2 w; w.x = pk_h2(y.x, y.y); w.y = pk_h2(y.z, y.w); o8[64 * j] = w; }
    }
}
__device__ __forceinline__ void phase1(const Args& a, LAS unsigned char* lds, int vcu, int G, int wave, int lane) {
    unsigned char* ws = a.ws;
    const float* mod = (const float*)(ws + WS_MOD);
    LAS float* S1 = (LAS float*)lds;
    for (int e = threadIdx.x; e < 2 * 4096; e += NWAVES * 64) { const int b = e >> 12, j = e & 4095; S1[e] = mod[(size_t)b * MODW + j]; }
    __syncthreads();
    if (blockIdx.x == 0 && wave == 0) {
#pragma unroll
        for (int b = 0; b < BATCH; ++b) { float mx = 0.f;
            for (int j = lane; j < DM; j += 64) mx = fmaxf(mx, fabsf(mod[(size_t)b * MODW + 3 * DM + j]));
#pragma unroll
            for (int o = 1; o < 64; o <<= 1) mx = fmaxf(mx, __shfl_xor(mx, o));
            if (lane == 0) ((float*)(ws + WS_MAXSH))[b] = mx; } }
    hrows(a.x, a.n1g, S1, (f16*)(ws + WS_H), vcu * NWAVES + wave, G * NWAVES, lane);
    __syncthreads();
    { int l2 = threadIdx.x; asm volatile("" : "+v"(l2)); l2 &= 63;
      const int it0 = vcu * NWAVES + wave, stride = G * NWAVES, nit = TR_I_UP - UP_DEFER;
      tr_run(a, (LAS float*)(lds + wave * 16384), TR_I_IN + TR_I_OUT + UP_DEFER, it0, stride, (nit - it0 + stride - 1) / stride, l2, false); }
}

__global__ void __launch_bounds__(NWAVES * 64, 2) mega(Args a) {
    extern __shared__ __attribute__((aligned(16))) unsigned char lds_raw[];
    LAS unsigned char* lds = (LAS unsigned char*)lds_raw;
    volatile LAS unsigned* MISC = (volatile LAS unsigned*)(lds + MISC_OFF);
    int tid = threadIdx.x; const int wave = __builtin_amdgcn_readfirstlane(tid >> 6); int lane = tid & 63;
#define FRESH() do { tid = threadIdx.x; asm volatile("" : "+v"(tid)); lane = tid & 63; } while (0)
    const int G = gridDim.x; const bool fuse = true;
    const int vcu = (G % 8 == 0) ? (blockIdx.x % 8) * (G / 8) + blockIdx.x / 8 : blockIdx.x;
    if (tid < 64) MISC[tid] = 0u;
    __syncthreads();
    unsigned* ctl = (unsigned*)(a.ws + WS_CTL);
    XcdBarrier bar = xcd_barrier_post(ctl + CW_BAR + a.region * XCD_BAR_WORDS, MISC + 8);
    const int lo = a.ph_lo, hi = a.ph_hi;
#define IN(k) (lo <= (k) && (k) < hi)
#define SEAM(k) do { if (IN(k) && IN((k) + 1)) xcd_barrier(bar); } while (0)
    if (IN(0)) { FRESH(); phase0(a, lds, vcu, G, wave, lane, fuse); } SEAM(0);
    if (IN(1)) { FRESH(); phase1(a, lds, vcu, G, wave, lane); } SEAM(1);
    if (IN(2)) { FRESH();
        pg8::Gemm g{(const f16*)(a.ws + WS_H), (const f16*)(a.ws + WS_WTIN), MTOK, NINP, DM}; pg8::StaticOrder S; S.init(MTOK, NINP, G, (int)blockIdx.x);
        pg8::EpiProjF E{(f16*)(a.ws + WS_PROJ), (f16*)(a.ws + WS_KIX), (float*)(a.ws + WS_WIX), (const float*)(a.ws + WS_ROPE), (f16*)(a.ws + WS_KSBC), (f16*)(a.ws + WS_VSBC), (f16*)(a.ws + WS_KDSC), (f16*)(a.ws + WS_VDSC)};
        pg8::gemm_phase<pg8::EpiProjF, pg8::StaticOrder, true, true>(lds, g, S, E);
        FRESH(); tr_deferred(a, lds, TR_I_IN + TR_I_OUT, UP_DEFER, (MTOK / 256) * (NINP / 256), G, wave, lane);
    } SEAM(2);
    if (IN(3)) { FRESH();
        const f16* P = (const f16*)(a.ws + WS_PROJ);
        if (!(a.pad & 1)) for (int it = vcu * NWAVES + wave; it < BATCH * NH * (SEQ / 32); it += G * NWAVES) {
            const int qb = it % (SEQ / 32), hd = (it / (SEQ / 32)) % NH, b = it / ((SEQ / 32) * NH);
            att::sb_item(P, (const f16*)(a.ws + WS_KSBC), (const f16*)(a.ws + WS_VSBC), (f16*)(a.ws + WS_MERGED), (float*)(a.ws + WS_SSQ), lds + wave * 16384, b, hd, qb, lane);
        }
        __syncthreads();
        if (!(a.pad & 2)) for (int k = vcu; k < BATCH * (SEQ / 8); k += G) {
            auto decode = [&](int kk, int& bb, int& tt0) { bb = kk / (SEQ / 8); const int r = kk % (SEQ / 8); tt0 = 8 * (r < SEQ / 16 ? r : (SEQ / 8 - 1) - (r - SEQ / 16)); };
            int b, t0, nb = 0, nt0 = -1; decode(k, b, t0);
            if (k + G < BATCH * (SEQ / 8)) decode(k + G, nb, nt0);
            att::dsa_round<0>(P, (const f16*)(a.ws + WS_KDSC), (const f16*)(a.ws + WS_VDSC), (const f16*)(a.ws + WS_KIX), (const float*)(a.ws + WS_WIX), a.dsg, (f16*)(a.ws + WS_MERGED), lds, b, t0, nb, nt0, wave, lane, a.pad);
        }
    } SEAM(3);
    if (IN(5)) { FRESH();
        pg8::Gemm g{(const f16*)(a.ws + WS_MERGED), (const f16*)(a.ws + WS_WTOUT), MTOK, DM, (a.pad & 256) ? 256 : DM}; pg8::StaticOrder S; S.init(MTOK, DM, G, (int)blockIdx.x);
        const float* mod = (const float*)(a.ws + WS_MOD);
        pg8::EpiResidNorm<1> E{a.x, mod + 2 * DM, a.n2g, mod + 3 * DM, (float*)(a.ws + WS_X1), (f16*)(a.ws + WS_H), (float*)(a.ws + WS_XCH), ctl + CW_XCNT, (const float*)(a.ws + WS_SSQ), (float*)(a.ws + WS_XCH2), (float*)(a.ws + WS_SA), (const float*)(a.ws + WS_MAXSH)};
        pg8::gemm_phase<pg8::EpiResidNorm<1>, pg8::StaticOrder, false, true>(lds, g, S, E);
    } SEAM(6);
    if (IN(7)) { FRESH();
        pg8::Gemm g{(const f16*)(a.ws + WS_H), (const f16*)(a.ws + WS_WTUP), MTOK, NUP, DM / 2}; pg8::StaticOrder S; S.init(MTOK, NUP, G, (int)blockIdx.x);
        pg8::EpiUpConv E{a.conv_w, a.conv_b, (f16*)(a.ws + WS_ACT), (float*)(a.ws + WS_UH), (const float*)(a.ws + WS_SA), (const float*)((const unsigned*)(a.ws + WS_CTL) + CW_SBMAX)};
        pg8::gemm_phase<pg8::EpiUpConv, pg8::StaticOrder, true, true>(lds, g, S, E);
        FRESH(); tr_deferred(a, lds, TR_I_IN + TR_I_OUT + TR_I_UP, TR_I_DN, (MTOK / 256) * (NUP / 256), G, wave, lane);
    } SEAM(7);
    if (IN(8)) { FRESH();
        const float* uh = (const float*)(a.ws + WS_UH); f16* act = (f16*)(a.ws + WS_ACT);
        for (int e = blockIdx.x * (NWAVES * 64) + tid; e < (MTOK / 64) * (DFF / 4); e += G * NWAVES * 64) {
            const int chunk = e / (DFF / 4), ch = 4 * (e % (DFF / 4)); const bool first = (chunk % (SEQ / 64)) == 0;
            f32x4 r0, r1;
#pragma unroll
            for (int gv = 0; gv < 2; ++gv) { const int c = gv * DFF + ch; const f32x4 z4 = {0.f, 0.f, 0.f, 0.f};
                const f32x4 um2 = first ? z4 : *(const f32x4*)(uh + (size_t)((chunk - 1) * 4 + 2) * NUP + c), um1 = first ? z4 : *(const f32x4*)(uh + (size_t)((chunk - 1) * 4 + 3) * NUP + c);
                const f32x4 u0 = *(const f32x4*)(uh + (size_t)(chunk * 4 + 0) * NUP + c), u1 = *(const f32x4*)(uh + (size_t)(chunk * 4 + 1) * NUP + c);
                const f32x4 k0 = *(const f32x4*)(a.conv_w + c), k1 = *(const f32x4*)(a.conv_w + NUP + c), k2 = *(const f32x4*)(a.conv_w + 2 * NUP + c), bz = *(const f32x4*)(a.conv_b + c);
                const f32x4 y0 = bz + k0 * um2 + k1 * um1 + k2 * u0, y1 = bz + k0 * um1 + k1 * u0 + k2 * u1;
                if (gv == 0) {
#pragma unroll
                    for (int j = 0; j < 4; ++j) { r0[j] = pg8::silu_fast(y0[j]); r1[j] = pg8::silu_fast(y1[j]); }
                } else { r0 *= y0; r1 *= y1; } }
            u32x2 w0, w1; w0.x = pk_h2(r0.x, r0.y); w0.y = pk_h2(r0.z, r0.w); w1.x = pk_h2(r1.x, r1.y); w1.y = pk_h2(r1.z, r1.w);
            *(u32x2*)(act + (size_t)(chunk * 64) * DFF + ch) = w0; *(u32x2*)(act + (size_t)(chunk * 64 + 1) * DFF + ch) = w1;
        }
    } SEAM(8);
    if (IN(9)) { FRESH();
        pg8::Gemm g{(const f16*)(a.ws + WS_ACT), (const f16*)(a.ws + WS_WTDN), MTOK, DM, (a.pad & 256) ? 256 : DFF}; pg8::StaticOrder S; S.init(MTOK, DM, G, (int)blockIdx.x);
        const float* mod = (const float*)(a.ws + WS_MOD);
        pg8::EpiResidNorm<0> E{(const float*)(a.ws + WS_X1), mod + 5 * DM, a.fng, nullptr, a.out, nullptr, (float*)(a.ws + WS_XCH) + 32 * 8 * 256, ctl + CW_XCNT + 32 * 64, nullptr, nullptr, nullptr, nullptr};
        pg8::gemm_phase<pg8::EpiResidNorm<0>, pg8::StaticOrder, false, true>(lds, g, S, E);
    }
#undef IN
#undef SEAM
}

extern "C" void kernel_launch(void* const* d_in, const int* in_sizes, int n_in, void* d_out, int out_size, void* d_ws, size_t ws_size, hipStream_t stream) {
    if (n_in != 16 || ws_size < WS_END) { fprintf(stderr, "kernel_launch: unexpected n_in %d / ws %zu\n", n_in, ws_size); return; }
    const float* x = (const float*)d_in[0]; const float* c = (const float*)d_in[1]; const int* pos = (const int*)d_in[2];
    const float* w_ada = (const float*)d_in[3]; const float* b_ada = (const float*)d_in[4]; const float* n1g = (const float*)d_in[5];
    const float* w_in = (const float*)d_in[6]; const float* sbg = (const float*)d_in[7]; const float* dsg = (const float*)d_in[8];
    const float* w_out = (const float*)d_in[9]; const float* n2g = (const float*)d_in[10]; const float* w_up = (const float*)d_in[11];
    const float* conv_w = (const float*)d_in[12]; const float* conv_b = (const float*)d_in[13]; const float* w_down = (const float*)d_in[14];
    const float* fng = (const float*)d_in[15];
    unsigned char* ws = (unsigned char*)d_ws; float* out = (float*)d_out;
    static int grid = 0;
    if (grid == 0) {
        int dev = 0, cus = 0;
        if (hipGetDevice(&dev) != hipSuccess || hipDeviceGetAttribute(&cus, hipDeviceAttributeMultiprocessorCount, dev) != hipSuccess) { fprintf(stderr, "kernel_launch: device query failed\n"); grid = -1; return; }
        if (hipFuncSetAttribute((const void*)mega, hipFuncAttributeMaxDynamicSharedMemorySize, LDS_BYTES) != hipSuccess) { fprintf(stderr, "kernel_launch: hipFuncSetAttribute failed\n"); grid = -1; return; }
        int per_cu = 0; (void)hipOccupancyMaxActiveBlocksPerMultiprocessor(&per_cu, (const void*)mega, NWAVES * 64, LDS_BYTES); (void)hipGetLastError();
        if (per_cu < 1) fprintf(stderr, "kernel_launch: occupancy query reports %d blocks/CU\n", per_cu);
        grid = cus;
        if (cus != (MTOK / 256) * (DM / 256)) { fprintf(stderr, "kernel_launch: built for a %d-CU device (one out-projection / down-projection unit per workgroup); found %d CUs; nothing launched\n", (MTOK / 256) * (DM / 256), cus); grid = -1; }
    }
    if (grid < 0) return;
    (void)hipMemsetAsync(ws + WS_CTL, 0, 1 * MiB, stream);
    Args a{};
    a.x = x; a.c = c; a.pos = pos; a.w_ada = w_ada; a.b_ada = b_ada; a.n1g = n1g; a.w_in = w_in; a.sbg = sbg; a.dsg = dsg; a.w_out = w_out; a.n2g = n2g; a.w_up = w_up;
    a.conv_w = conv_w; a.conv_b = conv_b; a.w_down = w_down; a.fng = fng; a.out = out; a.ws = ws;
    auto run = [&](int lo, int hi, int region) { a.ph_lo = lo; a.ph_hi = hi; a.region = region; hipLaunchKernelGGL(mega, dim3(grid), dim3(NWAVES * 64), LDS_BYTES, stream, a); };
    run(0, 11, 0);
#ifdef PROBE_LO
    a.pad = PROBE_FLAGS; run(PROBE_LO, PROBE_HI, 1);
#endif
}
```

```cpp
#include <hip/hip_runtime.h>
#include <cstdio>

typedef _Float16 f16;

constexpr int BATCH = 2, SEQ = 4096, DM = 2048, MTOK = BATCH * SEQ;
constexpr int HD = 128, NH = 8, IXH = 16, IXD = 64, TOPK = 256;
constexpr int DFF = 5504, NUP = 2 * DFF;
constexpr int NIN = 5456, NINP = 5632;
constexpr int C_QSB = 0, C_KSB = 1024, C_VSB = 2048, C_QDS = 3072, C_KDS = 4096, C_VDS = 4224, C_QIX = 4352, C_KIX = 5376, C_WIX = 5440;
constexpr int MODW = 6 * DM;
constexpr float EPS = 1e-6f;
constexpr float QSCALE = 0.08838834764831845f;
constexpr float IDX_SCALE = 0.03125f;

__constant__ float INV128[16] = {1.0f, 0.44036659598350525f, 0.1939227432012558f, 0.08539710193872452f, 0.03760603070259094f, 0.01656043902039528f, 0.007292664609849453f, 0.0032114458736032248f,
                                 0.0014142135623842478f, 0.000622772378847003f, 0.00027424818836152554f, 0.00012076973507646471f, 5.318296098266728e-05f, 2.34199997066753e-05f, 1.0313386155758053e-05f, 4.541670477919979e-06f};
__constant__ float INV64[8] = {1.0f, 0.1939227432012558f, 0.03760603070259094f, 0.007292664609849453f, 0.0014142135623842478f, 0.00027424818836152554f, 5.318296098266728e-05f, 1.0313386155758053e-05f};

constexpr size_t MiB = 1u << 20;
constexpr size_t WS_CTL = 0;
constexpr size_t WS_MOD = 1 * MiB;
constexpr size_t WS_MODP = 380 * MiB;
constexpr size_t WS_ROPE = 4 * MiB;
constexpr size_t WS_XCH = 3 * MiB + 512 * 1024;
constexpr size_t WS_SA = 6 * MiB + 768 * 1024;
constexpr size_t WS_SACT = WS_SA + 64 * 1024;
constexpr size_t WS_MAXSH = WS_SA + 128 * 1024;
constexpr size_t WS_XCH2 = 383 * MiB;
constexpr size_t WS_SSQ = 6 * MiB + 512 * 1024;
constexpr size_t WS_WIX = 6 * MiB;
constexpr size_t WS_KIX = 7 * MiB;
constexpr size_t WS_WTIN = 8 * MiB;
constexpr size_t WS_WTOUT = 30 * MiB;
constexpr size_t WS_WTUP = 38 * MiB;
constexpr size_t WS_WTDN = 81 * MiB;
constexpr size_t WS_H = 103 * MiB;
constexpr size_t WS_X1 = 135 * MiB;
constexpr size_t WS_PROJ = 199 * MiB;
constexpr size_t WS_ACT = WS_PROJ;
constexpr size_t WS_MERGED = 287 * MiB;
constexpr size_t WS_FREE = 319 * MiB;
constexpr size_t WS_OSB32 = 319 * MiB;
constexpr size_t WS_ODS32 = 351 * MiB;
constexpr size_t WS_U16 = 287 * MiB;
constexpr size_t WS_UH = 8 * MiB;
constexpr size_t WS_ACT8 = 287 * MiB;
constexpr int DFFP = 5632;
constexpr size_t WS_KSBC = 342 * MiB;
constexpr size_t WS_VSBC = 358 * MiB;
constexpr size_t WS_KDSC = 374 * MiB;
constexpr size_t WS_VDSC = 376 * MiB;
constexpr size_t WS_END = 384 * MiB;

__device__ __forceinline__ float wave_sum(float v) {
#pragma unroll
    for (int o = 1; o < 64; o <<= 1) v += __shfl_xor(v, o);
    return v;
}
__device__ __forceinline__ float block_sum256(float v, float* red) {
    v = wave_sum(v);
    __syncthreads();
    if ((threadIdx.x & 63) == 0) red[threadIdx.x >> 6] = v;
    __syncthreads();
    return red[0] + red[1] + red[2] + red[3];
}
__device__ __forceinline__ float silu_f(float v) { return v / (1.f + expf(-v)); }
__device__ __forceinline__ float softplus_f(float z) { return fmaxf(z, 0.f) + log1pf(expf(-fabsf(z))); }

#define LAS __attribute__((address_space(3)))
typedef _Float16 half8 __attribute__((ext_vector_type(8)));
typedef _Float16 half4 __attribute__((ext_vector_type(4)));
typedef _Float16 half2v __attribute__((ext_vector_type(2)));
typedef float f32x4 __attribute__((ext_vector_type(4)));
typedef float f32x16 __attribute__((ext_vector_type(16)));
typedef unsigned u32x4 __attribute__((ext_vector_type(4)));
typedef unsigned u32x2 __attribute__((ext_vector_type(2)));
typedef int i32x4 __attribute__((ext_vector_type(4)));
__device__ __forceinline__ unsigned q8x4(float a, float b, float c, float d) {
    a = __builtin_amdgcn_fmed3f(__builtin_rintf(a), -127.f, 127.f); b = __builtin_amdgcn_fmed3f(__builtin_rintf(b), -127.f, 127.f);
    c = __builtin_amdgcn_fmed3f(__builtin_rintf(c), -127.f, 127.f); d = __builtin_amdgcn_fmed3f(__builtin_rintf(d), -127.f, 127.f);
    const unsigned p01 = __builtin_bit_cast(unsigned, __builtin_amdgcn_cvt_pk_i16((int)a, (int)b)), p23 = __builtin_bit_cast(unsigned, __builtin_amdgcn_cvt_pk_i16((int)c, (int)d));
    return __builtin_amdgcn_perm(p23, p01, 0x06040200u);
}
__device__ __forceinline__ unsigned pk_h2(float lo, float hi) { half2v h = {(f16)lo, (f16)hi}; return __builtin_bit_cast(unsigned, h); }

constexpr int NWAVES = 8;
constexpr int LDS_BYTES = 159744;
constexpr int RING_BYTES = 131072;
constexpr int XTRA_OFF = RING_BYTES;
constexpr int MISC_OFF = LDS_BYTES - 256;
constexpr int CW_TMO = 0, CW_BAR = 4096, CW_XCNT = 32768, CW_ADA = 40960, CW_SBMAX = 49152, CW_SDMAX = 61440;

namespace pg8 {
constexpr int BM = 256, BK = 64, HALF = 128, HTB = HALF * BK * 2, STAGE_BYTES = 8 * HTB, NXCD = 8, WGM = 8;
__host__ __device__ __forceinline__ int lds_byte(int r, int c) { const int st = (r >> 4) * 2 + (c >> 5), rr = r & 15, cc = c & 31, ob = rr * 64 + cc * 2; return st * 1024 + (ob ^ (((ob >> 9) & 1) << 5)); }
__host__ __device__ __forceinline__ void stage_rc(int b, int& R, int& C) { const int st = b / 1024, sb = b % 1024, swz = sb ^ (((sb >> 9) & 1) << 5); R = (st >> 1) * 16 + swz / 64; C = (st & 1) * 32 + (swz % 64) / 2; }
__host__ __device__ __forceinline__ int perm32(int rho) { const int n = rho >> 4, i = rho & 15; return 8 * (i >> 2) + 4 * n + (i & 3); }
struct Unit { int pm, pn; };
struct Gemm { const f16* A; const f16* Bt; int M, N, K; };
struct StaticOrder {
    int nM, nN, nwg, G, c;
    __host__ __device__ __forceinline__ void init(int M, int N, int G_, int c_) { nM = M / BM; nN = N / BM; nwg = nM * nN; G = G_; c = c_; }
    __host__ __device__ __forceinline__ bool next(int i, Unit& u) const {
        const long L = (long)i * G + c; if (L >= nwg) return false;
        int wgid = (int)L; { const int q = nwg / NXCD, r = nwg % NXCD, xcd = wgid % NXCD, off = wgid / NXCD; wgid = (xcd < r ? xcd * (q + 1) : r * (q + 1) + (xcd - r) * q) + off; }
        const int nig = WGM * nN, gid = wgid / nig, fm = gid * WGM, gsz = (nM - fm) < WGM ? (nM - fm) : WGM;
        u.pm = fm + ((wgid % nig) % gsz); u.pn = (wgid % nig) / gsz; return true;
    }
    __device__ __forceinline__ void a_ready(const Unit&) const {}
    __device__ __forceinline__ void done(const Unit&) const {}
};
__device__ __forceinline__ void mma16(f32x4& c, const half8& b, const half8& a) { c = __builtin_amdgcn_mfma_f32_16x16x32_f16(b, a, c, 0, 0, 0); }
__device__ __forceinline__ void mma16(i32x4& c, const half8& b, const half8& a) { c = __builtin_amdgcn_mfma_i32_16x16x64_i8(__builtin_bit_cast(i32x4, b), __builtin_bit_cast(i32x4, a), c, 0, 0, 0); }
template <class Epi, class Sched, bool ALIGN_EPI, bool SP2>
__device__ __forceinline__ void gemm_phase(LAS unsigned char* lds, const Gemm g, const Sched& S, const Epi& E) {
    int tid = threadIdx.x; asm volatile("" : "+v"(tid));
    const int wid = __builtin_amdgcn_readfirstlane(tid >> 6), lane = tid & 63, wr = wid >> 2, wc = wid & 3, fr = lane & 15, fq = lane >> 4;
    const int K = g.K, nt = K / BK;
    unsigned voffA[2], voffB[2];
#pragma unroll
    for (int i = 0; i < 2; ++i) { int R, C; stage_rc(tid * 16 + i * 8192, R, C); const int Rb = Epi::PERM ? ((R & ~31) + perm32(R & 31)) : R;
        voffA[i] = (unsigned)(R * K + C) * 2u; voffB[i] = (unsigned)(Rb * K + C) * 2u; }
    const size_t kstep = (size_t)(BK * 2);
    const size_t hstep = (size_t)HALF * K * 2;
    const size_t tstep = 2 * hstep;
    const unsigned ldsw = (unsigned)wid * 1024u;
    const int aoff = lds_byte(wr * 64 + fr, fq * 8), boff = lds_byte(wc * 32 + fr, fq * 8);
#define PG8_SA(b, h) (((b) * 2 + (h)) * HTB)
#define PG8_SB(b, h) ((4 + (b) * 2 + (h)) * HTB)
#define PG8_STAGE(bufoff, gbase, voff) do { _Pragma("unroll") for (int _i = 0; _i < 2; ++_i) \
        __builtin_amdgcn_global_load_lds((const unsigned*)((const char*)(gbase) + (voff)[_i]), (LAS unsigned*)(lds + (bufoff) + ldsw + _i * 8192), 16, 0, 0); } while (0)
#define PG8_LDA(dst, b, h) do { _Pragma("unroll") for (int m = 0; m < 4; ++m) _Pragma("unroll") for (int k = 0; k < 2; ++k) dst[m][k] = *(const LAS half8*)(lds + PG8_SA(b, h) + aoff + m * 2048 + k * 1024); } while (0)
#define PG8_LDB(dst, b, h) do { _Pragma("unroll") for (int n = 0; n < 2; ++n) _Pragma("unroll") for (int k = 0; k < 2; ++k) dst[n][k] = *(const LAS half8*)(lds + PG8_SB(b, h) + boff + n * 2048 + k * 1024); } while (0)
#define PG8_MMA(ai, bj, At, Bt) do { __builtin_amdgcn_s_setprio(1); _Pragma("unroll") for (int m = 0; m < 4; ++m) _Pragma("unroll") for (int n = 0; n < 2; ++n) _Pragma("unroll") for (int k = 0; k < 2; ++k) \
        mma16(acc[ai][bj][m][n], Bt[n][k], At[m][k]); __builtin_amdgcn_s_setprio(0); } while (0)
#define PG8_WAIT_V(n) asm volatile("s_waitcnt vmcnt(" #n ")" ::: "memory")
#define PG8_WAIT_L(n) asm volatile("s_waitcnt lgkmcnt(" #n ")" ::: "memory")
#define PG8_BAR __builtin_amdgcn_s_barrier()
#define PG8_SCHED __builtin_amdgcn_sched_barrier(0)
    Unit cur, nxt; int ui = 0;
    if (!S.next(0, cur)) return;
    typedef typename Epi::acc_t acc_t;
    acc_t acc[2][2][4][2];
#pragma unroll
    for (int a = 0; a < 2; ++a)
#pragma unroll
        for (int b = 0; b < 2; ++b)
#pragma unroll
            for (int m = 0; m < 4; ++m)
#pragma unroll
                for (int n = 0; n < 2; ++n) acc[a][b][m][n] = (acc_t){0, 0, 0, 0};
    half8 At[4][2], B0[2][2], B1[2][2];
    const char* cA = (const char*)g.A + (size_t)cur.pm * tstep; const char* cB = (const char*)g.Bt + (size_t)cur.pn * tstep;
    S.a_ready(cur);
    if constexpr (SP2) {
        PG8_STAGE(PG8_SB(0, 0), cB, voffB); PG8_STAGE(PG8_SB(0, 1), cB + hstep, voffB); PG8_STAGE(PG8_SA(0, 0), cA, voffA); PG8_STAGE(PG8_SA(0, 1), cA + hstep, voffA);
        if (wr == 1) PG8_BAR;
        PG8_WAIT_V(2); PG8_BAR;
        PG8_STAGE(PG8_SB(1, 0), cB + kstep, voffB); PG8_STAGE(PG8_SA(1, 0), cA + kstep, voffA); PG8_STAGE(PG8_SB(1, 1), cB + hstep + kstep, voffB);
        PG8_WAIT_V(6); PG8_BAR;
    } else {
        PG8_STAGE(PG8_SB(0, 0), cB, voffB); PG8_STAGE(PG8_SA(0, 0), cA, voffA); PG8_STAGE(PG8_SB(0, 1), cB + hstep, voffB); PG8_STAGE(PG8_SA(0, 1), cA + hstep, voffA);
        if (wr == 1) PG8_BAR;
        PG8_WAIT_V(4); PG8_BAR;
        PG8_STAGE(PG8_SB(1, 0), cB + kstep, voffB); PG8_STAGE(PG8_SA(1, 0), cA + kstep, voffA); PG8_STAGE(PG8_SB(1, 1), cB + hstep + kstep, voffB);
        PG8_WAIT_V(6); PG8_BAR;
    }
    for (;;) {
        const bool has_next = S.next(ui + 1, nxt);
        const char* nA = has_next ? (const char*)g.A + (size_t)nxt.pm * tstep : cA; const char* nB = has_next ? (const char*)g.Bt + (size_t)nxt.pn * tstep : cB;
        for (int t = 0; t < nt; t += 2) {
            const bool last = (t == nt - 2);
            const char* a1 = cA + (size_t)(t + 1) * kstep;
            const char* a2 = last ? nA : cA + (size_t)(t + 2) * kstep; const char* b2 = last ? nB : cB + (size_t)(t + 2) * kstep;
            const char* a3 = a2 + kstep; const char* b3 = b2 + kstep;
            if (last && has_next) S.a_ready(nxt);
            if constexpr (Epi::MIDK) { if (t == nt / 2) E.midk(acc, cur, wr, fr); }
            if constexpr (SP2) {
            PG8_LDB(B0, 0, 0); PG8_LDB(B1, 0, 1); PG8_SCHED; PG8_LDA(At, 0, 0); PG8_STAGE(PG8_SA(1, 1), a1 + hstep, voffA);
            PG8_WAIT_V(8); PG8_WAIT_L(0); PG8_BAR; PG8_MMA(0, 0, At, B0); PG8_MMA(0, 1, At, B1); PG8_BAR; PG8_SCHED;
            PG8_LDA(At, 0, 1); PG8_STAGE(PG8_SB(0, 0), b2, voffB); PG8_STAGE(PG8_SB(0, 1), b2 + hstep, voffB); PG8_STAGE(PG8_SA(0, 0), a2, voffA);
            PG8_WAIT_V(8); PG8_WAIT_L(0); PG8_BAR; PG8_MMA(1, 0, At, B0); PG8_MMA(1, 1, At, B1); PG8_BAR; PG8_SCHED;
            PG8_LDB(B0, 1, 0); PG8_LDB(B1, 1, 1); PG8_SCHED; PG8_LDA(At, 1, 0); PG8_STAGE(PG8_SA(0, 1), a2 + hstep, voffA);
            PG8_WAIT_V(8); PG8_WAIT_L(0); PG8_BAR; PG8_MMA(0, 0, At, B0); PG8_MMA(0, 1, At, B1); PG8_BAR; PG8_SCHED;
            PG8_LDA(At, 1, 1); PG8_STAGE(PG8_SB(1, 0), b3, voffB); PG8_STAGE(PG8_SB(1, 1), b3 + hstep, voffB); PG8_STAGE(PG8_SA(1, 0), a3, voffA);
            PG8_WAIT_V(8); PG8_WAIT_L(0); PG8_BAR; PG8_MMA(1, 0, At, B0); PG8_MMA(1, 1, At, B1); PG8_BAR; PG8_SCHED;
            } else {
            PG8_LDB(B0, 0, 0); PG8_SCHED; PG8_LDA(At, 0, 0); PG8_STAGE(PG8_SA(1, 1), a1 + hstep, voffA);
            PG8_WAIT_L(8); PG8_BAR; PG8_WAIT_L(0); PG8_MMA(0, 0, At, B0); PG8_BAR; PG8_SCHED;
            PG8_LDB(B1, 0, 1); PG8_STAGE(PG8_SB(0, 0), b2, voffB);
            PG8_BAR; PG8_WAIT_L(0); PG8_MMA(0, 1, At, B1); PG8_BAR;
            PG8_LDA(At, 0, 1); PG8_STAGE(PG8_SA(0, 0), a2, voffA);
            PG8_BAR; PG8_WAIT_L(0); PG8_MMA(1, 0, At, B0); PG8_BAR; PG8_SCHED;
            PG8_STAGE(PG8_SB(0, 1), b2 + hstep, voffB);
            PG8_WAIT_V(6); PG8_BAR; PG8_MMA(1, 1, At, B1); PG8_BAR;
            PG8_LDB(B0, 1, 0); PG8_SCHED; PG8_LDA(At, 1, 0); PG8_STAGE(PG8_SA(0, 1), a2 + hstep, voffA);
            PG8_WAIT_L(8); PG8_BAR; PG8_WAIT_L(0); PG8_MMA(0, 0, At, B0); PG8_BAR; PG8_SCHED;
            PG8_LDB(B1, 1, 1); PG8_STAGE(PG8_SB(1, 0), b3, voffB);
            PG8_BAR; PG8_WAIT_L(0); PG8_MMA(0, 1, At, B1); PG8_BAR;
            PG8_LDA(At, 1, 1); PG8_STAGE(PG8_SA(1, 0), a3, voffA);
            PG8_BAR; PG8_WAIT_L(0); PG8_MMA(1, 0, At, B0); PG8_BAR; PG8_SCHED;
            PG8_STAGE(PG8_SB(1, 1), b3 + hstep, voffB);
            PG8_WAIT_V(6); PG8_BAR; PG8_MMA(1, 1, At, B1); PG8_BAR;
            }
        }
        if constexpr (ALIGN_EPI) { if (wr == 0) PG8_BAR; }
        if constexpr (!Epi::AFTER_DRAIN) { E(acc, cur, wr, wc, fr, fq); S.done(cur); }
        if (!has_next) break;
#pragma unroll
        for (int a = 0; a < 2; ++a)
#pragma unroll
            for (int b = 0; b < 2; ++b)
#pragma unroll
                for (int m = 0; m < 4; ++m)
#pragma unroll
                    for (int n = 0; n < 2; ++n) acc[a][b][m][n] = (acc_t){0, 0, 0, 0};
        cur = nxt; cA = nA; cB = nB; ++ui;
        if constexpr (ALIGN_EPI) { if (wr == 1) PG8_BAR; }
    }
    PG8_WAIT_V(0);
    if constexpr (!ALIGN_EPI) { if (wr == 0) PG8_BAR; }
    PG8_BAR;
    if constexpr (Epi::AFTER_DRAIN) { E.fused(acc, cur, wr, wc, fr, fq, lds); S.done(cur); }
#undef PG8_SA
#undef PG8_SB
#undef PG8_STAGE
#undef PG8_LDA
#undef PG8_LDB
#undef PG8_MMA
#undef PG8_WAIT_V
#undef PG8_WAIT_L
#undef PG8_BAR
#undef PG8_SCHED
}

struct EpiProjF {
    static constexpr bool PERM = true, AFTER_DRAIN = false, MIDK = false; typedef f32x4 acc_t;
    f16* P; f16* kix; float* wix; const float* rope; f16* ksbc; f16* vsbc; f16* kdsc; f16* vdsc;
    __device__ __forceinline__ void operator()(const f32x4 (&acc)[2][2][4][2], const Unit& u, int wr, int wc, int fr, int fq) const {
        const int row0 = u.pm * BM + wr * 64 + fr;
#pragma unroll
        for (int bj = 0; bj < 2; ++bj) {
            const int cbase = u.pn * BM + bj * HALF;
            if (cbase >= 5504) continue;
            const bool r128 = (cbase >= C_QDS && cbase < C_VDS) && (wc == 0);
            const bool r64 = (cbase >= C_QIX) && ((wc & 1) == 0) && (cbase != C_KIX || wc == 0);
            const float sc = (cbase < 1024 || (cbase >= C_QDS && cbase < C_KDS)) ? QSCALE : 1.f;
#pragma unroll
            for (int ai = 0; ai < 2; ++ai)
#pragma unroll
                for (int m = 0; m < 4; ++m) {
                    const int row = row0 + ai * HALF + m * 16;
                    float v[8];
#pragma unroll
                    for (int n = 0; n < 2; ++n)
#pragma unroll
                        for (int j = 0; j < 4; ++j) v[n * 4 + j] = acc[ai][bj][m][n][j];
                    if (r128) {
                        const float* rp = rope + (size_t)row * 48 + 2 * (8 * (fq & 1));
#pragma unroll
                        for (int e = 0; e < 8; ++e) { const float o = __shfl_xor(v[e], 32); const float cs = rp[2 * e], sn = rp[2 * e + 1];
                            v[e] = fq < 2 ? v[e] * cs - o * sn : v[e] * cs + o * sn; }
                    }
                    if (r64) {
                        const float* rp = rope + (size_t)row * 48 + 32;
#pragma unroll
                        for (int e = 0; e < 8; ++e) { const float o = __shfl_xor(v[e], 16); const float cs = rp[2 * e], sn = rp[2 * e + 1];
                            const float r = fq == 0 ? v[e] * cs - o * sn : v[e] * cs + o * sn; v[e] = fq < 2 ? r : v[e]; }
                    }
                    u32x4 w; w.x = pk_h2(v[0] * sc, v[1] * sc); w.y = pk_h2(v[2] * sc, v[3] * sc); w.z = pk_h2(v[4] * sc, v[5] * sc); w.w = pk_h2(v[6] * sc, v[7] * sc);
                    {
                        f16* dst = P + (size_t)row * NINP + cbase;
                        const int bb = row / SEQ, ss = row % SEQ;
                        if (cbase >= C_KSB && cbase < C_VSB) dst = ksbc + ((size_t)(bb * NH + (cbase - C_KSB) / HD) * SEQ + ss) * HD;
                        else if (cbase >= C_VSB && cbase < C_QDS) dst = vsbc + ((size_t)(bb * NH + (cbase - C_VSB) / HD) * SEQ + ss) * HD;
                        else if (cbase == C_KDS) dst = kdsc + (size_t)row * HD;
                        else if (cbase == C_VDS) dst = vdsc + (size_t)row * HD;
                        *(u32x4*)(dst + wc * 32 + 8 * fq) = w; }
                    if (cbase == C_KIX) {
                        if (wc < 2) *(u32x4*)(kix + (size_t)row * 64 + wc * 32 + 8 * fq) = w;
                        if (wc == 2 && fq < 2) { float* wp = wix + (size_t)row * 16 + 8 * fq;
                            *(f32x4*)wp = (f32x4){v[0] * IDX_SCALE, v[1] * IDX_SCALE, v[2] * IDX_SCALE, v[3] * IDX_SCALE};
                            *(f32x4*)(wp + 4) = (f32x4){v[4] * IDX_SCALE, v[5] * IDX_SCALE, v[6] * IDX_SCALE, v[7] * IDX_SCALE}; }
                    }
                }
        }
    }
};
struct EpiResidF {
    static constexpr bool PERM = false, AFTER_DRAIN = false, MIDK = false; typedef f32x4 acc_t;
    const float* base; const float* gate; float* out;
    __device__ __forceinline__ void operator()(const f32x4 (&acc)[2][2][4][2], const Unit& u, int wr, int wc, int fr, int fq) const {
        const int row0 = u.pm * BM + wr * 64 + fr, col0 = u.pn * BM + wc * 32 + 4 * fq;
        const float* gp = gate + (size_t)(u.pm / (SEQ / BM)) * MODW + col0;
        f32x4 gv[2][2];
#pragma unroll
        for (int bj = 0; bj < 2; ++bj)
#pragma unroll
            for (int n = 0; n < 2; ++n) gv[bj][n] = *(const f32x4*)(gp + bj * HALF + n * 16);
#pragma unroll
        for (int ai = 0; ai < 2; ++ai)
#pragma unroll
            for (int m = 0; m < 4; ++m) { const size_t off = (size_t)(row0 + ai * HALF + m * 16) * DM + col0;
#pragma unroll
                for (int bj = 0; bj < 2; ++bj)
#pragma unroll
                    for (int n = 0; n < 2; ++n) { const f32x4 bs = *(const f32x4*)(base + off + bj * HALF + n * 16);
                        *(f32x4*)(out + off + bj * HALF + n * 16) = bs + gv[bj][n] * acc[ai][bj][m][n]; }
                asm volatile("" ::: "memory"); }
    }
};
__device__ __forceinline__ float silu_fast(float v) { return v * __builtin_amdgcn_rcpf(1.f + __expf(-v)); }
struct EpiUpConv {
    static constexpr bool PERM = true, AFTER_DRAIN = false, MIDK = false; typedef i32x4 acc_t;
    const float* cw; const float* cb; f16* act; float* uh; const float* sa; const float* sbw;
    __device__ __forceinline__ void operator()(i32x4 (&acc)[2][2][4][2], const Unit& u, int wr, int wc, int fr_in, int fq_in) const {
        int tix = threadIdx.x; asm volatile("" : "+v"(tix));
        const int fr = tix & 15, fq = (tix >> 4) & 3; (void)fr_in; (void)fq_in;
        const int lane = fr + 16 * fq;
        int ch0 = u.pn * HALF + wc * 32 + 8 * fq;
        {
            f32x4 sbv[2][2];
#pragma unroll
            for (int gv = 0; gv < 2; ++gv)
#pragma unroll
                for (int n = 0; n < 2; ++n) sbv[gv][n] = *(const f32x4*)(sbw + gv * DFF + ch0 + 4 * n) * (2.f / 127.f);
#pragma unroll
            for (int ai = 0; ai < 2; ++ai)
#pragma unroll
                for (int m = 0; m < 4; ++m) { const float rs = sa[u.pm * BM + ai * HALF + wr * 64 + m * 16 + fr];
#pragma unroll
                    for (int gv = 0; gv < 2; ++gv)
#pragma unroll
                        for (int n = 0; n < 2; ++n) { const i32x4 t = acc[ai][gv][m][n];
                            const f32x4 f = (f32x4){(float)t.x, (float)t.y, (float)t.z, (float)t.w} * rs * sbv[gv][n]; acc[ai][gv][m][n] = __builtin_bit_cast(i32x4, f); } }
        }
#define UF(ai, gv, m, n) __builtin_bit_cast(f32x4, acc[ai][gv][m][n])
        const int src1 = (lane & 48) | ((fr - 1) & 15), src2 = (lane & 48) | ((fr - 2) & 15);
#pragma unroll
        for (int n = 0; n < 2; ++n) {
            asm volatile("" : "+v"(ch0));
            f32x4 w0[2], w1[2], w2[2], bb[2];
#pragma unroll
            for (int gv = 0; gv < 2; ++gv) { const int c = gv * DFF + ch0 + 4 * n;
                w0[gv] = *(const f32x4*)(cw + c); w1[gv] = *(const f32x4*)(cw + NUP + c); w2[gv] = *(const f32x4*)(cw + 2 * NUP + c); bb[gv] = *(const f32x4*)(cb + c); }
#pragma unroll
            for (int ai = 0; ai < 2; ++ai) {
                const int chunk = u.pm * 4 + ai * 2 + wr;
#pragma unroll
                for (int m = 0; m < 4; ++m) {
                    const int row = u.pm * BM + ai * HALF + wr * 64 + m * 16 + fr;
                    f32x4 uc[2];
#pragma unroll
                    for (int gv = 0; gv < 2; ++gv) {
                        const f32x4 cur = UF(ai, gv, m, n); const f32x4 prv = UF(ai, gv, m > 0 ? m - 1 : 0, n);
                        f32x4 p1, p2;
#pragma unroll
                        for (int j = 0; j < 4; ++j) { const float t1 = fr == 15 ? prv[j] : cur[j], t2 = fr >= 14 ? prv[j] : cur[j]; p1[j] = __shfl(t1, src1); p2[j] = __shfl(t2, src2); }
                        uc[gv] = bb[gv] + w0[gv] * p2 + w1[gv] * p1 + w2[gv] * cur;
                    }
                    if (m > 0 || fr >= 2) { u32x2 w; w.x = pk_h2(silu_fast(uc[0].x) * uc[1].x, silu_fast(uc[0].y) * uc[1].y); w.y = pk_h2(silu_fast(uc[0].z) * uc[1].z, silu_fast(uc[0].w) * uc[1].w);
                        *(u32x2*)(act + (size_t)row * DFF + ch0 + 4 * n) = w; }
                    if ((m == 0 && fr < 2) || (m == 3 && fr >= 14)) { const int slot = m == 0 ? fr : fr - 12; float* up = uh + (size_t)(chunk * 4 + slot) * NUP + ch0 + 4 * n;
#pragma unroll
                        for (int gv = 0; gv < 2; ++gv) *(f32x4*)(up + gv * DFF) = UF(ai, gv, m, n); }
                }
            }
        }
    }
#undef UF
};
template <int MODE> struct AccSel { typedef f32x4 type; };
template <> struct AccSel<0> { typedef i32x4 type; };
template <int MODE> struct EpiResidNorm {
    static constexpr bool PERM = true, AFTER_DRAIN = true, MIDK = (MODE == 1); typedef typename AccSel<MODE>::type acc_t;
    const float* base; const float* gate; const float* g; const float* shsc; float* xout; f16* h; float* xch; unsigned* cnt; const float* ssq; float* xch2; float* sa; const float* maxsh;
    __device__ __forceinline__ void midk(f32x4 (&acc)[2][2][4][2], const Unit& u, int wr, int fr) const {
#pragma unroll
        for (int ai = 0; ai < 2; ++ai)
#pragma unroll
            for (int m = 0; m < 4; ++m) { const float* sp = ssq + (size_t)(u.pm * BM + ai * HALF + wr * 64 + m * 16 + fr) * NH;
                const f32x4 s0 = *(const f32x4*)sp, s1 = *(const f32x4*)(sp + 4);
                const float rs = rsqrtf((((s0.x + s0.y) + (s0.z + s0.w)) + ((s1.x + s1.y) + (s1.z + s1.w))) * (1.f / 1024.f) + EPS);
#pragma unroll
                for (int bj = 0; bj < 2; ++bj)
#pragma unroll
                    for (int n = 0; n < 2; ++n) acc[ai][bj][m][n] *= rs; }
    }
    __device__ __forceinline__ void fused(acc_t (&acc)[2][2][4][2], const Unit& u, int wr, int wc, int fr_in, int fq_in, LAS unsigned char* lds) const {
        int tix = threadIdx.x; asm volatile("" : "+v"(tix));
        const int fr = tix & 15, fq = (tix >> 4) & 3; (void)fr_in; (void)fq_in;
        LAS float* PT = (LAS float*)(lds + XTRA_OFF);
        LAS float* ST = (LAS float*)(lds + XTRA_OFF + 4096);
        const int bt = u.pm / (SEQ / BM);
        const int row0 = u.pm * BM + wr * 64 + fr, col0 = u.pn * BM + wc * 32 + 8 * fq;
#define XF(ai, bj, m, n) __builtin_bit_cast(f32x4, acc[ai][bj][m][n])
#define XS(ai, bj, m, n, v) acc[ai][bj][m][n] = __builtin_bit_cast(acc_t, (f32x4)(v))
        if (MODE == 0) {
            f32x4 sdv[2][2];
#pragma unroll
            for (int bj = 0; bj < 2; ++bj)
#pragma unroll
                for (int n = 0; n < 2; ++n) sdv[bj][n] = *(const f32x4*)(maxsh + col0 + bj * HALF + 4 * n) * (2.f / 127.f);
#pragma unroll
            for (int ai = 0; ai < 2; ++ai)
#pragma unroll
                for (int m = 0; m < 4; ++m) { const float rsa = sa[row0 + ai * HALF + m * 16];
#pragma unroll
                    for (int bj = 0; bj < 2; ++bj)
#pragma unroll
                        for (int n = 0; n < 2; ++n) { const i32x4 t = __builtin_bit_cast(i32x4, acc[ai][bj][m][n]);
                            XS(ai, bj, m, n, ((f32x4){(float)t.x, (float)t.y, (float)t.z, (float)t.w} * rsa * sdv[bj][n])); } }
        }
        {   const float* gp = gate + (size_t)bt * MODW + col0;
            f32x4 gv[2][2];
#pragma unroll
            for (int bj = 0; bj < 2; ++bj)
#pragma unroll
                for (int n = 0; n < 2; ++n) gv[bj][n] = *(const f32x4*)(gp + bj * HALF + 4 * n);
            int tok = 0;
#pragma unroll
            for (int ai = 0; ai < 2; ++ai)
#pragma unroll
                for (int m = 0; m < 4; ++m) { const size_t off = (size_t)(row0 + ai * HALF + m * 16 + tok) * DM + col0;
#pragma unroll
                    for (int bj = 0; bj < 2; ++bj) {
                        if (MODE == 1) {
#pragma unroll
                            for (int n = 0; n < 2; ++n) XS(ai, bj, m, n, *(const f32x4*)(base + off + bj * HALF + 4 * n) + gv[bj][n] * XF(ai, bj, m, n));
                        } else {
                            const half8 b8 = *(const half8*)((const f16*)base + off + bj * HALF);
                            XS(ai, bj, m, 0, ((f32x4){(float)b8[0], (float)b8[1], (float)b8[2], (float)b8[3]} + gv[bj][0] * XF(ai, bj, m, 0)));
                            XS(ai, bj, m, 1, ((f32x4){(float)b8[4], (float)b8[5], (float)b8[6], (float)b8[7]} + gv[bj][1] * XF(ai, bj, m, 1)));
                        } }
                    asm volatile("" : "+v"(tok) : "v"(acc[ai][0][m][0].x), "v"(acc[ai][0][m][1].x), "v"(acc[ai][1][m][0].x), "v"(acc[ai][1][m][1].x) : "memory"); }
        }
#pragma unroll
        for (int ai = 0; ai < 2; ++ai)
#pragma unroll
            for (int m = 0; m < 4; ++m) { float q = 0.f;
#pragma unroll
                for (int bj = 0; bj < 2; ++bj)
#pragma unroll
                    for (int n = 0; n < 2; ++n) { const f32x4 x = XF(ai, bj, m, n); q += (x.x * x.x + x.y * x.y) + (x.z * x.z + x.w * x.w); }
                q += __shfl_xor(q, 16); q += __shfl_xor(q, 32);
                if (fq == 0) PT[(ai * HALF + wr * 64 + m * 16 + fr) * 4 + wc] = q; }
        if (MODE == 1) {
            LAS float* PT2 = (LAS float*)(lds + XTRA_OFF + 8192);
            float mxa[2][4];
#pragma unroll
            for (int ai = 0; ai < 2; ++ai)
#pragma unroll
                for (int m = 0; m < 4; ++m) mxa[ai][m] = 0.f;
#pragma unroll
            for (int bj = 0; bj < 2; ++bj) {
                f32x4 av[2];
#pragma unroll
                for (int n = 0; n < 2; ++n) { const int c = col0 + bj * HALF + 4 * n; av[n] = *(const f32x4*)(g + c) * (*(const f32x4*)(shsc + (size_t)bt * MODW + DM + c) + 1.f); }
#pragma unroll
                for (int ai = 0; ai < 2; ++ai)
#pragma unroll
                    for (int m = 0; m < 4; ++m)
#pragma unroll
                        for (int n = 0; n < 2; ++n) { const f32x4 t = __builtin_elementwise_abs(XF(ai, bj, m, n) * av[n]); mxa[ai][m] = fmaxf(mxa[ai][m], fmaxf(fmaxf(t.x, t.y), fmaxf(t.z, t.w))); }
            }
#pragma unroll
            for (int ai = 0; ai < 2; ++ai)
#pragma unroll
                for (int m = 0; m < 4; ++m) { float q = mxa[ai][m]; q = fmaxf(q, __shfl_xor(q, 16)); q = fmaxf(q, __shfl_xor(q, 32));
                    if (fq == 0) PT2[(ai * HALF + wr * 64 + m * 16 + fr) * 4 + wc] = q; }
        }
        __syncthreads();
        const int tid = threadIdx.x;
        float* slot = xch + ((size_t)u.pm * 8 + u.pn) * BM;
        if (tid < BM) { const f32x4 p4 = *(const LAS f32x4*)(PT + tid * 4); __hip_atomic_store(slot + tid, (p4.x + p4.y) + (p4.z + p4.w), __ATOMIC_RELAXED, __HIP_MEMORY_SCOPE_AGENT);
            if (MODE == 1) { const f32x4 m4 = *(const LAS f32x4*)((LAS float*)(lds + XTRA_OFF + 8192) + tid * 4);
                __hip_atomic_store(xch2 + ((size_t)u.pm * 8 + u.pn) * BM + tid, fmaxf(fmaxf(m4.x, m4.y), fmaxf(m4.z, m4.w)), __ATOMIC_RELAXED, __HIP_MEMORY_SCOPE_AGENT); } }
        asm volatile("s_waitcnt vmcnt(0)" ::: "memory");
        __syncthreads();
        if (tid == 0) {
            __hip_atomic_fetch_add(cnt + 64 * u.pm, 1u, __ATOMIC_RELAXED, __HIP_MEMORY_SCOPE_AGENT);
            unsigned sp = 0;
            while (__hip_atomic_load(cnt + 64 * u.pm, __ATOMIC_RELAXED, __HIP_MEMORY_SCOPE_AGENT) < 8u) { __builtin_amdgcn_s_sleep(1); if (++sp > (1u << 22)) break; }
        }
        __syncthreads();
        if (tid < BM) { const float* sp = xch + (size_t)u.pm * 8 * BM + tid; float tot = 0.f;
#pragma unroll
            for (int j = 0; j < 8; ++j) tot += __hip_atomic_load(sp + j * BM, __ATOMIC_RELAXED, __HIP_MEMORY_SCOPE_AGENT);
            const float rstd = rsqrtf(tot * (1.f / DM) + EPS); ST[tid] = rstd;
            if (MODE == 1) { const float* mp = xch2 + (size_t)u.pm * 8 * BM + tid; float mxr = 0.f;
#pragma unroll
                for (int j = 0; j < 8; ++j) mxr = fmaxf(mxr, __hip_atomic_load(mp + j * BM, __ATOMIC_RELAXED, __HIP_MEMORY_SCOPE_AGENT));
                const float bound = fmaxf(rstd * mxr + maxsh[bt], 1e-20f);
                ST[BM + tid] = 127.f / bound; if (u.pn == 0) sa[u.pm * BM + tid] = bound * (1.f / 127.f); } }
        __syncthreads();
#pragma unroll
        for (int bj = 0; bj < 2; ++bj) {
            f32x4 gg[2], sh[2], sc[2];
#pragma unroll
            for (int n = 0; n < 2; ++n) { const int c = col0 + bj * HALF + 4 * n; gg[n] = *(const f32x4*)(g + c);
                if (MODE == 1) { sh[n] = *(const f32x4*)(shsc + (size_t)bt * MODW + c); sc[n] = *(const f32x4*)(shsc + (size_t)bt * MODW + DM + c) + 1.f; } }
#pragma unroll
            for (int ai = 0; ai < 2; ++ai)
#pragma unroll
                for (int m = 0; m < 4; ++m) { const int rl = ai * HALF + wr * 64 + m * 16 + fr; const float rs = ST[rl]; const size_t off = (size_t)(u.pm * BM + rl) * DM + col0 + bj * HALF;
                    if (MODE == 0) {
#pragma unroll
                        for (int n = 0; n < 2; ++n) *(f32x4*)(xout + off + 4 * n) = (XF(ai, bj, m, n) * rs) * gg[n];
                    } else {
                        const f32x4 y0 = ((XF(ai, bj, m, 0) * rs) * gg[0]) * sc[0] + sh[0], y1 = ((XF(ai, bj, m, 1) * rs) * gg[1]) * sc[1] + sh[1];
                        { const f32x4 x0 = XF(ai, bj, m, 0), x1 = XF(ai, bj, m, 1); u32x4 xw; xw.x = pk_h2(x0.x, x0.y); xw.y = pk_h2(x0.z, x0.w); xw.z = pk_h2(x1.x, x1.y); xw.w = pk_h2(x1.z, x1.w);
                          *(u32x4*)((f16*)xout + off) = xw; }
                        {   const float qs = ST[BM + rl];
                            u32x2 w8; w8.x = q8x4(y0.x * qs, y0.y * qs, y0.z * qs, y0.w * qs); w8.y = q8x4(y1.x * qs, y1.y * qs, y1.z * qs, y1.w * qs);
                            *(u32x2*)((signed char*)h + off) = w8; }
                    }
                    asm volatile("" ::: "memory"); }
        }
    }
#undef XF
#undef XS
};
}


namespace att {
typedef short v4i16_t __attribute__((ext_vector_type(4)));
__device__ __forceinline__ int sw16(int row) { return ((row & 3) << 2) | ((row >> 2) & 3); }
__device__ __forceinline__ int crow(int i, int h) { return (i & 3) + 8 * (i >> 2) + 4 * h; }
__device__ __forceinline__ half4 tr_read(LAS unsigned char* p) { return __builtin_bit_cast(half4, __builtin_amdgcn_ds_read_tr16_b64_v4i16((LAS v4i16_t*)p)); }
__device__ __forceinline__ half8 cat8(half4 a, half4 b) { return __builtin_shufflevector(a, b, 0, 1, 2, 3, 4, 5, 6, 7); }
__device__ __forceinline__ half8 cvt8(const f32x16& x, int s) {
    half8 r;
#pragma unroll
    for (int j = 0; j < 8; ++j) r[j] = (f16)x[8 * s + j];
    return r;
}
struct TileRegs { u32x4 v[8]; };
template <class RowOff> __device__ __forceinline__ void tile_fetch(TileRegs& t, const unsigned char* base, RowOff roff, int lane) {
#pragma unroll
    for (int i = 0; i < 8; ++i) { const int row = (lane >> 4) + 4 * i; const unsigned off = (unsigned)roff(row) + 16u * (unsigned)(lane & 15); t.v[i] = *(const u32x4*)(base + off); }
}
__device__ __forceinline__ void tile_put(const TileRegs& t, LAS unsigned char* tile, int lane) {
#pragma unroll
    for (int i = 0; i < 8; ++i) { const int row = (lane >> 4) + 4 * i; *(LAS u32x4*)(tile + 256 * row + 16 * ((lane & 15) ^ sw16(row))) = t.v[i]; }
}
__device__ __forceinline__ void fetch_rows8(TileRegs& t, const unsigned char* base, const unsigned (&offs)[8], int lane) {
#pragma unroll
    for (int i = 0; i < 8; ++i) t.v[i] = *(const u32x4*)(base + (offs[i] + 16u * (unsigned)(lane & 15)));
}
__device__ __forceinline__ void put_rows8(const TileRegs& t, LAS unsigned char* tile, int lane) {
#pragma unroll
    for (int i = 0; i < 8; ++i) { const int row = 8 * (lane >> 4) + i; *(LAS u32x4*)(tile + 256 * row + 16 * ((lane & 15) ^ sw16(row))) = t.v[i]; }
}
__device__ __forceinline__ void sel_offs8(unsigned (&offs)[8], const LAS unsigned short* sel, int j0, int cnt) {
    const u32x4 w = *(const LAS u32x4*)(sel + j0);
    const unsigned e[8] = {w.x & 0xffffu, w.x >> 16, w.y & 0xffffu, w.y >> 16, w.z & 0xffffu, w.z >> 16, w.w & 0xffffu, w.w >> 16};
#pragma unroll
    for (int i = 0; i < 8; ++i) offs[i] = (j0 + i < cnt ? e[i] : 0u) << 8;
}
__device__ __forceinline__ f32x16 qk_tile(LAS unsigned char* ktile, const half8 (&qf)[8], int lane) {
    const int r = lane & 31, h = lane >> 5, swr = sw16(r);
    f32x16 z;
#pragma unroll
    for (int i = 0; i < 16; ++i) z[i] = 0.f;
#pragma unroll
    for (int st = 0; st < 8; ++st) { const half8 kf = *(const LAS half8*)(ktile + 256 * r + 16 * ((2 * st + h) ^ swr)); z = __builtin_amdgcn_mfma_f32_32x32x16_f16(kf, qf[st], z, 0, 0, 0); }
    return z;
}
__device__ __forceinline__ void tr_addrs(int (&va)[4][2], int lane) {
    const int q = (lane & 15) >> 2, p = lane & 3, g = lane >> 4, h = g >> 1, g1 = g & 1;
#pragma unroll
    for (int mt = 0; mt < 4; ++mt)
#pragma unroll
        for (int sec = 0; sec < 2; ++sec) { const int key = 8 * sec + 4 * h + q, sw = (q << 2) | (2 * sec + h), ch = 4 * mt + 2 * g1 + (p >> 1);
            va[mt][sec] = 256 * key + 16 * (ch ^ sw) + 8 * (p & 1); }
}
__device__ __forceinline__ void pv_tile(f32x16 (&o)[4], LAS unsigned char* vtile, const int (&va)[4][2], const half8 (&wf)[2]) {
#pragma unroll
    for (int ks = 0; ks < 2; ++ks)
#pragma unroll
        for (int mt = 0; mt < 4; ++mt) { const half8 vf = cat8(tr_read(vtile + va[mt][0] + 4096 * ks), tr_read(vtile + va[mt][1] + 4096 * ks));
            o[mt] = __builtin_amdgcn_mfma_f32_32x32x16_f16(vf, wf[ks], o[mt], 0, 0, 0); }
}

__device__ __forceinline__ void sb_item(const f16* __restrict__ P, const f16* __restrict__ ksbc, const f16* __restrict__ vsbc, f16* __restrict__ merged, float* __restrict__ ssq, LAS unsigned char* reg, int b, int hd, int qb, int lane) {
    const int c = lane & 31, h = lane >> 5, t0 = 32 * qb;
    LAS unsigned char* ktile = reg; LAS unsigned char* vtile = reg + 8192;
    half8 qf[8];
    { const f16* qp = P + (size_t)(b * SEQ + t0 + c) * NINP + C_QSB + hd * HD + 8 * h;
#pragma unroll
      for (int st = 0; st < 8; ++st) qf[st] = *(const half8*)(qp + 16 * st); }
    half8 uf[2];
#pragma unroll
    for (int ks = 0; ks < 2; ++ks)
#pragma unroll
        for (int j = 0; j < 8; ++j) uf[ks][j] = (16 * ks + 8 * (j >> 2) + 4 * h + (j & 3)) > c ? (f16)1.f : (f16)0.f;
    int va[4][2]; tr_addrs(va, lane);
    f32x16 o[4];
#pragma unroll
    for (int mt = 0; mt < 4; ++mt)
#pragma unroll
        for (int i = 0; i < 16; ++i) o[mt][i] = 0.f;
    float R = 0.f;
    const unsigned char* kbase = (const unsigned char*)(ksbc + (size_t)(b * NH + hd) * SEQ * HD);
    const unsigned char* vbase = (const unsigned char*)(vsbc + (size_t)(b * NH + hd) * SEQ * HD);
    TileRegs tk, tv;
    tile_fetch(tk, kbase, [&](int row) { return (size_t)(32 * qb + row) * (HD * 2); }, lane);
    for (int kt = qb; kt >= 0; --kt) {
        const int s0 = 32 * kt;
        tile_put(tk, ktile, lane);
        tile_fetch(tv, vbase, [&](int row) { return (size_t)(s0 + row) * (HD * 2); }, lane);
        f32x16 z = qk_tile(ktile, qf, lane);
        f32x16 l, a;
        float lsum = 0.f;
        const bool diag = (kt == qb);
#pragma unroll
        for (int i = 0; i < 16; ++i) { const float zi = z[i]; const float sp = fmaxf(zi, 0.f) + __logf(1.f + __expf(-fabsf(zi)));
            const bool ok = !diag || crow(i, h) < c;
            l[i] = ok ? -sp : 0.f; a[i] = zi - sp; lsum += l[i]; z[i] = ok ? 1.f : 0.f; }
        half8 lf[2] = {cvt8(l, 0), cvt8(l, 1)};
        f32x16 cs;
#pragma unroll
        for (int i = 0; i < 16; ++i) cs[i] = 0.f;
        cs = __builtin_amdgcn_mfma_f32_32x32x16_f16(uf[0], lf[0], cs, 0, 0, 0);
        cs = __builtin_amdgcn_mfma_f32_32x32x16_f16(uf[1], lf[1], cs, 0, 0, 0);
        f32x16 w;
#pragma unroll
        for (int i = 0; i < 16; ++i) w[i] = z[i] != 0.f ? __expf((a[i] + cs[i]) + R) : 0.f;
        half8 wf[2] = {cvt8(w, 0), cvt8(w, 1)};
        tile_put(tv, vtile, lane);
        { const int sn = 32 * (kt > 0 ? kt - 1 : 0); tile_fetch(tk, kbase, [&](int row) { return (size_t)(sn + row) * (HD * 2); }, lane); }
        pv_tile(o, vtile, va, wf);
        R += lsum + __shfl_xor(lsum, 32);
        if (__all(R < -104.f)) break;
    }
    float sq = 0.f;
#pragma unroll
    for (int mt = 0; mt < 4; ++mt)
#pragma unroll
        for (int gI = 0; gI < 4; ++gI) { const f32x16& x = o[mt]; const int i0 = 4 * gI;
            sq += (x[i0] * x[i0] + x[i0 + 1] * x[i0 + 1]) + (x[i0 + 2] * x[i0 + 2] + x[i0 + 3] * x[i0 + 3]);
            u32x2 w2; w2.x = pk_h2(x[i0], x[i0 + 1]); w2.y = pk_h2(x[i0 + 2], x[i0 + 3]);
            *(LAS u32x2*)(reg + 272 * c + 2 * (32 * mt + 8 * gI + 4 * h)) = w2; }
    sq += __shfl_xor(sq, 32);
    if (lane < 32) ssq[(size_t)(b * SEQ + t0 + c) * NH + hd] = sq;
#pragma unroll
    for (int it = 0; it < 8; ++it) { const int row = (lane >> 4) + 4 * it;
        const u32x4 v = *(const LAS u32x4*)(reg + 272 * row + 16 * (lane & 15));
        *(u32x4*)(merged + (size_t)(b * SEQ + t0 + row) * DM + hd * HD + 8 * (lane & 15)) = v; }
}

constexpr int X_HIST = 0, X_SEL = 16384, X_CVAL = 20480, X_CIDX = 22528, X_MM = 24576, X_WSM = 25600;
__device__ __forceinline__ int mbcnt64(unsigned long long m) { return __builtin_amdgcn_mbcnt_hi((unsigned)(m >> 32), __builtin_amdgcn_mbcnt_lo((unsigned)m, 0u)); }
__device__ __forceinline__ float wave_min(float v) {
#pragma unroll
    for (int o = 1; o < 64; o <<= 1) v = fminf(v, __shfl_xor(v, o));
    return v; }
__device__ __forceinline__ float wave_max(float v) {
#pragma unroll
    for (int o = 1; o < 64; o <<= 1) v = fmaxf(v, __shfl_xor(v, o));
    return v; }
__device__ __forceinline__ int binof(float v, float lo, float scale) { const int bq = (int)((v - lo) * scale); return bq > 1023 ? 1023 : bq; }
__device__ __forceinline__ bool topk_fast(const LAS float* sc, int n, float lo, float hi, LAS unsigned* hist, LAS unsigned short* sel, LAS float* cval, LAS unsigned short* cidx, LAS unsigned* ctr, int lane) {
    const float range = hi - lo;
    if (!(range > 1e-30f)) return false;
    const float scale = 512.f / range;
#pragma unroll
    for (int k = 0; k < 8; ++k) hist[lane * 8 + k] = 0u;
    if (lane < 2) ctr[lane] = 0u;
    const int nfull = n >> 8;
    for (int j = 0; j < nfull; ++j) { const f32x4 v4 = *(const LAS f32x4*)(sc + 256 * j + 4 * lane);
#pragma unroll
        for (int e = 0; e < 4; ++e) { int bq = (int)((v4[e] - lo) * scale); bq = bq > 511 ? 511 : bq; (void)__hip_atomic_fetch_add(hist + bq, 1u, __ATOMIC_RELAXED, __HIP_MEMORY_SCOPE_WORKGROUP); } }
    if ((nfull << 8) < n) { const int i0 = 256 * nfull + 4 * lane; const f32x4 v4 = *(const LAS f32x4*)(sc + i0);
#pragma unroll
        for (int e = 0; e < 4; ++e) if (i0 + e < n) { int bq = (int)((v4[e] - lo) * scale); bq = bq > 511 ? 511 : bq; (void)__hip_atomic_fetch_add(hist + bq, 1u, __ATOMIC_RELAXED, __HIP_MEMORY_SCOPE_WORKGROUP); } }
    unsigned wd[8]; int lsum = 0;
#pragma unroll
    for (int k = 0; k < 8; ++k) { wd[k] = hist[lane * 8 + k]; lsum += (int)wd[k]; }
    int incl = lsum;
#pragma unroll
    for (int d = 1; d < 64; d <<= 1) { const int t = __shfl_down(incl, d); if (lane + d < 64) incl += t; }
    const int excl = incl - lsum;
    const bool mine = (excl < TOPK) && (incl >= TOPK);
    int fb = 0, fabove = 0, fcnt = 0, run = excl; bool found = false;
#pragma unroll
    for (int k = 7; k >= 0; --k) { const int cb = (int)wd[k]; const bool hit = !found && (run + cb >= TOPK);
        if (hit) { fb = 8 * lane + k; fabove = run; fcnt = cb; found = true; } if (!found) run += cb; }
    const unsigned long long bm = __ballot(mine);
    const int src = bm ? __builtin_ctzll(bm) : 0;
    const int bstar = __shfl(fb, src), above = __shfl(fabove, src), cntb = __shfl(fcnt, src);
    const int need = TOPK - above;
    const bool all = (cntb == need);
    if (!all && cntb > 64) return false;
    const float T0 = (float)bstar, T1 = all ? T0 : (bstar == 511 ? 3.0e38f : (float)(bstar + 1));
    const unsigned selb = (unsigned)(size_t)sel, trash = (unsigned)(size_t)(cidx + 64 + lane);
    const int nblk = (n + 255) >> 8; int nsel = 0;
    for (int j = 0; j < nblk; ++j) { const int i0 = 256 * j + 4 * lane; const f32x4 v4 = *(const LAS f32x4*)(sc + i0);
        float x[4]; unsigned tk[4]; bool cd[4]; bool anyc = false;
#pragma unroll
        for (int e = 0; e < 4; ++e) { x[e] = (v4[e] - lo) * scale; const bool in = i0 + e < n; tk[e] = (in && x[e] >= T1) ? 1u : 0u; cd[e] = in && !(x[e] >= T1) && x[e] >= T0; anyc = anyc || cd[e]; }
#pragma unroll
        for (int e = 0; e < 4; ++e) { const unsigned long long bt = __ballot(tk[e] != 0u);
            const unsigned addr = tk[e] ? selb + 2u * (unsigned)(nsel + mbcnt64(bt)) : trash; *(LAS unsigned short*)(size_t)addr = (unsigned short)(i0 + e); nsel += __builtin_popcountll(bt); }
        if (__any(anyc)) {
#pragma unroll
            for (int e = 0; e < 4; ++e) if (cd[e]) { const unsigned k = __hip_atomic_fetch_add(ctr + 1, 1u, __ATOMIC_RELAXED, __HIP_MEMORY_SCOPE_WORKGROUP); cval[k] = v4[e]; cidx[k] = (unsigned short)(i0 + e); } }
    }
    if (!all) {
        const float my = lane < cntb ? cval[lane] : 0.f; const int myi = lane < cntb ? (int)cidx[lane] : 0; int rank = 0;
        for (int k = 0; k < cntb; ++k) { const float o = cval[k]; const int oi = (int)cidx[k]; rank += (o > my || (o == my && oi < myi)) ? 1 : 0; }
        const bool take = lane < cntb && rank < need;
        const unsigned long long bt = __ballot(take);
        if (take) sel[above + mbcnt64(bt)] = (unsigned short)myi;
    }
    return true;
}
__device__ __forceinline__ void topk_select(const LAS float* sc, int n, float lo, float hi, LAS unsigned* hist, LAS unsigned short* sel, LAS float* cval, LAS unsigned short* cidx, int lane) {
    int need = TOPK, mode = 2, bstar = 0; float scale = 0.f;
    const int nit = (n + 255) >> 8;
    for (int level = 0; level < 8; ++level) {
        const float range = hi - lo;
        if (!(range > 1e-30f)) { mode = 2; bstar = 0; scale = 0.f; break; }
        scale = 1024.f / range;
#pragma unroll
        for (int k = 0; k < 8; ++k) hist[lane * 8 + k] = 0u;
        for (int j = 0; j < nit; ++j) { const int i0 = 256 * j + 4 * lane; const f32x4 v4 = *(const LAS f32x4*)(sc + i0);
#pragma unroll
            for (int e = 0; e < 4; ++e) { const float v = v4[e];
                if (i0 + e < n && v >= lo && v <= hi) { const int bq = binof(v, lo, scale); (void)__hip_atomic_fetch_add(hist + (bq >> 1), 1u << (16 * (bq & 1)), __ATOMIC_RELAXED, __HIP_MEMORY_SCOPE_WORKGROUP); } } }
        unsigned wd[8]; int lsum = 0;
#pragma unroll
        for (int k = 0; k < 8; ++k) { wd[k] = hist[lane * 8 + k]; lsum += (int)(wd[k] & 0xffffu) + (int)(wd[k] >> 16); }
        int incl = lsum;
#pragma unroll
        for (int d = 1; d < 64; d <<= 1) { const int t = __shfl_down(incl, d); if (lane + d < 64) incl += t; }
        const int excl = incl - lsum;
        const bool mine = (excl < need) && (incl >= need);
        int fb = 0, fabove = 0, fcnt = 0, run = excl; bool found = false;
#pragma unroll
        for (int k = 15; k >= 0; --k) { const int cb = (int)((wd[k >> 1] >> (16 * (k & 1))) & 0xffffu); const bool hit = !found && (run + cb >= need);
            if (hit) { fb = 16 * lane + k; fabove = run; fcnt = cb; found = true; } if (!found) run += cb; }
        const unsigned long long bm = __ballot(mine);
        const int src = bm ? __builtin_ctzll(bm) : 0;
        bstar = __shfl(fb, src); const int above = __shfl(fabove, src), cntb = __shfl(fcnt, src);
        need -= above;
        if (cntb == need) { mode = 1; break; }
        if (cntb <= 64) { mode = 0; break; }
        float cl = 3.0e38f, chh = -3.0e38f;
        for (int i = lane; i < n; i += 64) { const float v = sc[i]; if (v >= lo && v <= hi && binof(v, lo, scale) == bstar) { cl = fminf(cl, v); chh = fmaxf(chh, v); } }
        lo = wave_min(cl); hi = wave_max(chh); mode = 2; bstar = 0; scale = 0.f;
    }
    int nsel = 0, ncand = 0;
    if (mode == 2) {
        for (int i0 = 0; i0 < n; i0 += 64) {
            const int i = i0 + lane; const bool in = i < n; const float v = in ? sc[i] : 0.f;
            const bool inr = in && v >= lo && v <= hi; const int bq = binof(v, lo, scale);
            const bool cand = inr && bq == bstar;
            const unsigned long long bc = __ballot(cand);
            const bool take = (in && (v > hi || (inr && bq > bstar))) || (cand && (ncand + mbcnt64(bc)) < need);
            const unsigned long long bt = __ballot(take);
            if (take) sel[nsel + mbcnt64(bt)] = (unsigned short)i;
            nsel += __builtin_popcountll(bt); ncand += __builtin_popcountll(bc);
        }
        return;
    }
    for (int j = 0; j < nit; ++j) { const int i0 = 256 * j + 4 * lane; const f32x4 v4 = *(const LAS f32x4*)(sc + i0);
#pragma unroll
        for (int e = 0; e < 4; ++e) { const float v = v4[e]; const int i = i0 + e; const bool in = i < n;
            const bool inr = in && v >= lo && v <= hi; const int bq = binof(v, lo, scale);
            const bool cand = inr && bq == bstar;
            const bool take = (in && (v > hi || (inr && bq > bstar))) || (mode == 1 && cand);
            const unsigned long long bt = __ballot(take);
            if (take) sel[nsel + mbcnt64(bt)] = (unsigned short)i;
            nsel += __builtin_popcountll(bt);
            if (mode == 0) { const unsigned long long bc = __ballot(cand);
                if (cand) { const int k = ncand + mbcnt64(bc); cval[k] = v; cidx[k] = (unsigned short)i; }
                ncand += __builtin_popcountll(bc); } } }
    if (mode == 0) {
        const float my = lane < ncand ? cval[lane] : 0.f; const int myi = lane < ncand ? (int)cidx[lane] : 0; int rank = 0;
        for (int k = 0; k < ncand; ++k) { const float o = cval[k]; const int oi = (int)cidx[k]; rank += (o > my || (o == my && oi < myi)) ? 1 : 0; }
        const bool take = lane < ncand && rank < need;
        const unsigned long long bt = __ballot(take);
        if (take) sel[nsel + mbcnt64(bt)] = (unsigned short)myi;
    }
}
template <int VAR> __device__ __forceinline__ void dsa_round(const f16* __restrict__ P, const f16* __restrict__ kdsc, const f16* __restrict__ vdsc, const f16* __restrict__ kix, const float* __restrict__ wix, const float* __restrict__ dsg, f16* __restrict__ merged,
                                          LAS unsigned char* lds, int b, int t0, int nb, int nt0, int wave, int lane_in, int flags) {
    int lane = lane_in; asm volatile("" : "+v"(lane));
    int c = lane & 31, h = lane >> 5;
    LAS float* MM = (LAS float*)(lds + XTRA_OFF + X_MM);
    LAS float* WSM = (LAS float*)(lds + XTRA_OFF + X_WSM);
    {
        half8 aix[4][4];
#pragma unroll
        for (int p = 0; p < 4; ++p) {
            const int query = t0 + 2 * p + ((c >> 2) & 1), head = (c & 3) + 4 * (c >> 3);
            const f16* ap = P + (size_t)(b * SEQ + query) * NINP + C_QIX + head * IXD + 8 * h;
#pragma unroll
            for (int st = 0; st < 4; ++st) aix[p][st] = *(const half8*)(ap + 16 * st);
        }
        float wv[4][16];
#pragma unroll
        for (int p = 0; p < 4; ++p) { const float* wp = wix + (size_t)(b * SEQ + t0 + 2 * p + h) * 16;
#pragma unroll
            for (int i4 = 0; i4 < 4; ++i4) { const f32x4 w4 = *(const f32x4*)(wp + 4 * i4); wv[p][4 * i4] = 0.5f * w4.x; wv[p][4 * i4 + 1] = 0.5f * w4.y; wv[p][4 * i4 + 2] = 0.5f * w4.z; wv[p][4 * i4 + 3] = 0.5f * w4.w; } }
        float mn[4], mx[4];
#pragma unroll
        for (int p = 0; p < 4; ++p) { mn[p] = 3.0e38f; mx[p] = -3.0e38f; }
        const int ntile = (t0 + 8 + 31) >> 5;
        half8 kf[4], kn[4];
        const f16* kp0 = kix + (size_t)(b * SEQ + c) * IXD + 8 * h;
        auto kload = [&](half8 (&dst)[4], int jt) {
#pragma unroll
            for (int st = 0; st < 4; ++st) dst[st] = *(const half8*)(kp0 + (unsigned)(32 * jt * IXD + 16 * st)); };
        auto body = [&](const half8 (&kk)[4], int jt) {
            f32x16 acc[4];
#pragma unroll
            for (int p = 0; p < 4; ++p)
#pragma unroll
                for (int i = 0; i < 16; ++i) acc[p][i] = 0.f;
#pragma unroll
            for (int st = 0; st < 4; ++st)
#pragma unroll
                for (int p = 0; p < 4; ++p) acc[p] = __builtin_amdgcn_mfma_f32_32x32x16_f16(aix[p][st], kk[st], acc[p], 0, 0, 0);
#pragma unroll
            for (int p = 0; p < 4; ++p) {
                float scv = 0.f;
#pragma unroll
                for (int i = 0; i < 16; ++i) scv = __builtin_fmaf(wv[p][i], acc[p][i] + __builtin_fabsf(acc[p][i]), scv);
                *(LAS float*)(lds + (2 * p + h) * 16384 + 4 * (32 * jt + c)) = scv;
                mn[p] = fminf(mn[p], scv); mx[p] = fmaxf(mx[p], scv);
            } };
        const int jlast = ntile - 1;
        kload(kf, wave < jlast ? wave : jlast);
        if (!(flags & 16)) for (int jt = wave; jt < ntile; jt += 2 * NWAVES) {
            const int j1 = jt + NWAVES < jlast ? jt + NWAVES : jlast, j2 = jt + 2 * NWAVES < jlast ? jt + 2 * NWAVES : jlast;
            kload(kn, j1);
            __builtin_amdgcn_sched_barrier(0);
            body(kf, jt);
            kload(kf, j2);
            __builtin_amdgcn_sched_barrier(0);
            body(kn, j1);

        }
#pragma unroll
        for (int p = 0; p < 4; ++p) {
#pragma unroll
            for (int o = 1; o < 32; o <<= 1) { mn[p] = fminf(mn[p], __shfl_xor(mn[p], o)); mx[p] = fmaxf(mx[p], __shfl_xor(mx[p], o)); }
            if (c == 0) { MM[(wave * 8 + 2 * p + h) * 2] = mn[p]; MM[(wave * 8 + 2 * p + h) * 2 + 1] = mx[p]; }
        }
    }
    __syncthreads();
    if (flags & 8) { __syncthreads(); return; }
    const int t = t0 + wave, n = t + 1;
    LAS unsigned char* reg = lds + wave * 16384;
    LAS unsigned short* sel = (LAS unsigned short*)(lds + XTRA_OFF + X_SEL + wave * 512);
    int cnt;
    if (n <= TOPK) { for (int i = lane; i < n; i += 64) sel[i] = (unsigned short)i; cnt = n; }
    else { cnt = TOPK;
        float lo = 3.0e38f, hi = -3.0e38f;
#pragma unroll
        for (int w = 0; w < NWAVES; ++w) { lo = fminf(lo, MM[(w * 8 + wave) * 2]); hi = fmaxf(hi, MM[(w * 8 + wave) * 2 + 1]); }
        LAS unsigned* hist = (LAS unsigned*)(lds + XTRA_OFF + X_HIST + wave * 2048); LAS float* cval = (LAS float*)(lds + XTRA_OFF + X_CVAL + wave * 256);
        LAS unsigned short* cidx = (LAS unsigned short*)(lds + XTRA_OFF + X_CIDX + wave * 256);
        if (!topk_fast((const LAS float*)reg, n, lo, hi, hist, sel, cval, cidx, (LAS unsigned*)(lds + XTRA_OFF + X_WSM + wave * 8), lane))
            topk_select((const LAS float*)reg, n, lo, hi, hist, sel, cval, cidx, lane); }
    if (flags & 4) { __syncthreads(); return; }
    asm volatile("" : "+v"(lane));
    const int cc = lane & 15, g = lane >> 4;
    LAS unsigned char* ktile = reg; LAS unsigned char* vtile = reg + 8192;
    half8 qf[4];
    { const f16* qp = P + (size_t)(b * SEQ + t) * NINP + C_QDS + (cc & 7) * HD + 8 * g;
#pragma unroll
      for (int st = 0; st < 4; ++st) { half8 v = *(const half8*)(qp + 32 * st);
#pragma unroll
          for (int j = 0; j < 8; ++j) v[j] = cc < 8 ? v[j] : (f16)0.f;
          qf[st] = v; } }
    int ka[4], va[8];
    { const int swr = sw16(cc);
#pragma unroll
      for (int st = 0; st < 4; ++st) ka[st] = 256 * cc + 16 * ((4 * st + g) ^ swr);
      const int q = cc >> 2, p = cc & 3, swk = (q << 2) | g;
#pragma unroll
      for (int mt = 0; mt < 8; ++mt) va[mt] = 256 * (4 * g + q) + 16 * ((2 * mt + (p >> 1)) ^ swk) + 8 * (p & 1); }
    f32x4 o[8];
#pragma unroll
    for (int mt = 0; mt < 8; ++mt) o[mt] = (f32x4){0.f, 0.f, 0.f, 0.f};
    float mrun = -1.0e30f, lrun = 0.f;
    const unsigned char* kbase = (const unsigned char*)(kdsc + (size_t)(b * SEQ) * HD);
    const unsigned char* vbase = (const unsigned char*)(vdsc + (size_t)(b * SEQ) * HD);
    const int nch = (cnt + 31) >> 5;
    TileRegs tk, tv;
    unsigned offs[8];
    sel_offs8(offs, sel, 8 * g, cnt);
    fetch_rows8(tk, kbase, offs, lane);
    for (int ch = 0; ch < nch; ++ch) {
        put_rows8(tk, ktile, lane);
        fetch_rows8(tv, vbase, offs, lane);
        f32x4 z0 = {0.f, 0.f, 0.f, 0.f}, z1 = z0;
#pragma unroll
        for (int st = 0; st < 4; ++st) {
            const half8 k0 = *(const LAS half8*)(ktile + ka[st]), k1 = *(const LAS half8*)(ktile + ka[st] + 4096);
            z0 = __builtin_amdgcn_mfma_f32_16x16x32_f16(k0, qf[st], z0, 0, 0, 0);
            z1 = __builtin_amdgcn_mfma_f32_16x16x32_f16(k1, qf[st], z1, 0, 0, 0); }
        float mx = -1.0e30f;
#pragma unroll
        for (int r = 0; r < 4; ++r) { if (32 * ch + 4 * g + r >= cnt) z0[r] = -1.0e30f; if (32 * ch + 16 + 4 * g + r >= cnt) z1[r] = -1.0e30f; mx = fmaxf(mx, fmaxf(z0[r], z1[r])); }
        if (__any(mx > mrun + 8.f)) {
            mx = fmaxf(mx, __shfl_xor(mx, 16)); mx = fmaxf(mx, __shfl_xor(mx, 32));
            const float mnew = fmaxf(mrun, mx), alpha = __expf(mrun - mnew);
            lrun *= alpha; mrun = mnew;
#pragma unroll
            for (int mt = 0; mt < 8; ++mt) o[mt] *= alpha;
        }
        half8 pf;
#pragma unroll
        for (int r = 0; r < 4; ++r) { const float p0 = __expf(z0[r] - mrun), p1 = __expf(z1[r] - mrun); lrun += p0 + p1; pf[r] = (f16)p0; pf[4 + r] = (f16)p1; }
        put_rows8(tv, vtile, lane);
        { const int chn = ch + 1 < nch ? ch + 1 : ch; sel_offs8(offs, sel, 32 * chn + 8 * g, cnt); fetch_rows8(tk, kbase, offs, lane); }
#pragma unroll
        for (int mt = 0; mt < 8; ++mt) { const half8 vf = cat8(tr_read(vtile + va[mt]), tr_read(vtile + va[mt] + 4096));
            o[mt] = __builtin_amdgcn_mfma_f32_16x16x32_f16(vf, pf, o[mt], 0, 0, 0); }
    }
    lrun += __shfl_xor(lrun, 16); lrun += __shfl_xor(lrun, 32);
    const float inv = 1.f / lrun;
    float sq = 0.f;
#pragma unroll
    for (int mt = 0; mt < 8; ++mt) { o[mt] *= inv; sq += (o[mt].x * o[mt].x + o[mt].y * o[mt].y) + (o[mt].z * o[mt].z + o[mt].w * o[mt].w); }
    sq = cc < 8 ? sq : 0.f;
    const float rstd = rsqrtf(wave_sum(sq) * (1.f / 1024.f) + EPS);
    if (cc < 8) {
#pragma unroll
        for (int mt = 0; mt < 8; ++mt) { const int d = 16 * mt + 4 * g; const f32x4 gg = *(const f32x4*)(dsg + cc * HD + d);
            u32x2 w2; w2.x = pk_h2(o[mt].x * rstd * gg.x, o[mt].y * rstd * gg.y); w2.y = pk_h2(o[mt].z * rstd * gg.z, o[mt].w * rstd * gg.w);
            *(u32x2*)(merged + (size_t)(b * SEQ + t) * DM + 1024 + cc * HD + d) = w2; }
    }
    if (nt0 >= 0) {
        int nb2 = nb, nt2 = nt0; asm volatile("" : "+s"(nb2), "+s"(nt2));
        int tid2 = threadIdx.x; asm volatile("" : "+v"(tid2)); const f16* rowp = P + (size_t)(nb2 * SEQ + nt2 + (tid2 >> 5 & 7)) * NINP;
        const void* src = tid2 < 256 ? (const void*)(rowp + C_QIX + (tid2 & 31) * 32) : (const void*)(rowp + C_QDS + (tid2 & 31) * 32);
        __builtin_amdgcn_global_load_lds((const unsigned*)src, (LAS unsigned*)(lds + XTRA_OFF + 26624 + (tid2 >> 6) * 0), 4, 0, 0);
        if (tid2 < 32) __builtin_amdgcn_global_load_lds((const unsigned*)(wix + (size_t)(nb2 * SEQ + nt2) * 16 + tid2 * 4), (LAS unsigned*)(lds + XTRA_OFF + 26624 + 256), 4, 0, 0);
    }
    __syncthreads();
}
}

#define XB_TMO      128
#define XB_XCNT(j)  (256  + 64 * (j))
#define XB_XSUB(j)  (1280 + 64 * (j))
#define XB_XGEN(j)  (2304 + 64 * (j))
#define XB_TOP      3328
#define XB_TOPGEN   3392
#define XCD_BAR_WORDS 3456
#define XB_SPIN_CAP (1u << 18)
__device__ __forceinline__ unsigned xb_ld(unsigned* p)              { return __hip_atomic_load(p, __ATOMIC_RELAXED, __HIP_MEMORY_SCOPE_AGENT); }
__device__ __forceinline__ unsigned xb_add(unsigned* p, unsigned v) { return __hip_atomic_fetch_add(p, v, __ATOMIC_RELAXED, __HIP_MEMORY_SCOPE_AGENT); }
__device__ __forceinline__ unsigned xb_xcc_id() { return (unsigned)__builtin_amdgcn_s_getreg((3 << 11) | 20) & 0xFu; }
#define XB_SPIN(cond, bar) do { unsigned _sp = 0; while (cond) { __builtin_amdgcn_s_sleep(1); \
    if ((++_sp & 255u) == 0u) { if (xb_ld(&(bar)[XB_TMO])) break; if (_sp > XB_SPIN_CAP) { atomicAdd(&(bar)[XB_TMO], 1u); break; } } } } while (0)
struct XcdBarrier { unsigned* bar; unsigned x; volatile LAS unsigned* st; };
__device__ __forceinline__ XcdBarrier xcd_barrier_post(unsigned* bar, volatile LAS unsigned* st) {
    XcdBarrier b; b.bar = bar; b.x = xb_xcc_id(); b.st = st;
    if (threadIdx.x == 0) (void)xb_add(&bar[XB_XCNT(b.x)], 1u);
    return b;
}
__device__ __forceinline__ void xcd_barrier_complete(unsigned* bar, unsigned x, unsigned& nloc, unsigned& nx) {
    const unsigned G = gridDim.x * gridDim.y * gridDim.z;
    unsigned sum, cnt, mine, sp = 0u;
    for (;;) {
        sum = 0u; cnt = 0u; mine = 0u;
#pragma unroll
        for (unsigned j = 0; j < 16; ++j) { const unsigned c = xb_ld(&bar[XB_XCNT(j)]); sum += c; cnt += (c > 0u) ? 1u : 0u; mine = (j == x) ? c : mine; }
        if (sum == G) break;
        __builtin_amdgcn_s_sleep(1);
        if ((++sp & 255u) == 0u) { if (xb_ld(&bar[XB_TMO])) break; if (sp > XB_SPIN_CAP) { atomicAdd(&bar[XB_TMO], 1u); break; } }
    }
    nloc = mine > 0u ? mine : 1u; nx = cnt > 0u ? cnt : 1u;
}
__device__ __forceinline__ void xcd_barrier(const XcdBarrier& b) {
    asm volatile("s_waitcnt vmcnt(0)" ::: "memory");
    __syncthreads();
    if (threadIdx.x == 0) {
        unsigned* bar = b.bar;
        __builtin_amdgcn_s_waitcnt(0);
        unsigned nloc = b.st[0], nx = b.st[1];
        if (nloc == 0u) { xcd_barrier_complete(bar, b.x, nloc, nx); b.st[0] = nloc; b.st[1] = nx; }
        const unsigned old = xb_add(&bar[XB_XSUB(b.x)], 1u);
        const unsigned gen = old / nloc;
        if (old + 1u == (gen + 1u) * nloc) {
            __builtin_amdgcn_fence(__ATOMIC_RELEASE, "agent");
            asm volatile("s_waitcnt vmcnt(0)" ::: "memory");
            const unsigned og = xb_add(&bar[XB_TOP], 1u);
            const unsigned tg = og / nx;
            if (og + 1u == (tg + 1u) * nx) xb_add(&bar[XB_TOPGEN], 1u);
            else XB_SPIN(xb_ld(&bar[XB_TOPGEN]) == tg, bar);
            __builtin_amdgcn_fence(__ATOMIC_ACQUIRE, "agent");
            xb_add(&bar[XB_XGEN(b.x)], 1u);
            asm volatile("s_waitcnt vmcnt(0)" ::: "memory");
        } else {
            XB_SPIN(xb_ld(&bar[XB_XGEN(b.x)]) == gen, bar);
            __builtin_amdgcn_fence(__ATOMIC_ACQUIRE, "agent");
            asm volatile("s_waitcnt vmcnt(0)" ::: "memory");
        }
    }
    __syncthreads();
}

struct Args {
    const float* x; const float* c; const int* pos; const float* w_ada; const float* b_ada; const float* n1g; const float* w_in; const float* sbg; const float* dsg;
    const float* w_out; const float* n2g; const float* w_up; const float* conv_w; const float* conv_b; const float* w_down; const float* fng;
    float* out; unsigned char* ws; int ph_lo, ph_hi, region, pad;
};

struct TrItem { const float* W; f16* WT; const float* gk; const float* q8; int K, N, k0, n0, up, pitch; };
__device__ __forceinline__ TrItem tr_decode(const Args& a, int r, bool fold) {
    constexpr int NB_IN = NINP / 32, I_IN = (DM / 64) * (NINP / 32), I_OUT = (DM / 64) * (DM / 32), I_UP = (DM / 64) * (NUP / 32);
    TrItem t; int nblk;
    t.gk = nullptr; t.q8 = nullptr; t.pitch = 0;
    if (r < I_IN) { t.W = a.w_in; t.WT = (f16*)(a.ws + WS_WTIN); t.K = DM; t.N = NIN; nblk = NB_IN; t.up = 0; }
    else if ((r -= I_IN) < I_OUT) { t.W = a.w_out; t.WT = (f16*)(a.ws + WS_WTOUT); t.K = DM; t.N = DM; nblk = DM / 32; t.up = 0; t.gk = fold ? a.sbg : nullptr; }
    else if ((r -= I_OUT) < I_UP) { t.W = a.w_up; t.WT = (f16*)(a.ws + WS_WTUP); t.K = DM; t.N = NUP; nblk = NUP / 32; t.up = 1; t.q8 = (const float*)((const unsigned*)(a.ws + WS_CTL) + CW_SBMAX); }
    else { r -= I_UP; t.W = a.w_down; t.WT = (f16*)(a.ws + WS_WTDN); t.K = DFF; t.N = DM; nblk = DM / 32; t.up = 0; t.q8 = (const float*)((const unsigned*)(a.ws + WS_CTL) + CW_SDMAX); t.pitch = DFFP; }
    t.k0 = 64 * (r / nblk); t.n0 = 32 * (r % nblk); return t;
}
__device__ __forceinline__ void tr_load(const TrItem& t, f32x4 (&v)[8], int lane) {
    const int n = t.n0 + 4 * (lane & 7); const bool ok = n < t.N;
    const float* p = t.W + (size_t)(t.k0 + (lane >> 3)) * t.N + (ok ? n : 0);
#pragma unroll
    for (int i = 0; i < 8; ++i) { const f32x4 x = __builtin_nontemporal_load((const f32x4*)(p + (size_t)(8 * i) * t.N)); v[i] = ok ? x : (f32x4){0.f, 0.f, 0.f, 0.f}; }
}
__device__ __forceinline__ void tr_store(const TrItem& t, const f32x4 (&v)[8], LAS float* scr, int lane) {
#pragma unroll
    for (int i = 0; i < 8; ++i) { LAS float* d = scr + ((lane >> 3) + 8 * i) * 33 + 4 * (lane & 7); d[0] = v[i].x; d[1] = v[i].y; d[2] = v[i].z; d[3] = v[i].w; }
    asm volatile("s_waitcnt lgkmcnt(0)" ::: "memory");
    const int c = lane & 7;
    f32x4 g0 = {1.f, 1.f, 1.f, 1.f}, g1 = g0;
    if (t.gk && t.k0 < 1024) { g0 = *(const f32x4*)(t.gk + t.k0 + 8 * c); g1 = *(const f32x4*)(t.gk + t.k0 + 8 * c + 4); }
#pragma unroll
    for (int j = 0; j < 4; ++j) { const int nn = (lane >> 3) + 8 * j; const LAS float* sp = scr + (8 * c) * 33 + nn;
        int n = t.n0 + nn;
        if (t.q8) {
            const float inv = 63.5f * __builtin_amdgcn_rcpf(fmaxf(t.q8[n], 1e-20f));
            u32x2 o; o.x = q8x4(sp[0 * 33] * inv, sp[1 * 33] * inv, sp[2 * 33] * inv, sp[3 * 33] * inv); o.y = q8x4(sp[4 * 33] * inv, sp[5 * 33] * inv, sp[6 * 33] * inv, sp[7 * 33] * inv);
            if (t.up) n = n < DFF ? (n / 128) * 256 + (n % 128) : ((n - DFF) / 128) * 256 + 128 + ((n - DFF) % 128);
            *(u32x2*)((unsigned char*)t.WT + (size_t)n * (t.pitch ? t.pitch : t.K) + t.k0 + 8 * c) = o;
        } else {
        u32x4 o; o.x = pk_h2(sp[0 * 33] * g0.x, sp[1 * 33] * g0.y); o.y = pk_h2(sp[2 * 33] * g0.z, sp[3 * 33] * g0.w); o.z = pk_h2(sp[4 * 33] * g1.x, sp[5 * 33] * g1.y); o.w = pk_h2(sp[6 * 33] * g1.z, sp[7 * 33] * g1.w);
        if (t.up) n = n < DFF ? (n / 128) * 256 + (n % 128) : ((n - DFF) / 128) * 256 + 128 + ((n - DFF) % 128);
        *(u32x4*)(t.WT + (size_t)n * t.K + t.k0 + 8 * c) = o; } }
    asm volatile("s_waitcnt lgkmcnt(0)" ::: "memory");
}
constexpr int ADA_KC = 32, ADA_ROWS = DM / ADA_KC;
__device__ __forceinline__ void p0_ada_item(const float* __restrict__ w_ada, const float* __restrict__ b_ada, const LAS float* sil, float* __restrict__ modp, float* __restrict__ mod, unsigned* cnt, int item, int lane) {
    const int kc = item / 48, jc = item % 48, j0 = jc * 256 + lane * 4;
    f32x4 a0 = {0.f, 0.f, 0.f, 0.f}, a1 = {0.f, 0.f, 0.f, 0.f};
    const float* wp = w_ada + (size_t)(kc * ADA_ROWS) * MODW + j0;
#pragma unroll 32
    for (int k = 0; k < ADA_ROWS; ++k) { const f32x4 w = __builtin_nontemporal_load((const f32x4*)(wp + (size_t)k * MODW)); const float s0 = sil[kc * ADA_ROWS + k], s1 = sil[DM + kc * ADA_ROWS + k]; a0 += w * s0; a1 += w * s1; }
    { float* p0 = modp + (size_t)(kc * 2 + 0) * MODW + j0; float* p1 = modp + (size_t)(kc * 2 + 1) * MODW + j0;
#pragma unroll
      for (int e = 0; e < 4; ++e) { __hip_atomic_store(p0 + e, a0[e], __ATOMIC_RELAXED, __HIP_MEMORY_SCOPE_AGENT); __hip_atomic_store(p1 + e, a1[e], __ATOMIC_RELAXED, __HIP_MEMORY_SCOPE_AGENT); } }
    asm volatile("s_waitcnt vmcnt(0)" ::: "memory");
    unsigned old = 0u;
    if (lane == 0) old = __hip_atomic_fetch_add(cnt + 64 * jc, 1u, __ATOMIC_RELAXED, __HIP_MEMORY_SCOPE_AGENT);
    old = (unsigned)__builtin_amdgcn_readfirstlane((int)old);
    if (old == (unsigned)(ADA_KC - 1)) {
        const f32x4 bias = *(const f32x4*)(b_ada + j0);
        f32x4 s0 = bias, s1 = bias;
#pragma unroll 4
        for (int k2 = 0; k2 < ADA_KC; ++k2) { const float* p0 = modp + (size_t)(k2 * 2 + 0) * MODW + j0; const float* p1 = modp + (size_t)(k2 * 2 + 1) * MODW + j0;
#pragma unroll
            for (int e = 0; e < 4; ++e) { s0[e] += __hip_atomic_load(p0 + e, __ATOMIC_RELAXED, __HIP_MEMORY_SCOPE_AGENT); s1[e] += __hip_atomic_load(p1 + e, __ATOMIC_RELAXED, __HIP_MEMORY_SCOPE_AGENT); } }
        *(f32x4*)(mod + j0) = s0; *(f32x4*)(mod + MODW + j0) = s1;
    }
}
__device__ __forceinline__ void tr_run(const Args& a, LAS float* scr, int base, int it0, int stride, int cnt, int lane, bool fold) {
    if (cnt <= 0) return;
    f32x4 v0[8], v1[8], v2[8];
    TrItem c0 = tr_decode(a, base + it0, fold), c1 = c0, c2 = c0;
    tr_load(c0, v0, lane);
    if (cnt > 1) { c1 = tr_decode(a, base + it0 + stride, fold); tr_load(c1, v1, lane); }
    for (int q = 0; q < cnt; ++q) {
        if (q + 2 < cnt) { c2 = tr_decode(a, base + it0 + (q + 2) * stride, fold); tr_load(c2, v2, lane); }
        tr_store(c0, v0, scr, lane);
        c0 = c1; c1 = c2;
#pragma unroll
        for (int i = 0; i < 8; ++i) { v0[i] = v1[i]; v1[i] = v2[i]; }
    }
}
constexpr int UP_DEFER = 4992;
constexpr int TR_I_IN = (DM / 64) * (NINP / 32), TR_I_OUT = (DM / 64) * (DM / 32), TR_I_UP = (DM / 64) * (NUP / 32), TR_I_DN = (DFF / 64) * (DM / 32);
__device__ __forceinline__ void tr_deferred(const Args& a, LAS unsigned char* lds, int base, int nitems, int nwg, int G, int wave, int lane) {
    const int busy = nwg % G;
    const int nidle = busy ? G - busy : G, me = busy ? (int)blockIdx.x - busy : (int)blockIdx.x;
    if (me < 0) return;
    const int it0 = me * NWAVES + wave, stride = nidle * NWAVES;
    tr_run(a, (LAS float*)(lds + wave * 16384), base, it0, stride, (nitems - it0 + stride - 1) / stride, lane, false);
}
__device__ __forceinline__ void phase0(const Args& a, LAS unsigned char* lds, int vcu, int G, int wave, int lane, bool fold) {
    unsigned char* ws = a.ws;
    LAS float* sil = (LAS float*)(lds + XTRA_OFF);
    for (int e = threadIdx.x; e < BATCH * DM; e += NWAVES * 64) sil[e] = silu_f(a.c[e]);
    __syncthreads();
    LAS float* scr = (LAS float*)(lds + wave * 16384);
    const int gw = vcu * NWAVES + wave, NGW = G * NWAVES;
    float* modp = (float*)(ws + WS_MODP);
    constexpr int NADA = ADA_KC * 48, HW = 6, HS = 2, NITEMS = TR_I_IN + TR_I_OUT;
    if (wave < HW) for (int it = vcu * HW + wave; it < NADA; it += G * HW) p0_ada_item(a.w_ada, a.b_ada, sil, modp, (float*)(ws + WS_MOD), (unsigned*)(ws + WS_CTL) + CW_ADA, it, lane);
    const int nheavy = G * HW, nlight = G * (NWAVES - HW);
    const int nh_items = nheavy * HS < NITEMS ? nheavy * HS : NITEMS;
    int it0, stride, cnt;
    if (wave < HW) { it0 = (NITEMS - nh_items) + (vcu * HW + wave) * HS; stride = 1; cnt = HS; if (it0 + cnt > NITEMS) cnt = NITEMS - it0 > 0 ? NITEMS - it0 : 0; }
    else { it0 = vcu * (NWAVES - HW) + (wave - HW); stride = nlight; cnt = (NITEMS - nh_items - it0 + stride - 1) / stride; if (cnt < 0) cnt = 0; }
    tr_run(a, scr, 0, it0, stride, cnt, lane, fold);
    { unsigned* sbmax = (unsigned*)(ws + WS_CTL) + CW_SBMAX;
      for (int e = (vcu * NWAVES + wave) * 64 + lane; e < NUP * 16; e += NGW * 64) { const int n = e % NUP, rg = e / NUP; float mx = 0.f;
#pragma unroll
          for (int k = 0; k < 8; ++k) mx = fmaxf(mx, fabsf(a.w_up[(size_t)(rg * 8 + k) * NUP + n]));
          (void)__hip_atomic_fetch_max(sbmax + n, __builtin_bit_cast(unsigned, mx), __ATOMIC_RELAXED, __HIP_MEMORY_SCOPE_AGENT); } }
    { unsigned* sdmax = (unsigned*)(ws + WS_CTL) + CW_SDMAX;
      for (int e = (vcu * NWAVES + wave) * 64 + lane; e < DM * 16; e += NGW * 64) { const int n = e % DM, rg = e / DM; float mx = 0.f;
#pragma unroll
          for (int k = 0; k < 8; ++k) mx = fmaxf(mx, fabsf(a.w_down[(size_t)(rg * 8 + k) * DM + n]));
          (void)__hip_atomic_fetch_max(sdmax + n, __builtin_bit_cast(unsigned, mx), __ATOMIC_RELAXED, __HIP_MEMORY_SCOPE_AGENT); } }
    float* rope = (float*)(ws + WS_ROPE);
    for (int idx = (vcu * NWAVES + wave) * 64 + lane; idx < MTOK * 24; idx += NGW * 64) {
        const int m = idx / 24, i = idx % 24;
        const float inv = i < 16 ? INV128[i] : INV64[i - 16];
        const float ang = (float)a.pos[m] * inv;
        const double rev = (double)ang * 0.15915494309189535;
        const float r = (float)((rev - floor(rev)) * 6.283185307179586);
        *(float2*)(rope + (size_t)idx * 2) = make_float2(cosf(r), sinf(r));
    }
}
__device__ __forceinline__ void hrows(const float* __restrict__ x, const float* __restrict__ g, const LAS float* S1, f16* __restrict__ H, int gw, int NGW, int lane) {
    for (int m0 = gw; m0 < MTOK; m0 += 2 * NGW) {
        const int m1 = m0 + NGW < MTOK ? m0 + NGW : m0;
        f32x4 v[2][8];
#pragma unroll
        for (int r = 0; r < 2; ++r) { const f32x4* xr = (const f32x4*)(x + (size_t)(r ? m1 : m0) * DM) + lane;
#pragma unroll
            for (int j = 0; j < 8; ++j) v[r][j] = __builtin_nontemporal_load(xr + 64 * j); }
#pragma unroll
        for (int r = 0; r < 2; ++r) {
            const int m = r ? m1 : m0; const int b = m / SEQ;
            float ss = 0.f;
#pragma unroll
            for (int j = 0; j < 8; ++j) ss += (v[r][j].x * v[r][j].x + v[r][j].y * v[r][j].y) + (v[r][j].z * v[r][j].z + v[r][j].w * v[r][j].w);
            const float rstd = rsqrtf(wave_sum(ss) * (1.f / DM) + EPS);
            u32x2* o8 = (u32x2*)(H + (size_t)m * DM) + lane;
#pragma unroll
            for (int j = 0; j < 8; ++j) { const int k = 4 * (lane + 64 * j);
                const f32x4 gg = *(const f32x4*)(g + k); const f32x4 sh = *(const LAS f32x4*)(S1 + b * 4096 + k), sc = *(const LAS f32x4*)(S1 + b * 4096 + 2048 + k);
                const f32x4 y = ((v[r][j] * rstd) * gg) * (sc + 1.f) + sh;
                u32x2 w; w.x = pk_h2(y.x, y.y); w.y = pk_h2(y.z, y.w); o8[64 * j] = w; }
        }
    }
}
__device__ __forceinline__ void hrows1(const float* __restrict__ x, const float* __restrict__ g, const LAS float* S1, f16* __restrict__ H, int gw, int NGW, int lane) {
    for (int m = gw; m < MTOK; m += NGW) {
        const int b = m / SEQ;
        const f32x4* xr = (const f32x4*)(x + (size_t)m * DM) + lane;
        f32x4 v[8]; float ss = 0.f;
#pragma unroll
        for (int j = 0; j < 8; ++j) { v[j] = xr[64 * j]; ss += (v[j].x * v[j].x + v[j].y * v[j].y) + (v[j].z * v[j].z + v[j].w * v[j].w); }
        const float rstd = rsqrtf(wave_sum(ss) * (1.f / DM) + EPS);
        u32x2* o8 = (u32x2*)(H + (size_t)m * DM) + lane;
#pragma unroll
        for (int j = 0; j < 8; ++j) { const int k = 4 * (lane + 64 * j);
            const f32x4 gg = *(const f32x4*)(g + k); const f32x4 sh = *(const LAS f32x4*)(S1 + b * 4096 + k), sc = *(const LAS f32x4*)(S1 + b * 4096 + 2048 + k);
            const f32x4 y = ((v[j] * rstd) * gg) * (sc + 1.f) + sh;
            u32x2 w; w.x = pk_h2(y.x, y.y); w.y = pk_h2(y.z, y.w); o8[64 * j] = w; }
    }
}
__device__ __forceinline__ void phase1(const Args& a, LAS unsigned char* lds, int vcu, int G, int wave, int lane) {
    unsigned char* ws = a.ws;
    const float* mod = (const float*)(ws + WS_MOD);
    LAS float* S1 = (LAS float*)lds;
    for (int e = threadIdx.x; e < 2 * 4096; e += NWAVES * 64) { const int b = e >> 12, j = e & 4095; S1[e] = mod[(size_t)b * MODW + j]; }
    __syncthreads();
    if (blockIdx.x == 0 && wave == 0) {
#pragma unroll
        for (int b = 0; b < BATCH; ++b) { float mx = 0.f;
            for (int j = lane; j < DM; j += 64) mx = fmaxf(mx, fabsf(mod[(size_t)b * MODW + 3 * DM + j]));
#pragma unroll
            for (int o = 1; o < 64; o <<= 1) mx = fmaxf(mx, __shfl_xor(mx, o));
            if (lane == 0) ((float*)(ws + WS_MAXSH))[b] = mx; } }
    hrows(a.x, a.n1g, S1, (f16*)(ws + WS_H), vcu * NWAVES + wave, G * NWAVES, lane);
    __syncthreads();
    { int l2 = threadIdx.x; asm volatile("" : "+v"(l2)); l2 &= 63;
      const int it0 = vcu * NWAVES + wave, stride = G * NWAVES, nit = TR_I_UP - UP_DEFER;
      tr_run(a, (LAS float*)(lds + wave * 16384), TR_I_IN + TR_I_OUT + UP_DEFER, it0, stride, (nit - it0 + stride - 1) / stride, l2, false); }
}

__global__ void __launch_bounds__(NWAVES * 64, 2) mega(Args a) {
    extern __shared__ __attribute__((aligned(16))) unsigned char lds_raw[];
    LAS unsigned char* lds = (LAS unsigned char*)lds_raw;
    volatile LAS unsigned* MISC = (volatile LAS unsigned*)(lds + MISC_OFF);
    int tid = threadIdx.x; const int wave = __builtin_amdgcn_readfirstlane(tid >> 6); int lane = tid & 63;
#define FRESH() do { tid = threadIdx.x; asm volatile("" : "+v"(tid)); lane = tid & 63; } while (0)
    const int G = gridDim.x; const bool fuse = true;
    const int vcu = (G % 8 == 0) ? (blockIdx.x % 8) * (G / 8) + blockIdx.x / 8 : blockIdx.x;
    if (tid < 64) MISC[tid] = 0u;
    __syncthreads();
    unsigned* ctl = (unsigned*)(a.ws + WS_CTL);
    XcdBarrier bar = xcd_barrier_post(ctl + CW_BAR + a.region * XCD_BAR_WORDS, MISC + 8);
    const int lo = a.ph_lo, hi = a.ph_hi;
#define IN(k) (lo <= (k) && (k) < hi)
#define SEAM(k) do { if (IN(k) && IN((k) + 1)) xcd_barrier(bar); } while (0)
    if (IN(0)) { FRESH(); phase0(a, lds, vcu, G, wave, lane, fuse); } SEAM(0);
    if (IN(1)) { FRESH(); phase1(a, lds, vcu, G, wave, lane); } SEAM(1);
    if (IN(2)) { FRESH();
        pg8::Gemm g{(const f16*)(a.ws + WS_H), (const f16*)(a.ws + WS_WTIN), MTOK, NINP, DM}; pg8::StaticOrder S; S.init(MTOK, NINP, G, (int)blockIdx.x);
        pg8::EpiProjF E{(f16*)(a.ws + WS_PROJ), (f16*)(a.ws + WS_KIX), (float*)(a.ws + WS_WIX), (const float*)(a.ws + WS_ROPE), (f16*)(a.ws + WS_KSBC), (f16*)(a.ws + WS_VSBC), (f16*)(a.ws + WS_KDSC), (f16*)(a.ws + WS_VDSC)};
        pg8::gemm_phase<pg8::EpiProjF, pg8::StaticOrder, true, true>(lds, g, S, E);
        FRESH(); tr_deferred(a, lds, TR_I_IN + TR_I_OUT, UP_DEFER, (MTOK / 256) * (NINP / 256), G, wave, lane);
    } SEAM(2);
    if (IN(3)) { FRESH();
        const f16* P = (const f16*)(a.ws + WS_PROJ);
        if (!(a.pad & 1)) for (int it = vcu * NWAVES + wave; it < BATCH * NH * (SEQ / 32); it += G * NWAVES) {
            const int qb = it % (SEQ / 32), hd = (it / (SEQ / 32)) % NH, b = it / ((SEQ / 32) * NH);
            att::sb_item(P, (const f16*)(a.ws + WS_KSBC), (const f16*)(a.ws + WS_VSBC), (f16*)(a.ws + WS_MERGED), (float*)(a.ws + WS_SSQ), lds + wave * 16384, b, hd, qb, lane);
        }
        __syncthreads();
        if (!(a.pad & 2)) for (int k = vcu; k < BATCH * (SEQ / 8); k += G) {
            auto decode = [&](int kk, int& bb, int& tt0) { bb = kk / (SEQ / 8); const int r = kk % (SEQ / 8); tt0 = 8 * (r < SEQ / 16 ? r : (SEQ / 8 - 1) - (r - SEQ / 16)); };
            int b, t0, nb = 0, nt0 = -1; decode(k, b, t0);
            if (k + G < BATCH * (SEQ / 8)) decode(k + G, nb, nt0);
            att::dsa_round<0>(P, (const f16*)(a.ws + WS_KDSC), (const f16*)(a.ws + WS_VDSC), (const f16*)(a.ws + WS_KIX), (const float*)(a.ws + WS_WIX), a.dsg, (f16*)(a.ws + WS_MERGED), lds, b, t0, nb, nt0, wave, lane, a.pad);
        }
    } SEAM(3);
    if (IN(5)) { FRESH();
        pg8::Gemm g{(const f16*)(a.ws + WS_MERGED), (const f16*)(a.ws + WS_WTOUT), MTOK, DM, DM}; pg8::StaticOrder S; S.init(MTOK, DM, G, (int)blockIdx.x);
        const float* mod = (const float*)(a.ws + WS_MOD);
        pg8::EpiResidNorm<1> E{a.x, mod + 2 * DM, a.n2g, mod + 3 * DM, (float*)(a.ws + WS_X1), (f16*)(a.ws + WS_H), (float*)(a.ws + WS_XCH), ctl + CW_XCNT, (const float*)(a.ws + WS_SSQ), (float*)(a.ws + WS_XCH2), (float*)(a.ws + WS_SA), (const float*)(a.ws + WS_MAXSH)};
        pg8::gemm_phase<pg8::EpiResidNorm<1>, pg8::StaticOrder, false, true>(lds, g, S, E);
    } SEAM(6);
    if (IN(7)) { FRESH();
        pg8::Gemm g{(const f16*)(a.ws + WS_H), (const f16*)(a.ws + WS_WTUP), MTOK, NUP, DM / 2}; pg8::StaticOrder S; S.init(MTOK, NUP, G, (int)blockIdx.x);
        pg8::EpiUpConv E{a.conv_w, a.conv_b, (f16*)(a.ws + WS_ACT), (float*)(a.ws + WS_UH), (const float*)(a.ws + WS_SA), (const float*)((const unsigned*)(a.ws + WS_CTL) + CW_SBMAX)};
        pg8::gemm_phase<pg8::EpiUpConv, pg8::StaticOrder, true, true>(lds, g, S, E);
        FRESH(); tr_deferred(a, lds, TR_I_IN + TR_I_OUT + TR_I_UP, TR_I_DN, (MTOK / 256) * (NUP / 256), G, wave, lane);
        for (int e = blockIdx.x * (NWAVES * 64) + tid; e < DM * 8; e += G * NWAVES * 64) *(u32x4*)(a.ws + WS_WTDN + (size_t)(e >> 3) * DFFP + DFF + 16 * (e & 7)) = (u32x4){0u, 0u, 0u, 0u};
    } SEAM(7);
    if (IN(8)) { FRESH();
        const float* uh = (const float*)(a.ws + WS_UH); f16* act = (f16*)(a.ws + WS_ACT); unsigned char* act8 = (unsigned char*)(a.ws + WS_ACT8); float* sact = (float*)(a.ws + WS_SACT);
        for (int blk = vcu; blk < MTOK / 32; blk += G) {
            const int mb = blk * 32;
            if ((mb & 63) == 0) {
                const int chunk = mb >> 6; const bool first = (chunk % (SEQ / 64)) == 0;
                for (int e = tid; e < DFF / 4; e += NWAVES * 64) { const int ch = 4 * e;
                    f32x4 r0, r1;
#pragma unroll
                    for (int gv = 0; gv < 2; ++gv) { const int c = gv * DFF + ch; const f32x4 z4 = {0.f, 0.f, 0.f, 0.f};
                        const f32x4 um2 = first ? z4 : *(const f32x4*)(uh + (size_t)((chunk - 1) * 4 + 2) * NUP + c), um1 = first ? z4 : *(const f32x4*)(uh + (size_t)((chunk - 1) * 4 + 3) * NUP + c);
                        const f32x4 u0 = *(const f32x4*)(uh + (size_t)(chunk * 4 + 0) * NUP + c), u1 = *(const f32x4*)(uh + (size_t)(chunk * 4 + 1) * NUP + c);
                        const f32x4 k0 = *(const f32x4*)(a.conv_w + c), k1 = *(const f32x4*)(a.conv_w + NUP + c), k2 = *(const f32x4*)(a.conv_w + 2 * NUP + c), bz = *(const f32x4*)(a.conv_b + c);
                        const f32x4 y0 = bz + k0 * um2 + k1 * um1 + k2 * u0, y1 = bz + k0 * um1 + k1 * u0 + k2 * u1;
                        if (gv == 0) {
#pragma unroll
                            for (int j = 0; j < 4; ++j) { r0[j] = pg8::silu_fast(y0[j]); r1[j] = pg8::silu_fast(y1[j]); }
                        } else { r0 *= y0; r1 *= y1; } }
                    u32x2 w0, w1; w0.x = pk_h2(r0.x, r0.y); w0.y = pk_h2(r0.z, r0.w); w1.x = pk_h2(r1.x, r1.y); w1.y = pk_h2(r1.z, r1.w);
                    *(u32x2*)(act + (size_t)mb * DFF + ch) = w0; *(u32x2*)(act + (size_t)(mb + 1) * DFF + ch) = w1; }
                asm volatile("s_waitcnt vmcnt(0)" ::: "memory");
            }
            __syncthreads();
#pragma unroll 1
            for (int pr = 0; pr < 2; ++pr) {
                const int m0 = mb + wave * 4 + 2 * pr;
                half8 v[2][11]; float mx[2] = {0.f, 0.f};
#pragma unroll
                for (int r = 0; r < 2; ++r)
#pragma unroll
                    for (int j = 0; j < 11; ++j) { const int cidx = lane + 64 * j;
                        v[r][j] = cidx < DFF / 8 ? *(const half8*)(act + (size_t)(m0 + r) * DFF + 8 * cidx) : (half8){0, 0, 0, 0, 0, 0, 0, 0}; }
#pragma unroll
                for (int r = 0; r < 2; ++r) {
#pragma unroll
                    for (int j = 0; j < 11; ++j)
#pragma unroll
                        for (int e = 0; e < 8; ++e) mx[r] = fmaxf(mx[r], fabsf((float)v[r][j][e]));
#pragma unroll
                    for (int o = 1; o < 64; o <<= 1) mx[r] = fmaxf(mx[r], __shfl_xor(mx[r], o));
                    mx[r] = fmaxf(mx[r], 1e-20f); const float qs = 127.f / mx[r];
                    unsigned char* orow = act8 + (size_t)(m0 + r) * DFFP;
#pragma unroll
                    for (int j = 0; j < 11; ++j) { const int cidx = lane + 64 * j;
                        if (cidx < DFF / 8) { u32x2 w; w.x = q8x4((float)v[r][j][0] * qs, (float)v[r][j][1] * qs, (float)v[r][j][2] * qs, (float)v[r][j][3] * qs);
                            w.y = q8x4((float)v[r][j][4] * qs, (float)v[r][j][5] * qs, (float)v[r][j][6] * qs, (float)v[r][j][7] * qs); *(u32x2*)(orow + 8 * cidx) = w; } }
                    if (lane < 8) *(u32x4*)(orow + DFF + 16 * lane) = (u32x4){0u, 0u, 0u, 0u};
                    if (lane == 0) sact[m0 + r] = mx[r] * (1.f / 127.f);
                }
            }
            __syncthreads();
        }
    } SEAM(8);
    if (IN(9)) { FRESH();
        pg8::Gemm g{(const f16*)(a.ws + WS_ACT8), (const f16*)(a.ws + WS_WTDN), MTOK, DM, DFFP / 2}; pg8::StaticOrder S; S.init(MTOK, DM, G, (int)blockIdx.x);
        const float* mod = (const float*)(a.ws + WS_MOD);
        pg8::EpiResidNorm<0> E{(const float*)(a.ws + WS_X1), mod + 5 * DM, a.fng, nullptr, a.out, nullptr, (float*)(a.ws + WS_XCH) + 32 * 8 * 256, ctl + CW_XCNT + 32 * 64, nullptr, nullptr, (float*)(a.ws + WS_SACT), (const float*)((const unsigned*)(a.ws + WS_CTL) + CW_SDMAX)};
        pg8::gemm_phase<pg8::EpiResidNorm<0>, pg8::StaticOrder, false, true>(lds, g, S, E);
    }
#undef IN
#undef SEAM
}

extern "C" void kernel_launch(void* const* d_in, const int* in_sizes, int n_in, void* d_out, int out_size, void* d_ws, size_t ws_size, hipStream_t stream) {
    if (n_in != 16 || ws_size < WS_END) { fprintf(stderr, "kernel_launch: unexpected n_in %d / ws %zu\n", n_in, ws_size); return; }
    const float* x = (const float*)d_in[0]; const float* c = (const float*)d_in[1]; const int* pos = (const int*)d_in[2];
    const float* w_ada = (const float*)d_in[3]; const float* b_ada = (const float*)d_in[4]; const float* n1g = (const float*)d_in[5];
    const float* w_in = (const float*)d_in[6]; const float* sbg = (const float*)d_in[7]; const float* dsg = (const float*)d_in[8];
    const float* w_out = (const float*)d_in[9]; const float* n2g = (const float*)d_in[10]; const float* w_up = (const float*)d_in[11];
    const float* conv_w = (const float*)d_in[12]; const float* conv_b = (const float*)d_in[13]; const float* w_down = (const float*)d_in[14];
    const float* fng = (const float*)d_in[15];
    unsigned char* ws = (unsigned char*)d_ws; float* out = (float*)d_out;
    static int grid = 0;
    if (grid == 0) {
        int dev = 0, cus = 0;
        if (hipGetDevice(&dev) != hipSuccess || hipDeviceGetAttribute(&cus, hipDeviceAttributeMultiprocessorCount, dev) != hipSuccess) { fprintf(stderr, "kernel_launch: device query failed\n"); grid = -1; return; }
        if (hipFuncSetAttribute((const void*)mega, hipFuncAttributeMaxDynamicSharedMemorySize, LDS_BYTES) != hipSuccess) { fprintf(stderr, "kernel_launch: hipFuncSetAttribute failed\n"); grid = -1; return; }
        int per_cu = 0; (void)hipOccupancyMaxActiveBlocksPerMultiprocessor(&per_cu, (const void*)mega, NWAVES * 64, LDS_BYTES); (void)hipGetLastError();
        if (per_cu < 1) fprintf(stderr, "kernel_launch: occupancy query reports %d blocks/CU\n", per_cu);
        grid = cus;
        if (cus != (MTOK / 256) * (DM / 256)) { fprintf(stderr, "kernel_launch: built for a %d-CU device (one out-projection / down-projection unit per workgroup); found %d CUs; nothing launched\n", (MTOK / 256) * (DM / 256), cus); grid = -1; }
    }
    if (grid < 0) return;
    (void)hipMemsetAsync(ws + WS_CTL, 0, 1 * MiB, stream);
    Args a{};
    a.x = x; a.c = c; a.pos = pos; a.w_ada = w_ada; a.b_ada = b_ada; a.n1g = n1g; a.w_in = w_in; a.sbg = sbg; a.dsg = dsg; a.w_out = w_out; a.n2g = n2g; a.w_up = w_up;
    a.conv_w = conv_w; a.conv_b = conv_b; a.w_down = w_down; a.fng = fng; a.out = out; a.ws = ws;
    auto run = [&](int lo, int hi, int region) { a.ph_lo = lo; a.ph_hi = hi; a.region = region; hipLaunchKernelGGL(mega, dim3(grid), dim3(NWAVES * 64), LDS_BYTES, stream, a); };
    run(0, 11, 0);
#ifdef PROBE_LO
    a.pad = PROBE_FLAGS; run(PROBE_LO, PROBE_HI, 1);
#endif
}
```

```cpp
#include <hip/hip_runtime.h>
#include <cstdio>

typedef _Float16 f16;

constexpr int BATCH = 2, SEQ = 4096, DM = 2048, MTOK = BATCH * SEQ;
constexpr int HD = 128, NH = 8, IXH = 16, IXD = 64, TOPK = 256;
constexpr int DFF = 5504, NUP = 2 * DFF;
constexpr int NIN = 5456, NINP = 5632;
constexpr int C_QSB = 0, C_KSB = 1024, C_VSB = 2048, C_QDS = 3072, C_KDS = 4096, C_VDS = 4224, C_QIX = 4352, C_KIX = 5376, C_WIX = 5440;
constexpr int MODW = 6 * DM;
constexpr float EPS = 1e-6f;
constexpr float QSCALE = 0.08838834764831845f;
constexpr float IDX_SCALE = 0.03125f;

__constant__ float INV128[16] = {1.0f, 0.44036659598350525f, 0.1939227432012558f, 0.08539710193872452f, 0.03760603070259094f, 0.01656043902039528f, 0.007292664609849453f, 0.0032114458736032248f,
                                 0.0014142135623842478f, 0.000622772378847003f, 0.00027424818836152554f, 0.00012076973507646471f, 5.318296098266728e-05f, 2.34199997066753e-05f, 1.0313386155758053e-05f, 4.541670477919979e-06f};
__constant__ float INV64[8] = {1.0f, 0.1939227432012558f, 0.03760603070259094f, 0.007292664609849453f, 0.0014142135623842478f, 0.00027424818836152554f, 5.318296098266728e-05f, 1.0313386155758053e-05f};

constexpr size_t MiB = 1u << 20;
constexpr size_t WS_CTL = 0;
constexpr size_t WS_MOD = 1 * MiB;
constexpr size_t WS_MODP = 380 * MiB;
constexpr size_t WS_ROPE = 4 * MiB;
constexpr size_t WS_XCH = 3 * MiB + 512 * 1024;
constexpr size_t WS_SA = 6 * MiB + 768 * 1024;
constexpr size_t WS_SACT = WS_SA + 64 * 1024;
constexpr size_t WS_MAXSH = WS_SA + 128 * 1024;
constexpr size_t WS_XCH2 = 383 * MiB;
constexpr size_t WS_SSQ = 6 * MiB + 512 * 1024;
constexpr size_t WS_WIX = 6 * MiB;
constexpr size_t WS_KIX = 7 * MiB;
constexpr size_t WS_WTIN = 8 * MiB;
constexpr size_t WS_WTOUT = 30 * MiB;
constexpr size_t WS_WTUP = 38 * MiB;
constexpr size_t WS_WTDN = 81 * MiB;
constexpr size_t WS_H = 103 * MiB;
constexpr size_t WS_X1 = 135 * MiB;
constexpr size_t WS_PROJ = 199 * MiB;
constexpr size_t WS_ACT = WS_PROJ;
constexpr size_t WS_MERGED = 287 * MiB;
constexpr size_t WS_FREE = 319 * MiB;
constexpr size_t WS_OSB32 = 319 * MiB;
constexpr size_t WS_ODS32 = 351 * MiB;
constexpr size_t WS_U16 = 287 * MiB;
constexpr size_t WS_UH = 8 * MiB;
constexpr size_t WS_ACT8 = 287 * MiB;
constexpr int DFFP = 5632;
constexpr size_t WS_KSBC = 342 * MiB;
constexpr size_t WS_VSBC = 358 * MiB;
constexpr size_t WS_KDSC = 374 * MiB;
constexpr size_t WS_VDSC = 376 * MiB;
constexpr size_t WS_END = 384 * MiB;

__device__ __forceinline__ float wave_sum(float v) {
#pragma unroll
    for (int o = 1; o < 64; o <<= 1) v += __shfl_xor(v, o);
    return v;
}
__device__ __forceinline__ float block_sum256(float v, float* red) {
    v = wave_sum(v);
    __syncthreads();
    if ((threadIdx.x & 63) == 0) red[threadIdx.x >> 6] = v;
    __syncthreads();
    return red[0] + red[1] + red[2] + red[3];
}
__device__ __forceinline__ float silu_f(float v) { return v / (1.f + expf(-v)); }
__device__ __forceinline__ float softplus_f(float z) { return fmaxf(z, 0.f) + log1pf(expf(-fabsf(z))); }

#define LAS __attribute__((address_space(3)))
typedef _Float16 half8 __attribute__((ext_vector_type(8)));
typedef _Float16 half4 __attribute__((ext_vector_type(4)));
typedef _Float16 half2v __attribute__((ext_vector_type(2)));
typedef float f32x4 __attribute__((ext_vector_type(4)));
typedef float f32x16 __attribute__((ext_vector_type(16)));
typedef unsigned u32x4 __attribute__((ext_vector_type(4)));
typedef unsigned u32x2 __attribute__((ext_vector_type(2)));
typedef int i32x4 __attribute__((ext_vector_type(4)));
__device__ __forceinline__ unsigned q8x4(float a, float b, float c, float d) {
    a = __builtin_amdgcn_fmed3f(__builtin_rintf(a), -127.f, 127.f); b = __builtin_amdgcn_fmed3f(__builtin_rintf(b), -127.f, 127.f);
    c = __builtin_amdgcn_fmed3f(__builtin_rintf(c), -127.f, 127.f); d = __builtin_amdgcn_fmed3f(__builtin_rintf(d), -127.f, 127.f);
    const unsigned p01 = __builtin_bit_cast(unsigned, __builtin_amdgcn_cvt_pk_i16((int)a, (int)b)), p23 = __builtin_bit_cast(unsigned, __builtin_amdgcn_cvt_pk_i16((int)c, (int)d));
    return __builtin_amdgcn_perm(p23, p01, 0x06040200u);
}
__device__ __forceinline__ unsigned pk_h2(float lo, float hi) { half2v h = {(f16)lo, (f16)hi}; return __builtin_bit_cast(unsigned, h); }

constexpr int NWAVES = 8;
constexpr int LDS_BYTES = 159744;
constexpr int RING_BYTES = 131072;
constexpr int XTRA_OFF = RING_BYTES;
constexpr int MISC_OFF = LDS_BYTES - 256;
constexpr int CW_TMO = 0, CW_BAR = 4096, CW_XCNT = 32768, CW_ADA = 40960, CW_SBMAX = 49152, CW_SDMAX = 61440;

namespace pg8 {
constexpr int BM = 256, BK = 64, HALF = 128, HTB = HALF * BK * 2, STAGE_BYTES = 8 * HTB, NXCD = 8, WGM = 8;
__host__ __device__ __forceinline__ int lds_byte(int r, int c) { const int st = (r >> 4) * 2 + (c >> 5), rr = r & 15, cc = c & 31, ob = rr * 64 + cc * 2; return st * 1024 + (ob ^ (((ob >> 9) & 1) << 5)); }
__host__ __device__ __forceinline__ void stage_rc(int b, int& R, int& C) { const int st = b / 1024, sb = b % 1024, swz = sb ^ (((sb >> 9) & 1) << 5); R = (st >> 1) * 16 + swz / 64; C = (st & 1) * 32 + (swz % 64) / 2; }
__host__ __device__ __forceinline__ int perm32(int rho) { const int n = rho >> 4, i = rho & 15; return 8 * (i >> 2) + 4 * n + (i & 3); }
struct Unit { int pm, pn; };
struct Gemm { const f16* A; const f16* Bt; int M, N, K; };
struct StaticOrder {
    int nM, nN, nwg, G, c;
    __host__ __device__ __forceinline__ void init(int M, int N, int G_, int c_) { nM = M / BM; nN = N / BM; nwg = nM * nN; G = G_; c = c_; }
    __host__ __device__ __forceinline__ bool next(int i, Unit& u) const {
        const long L = (long)i * G + c; if (L >= nwg) return false;
        int wgid = (int)L; { const int q = nwg / NXCD, r = nwg % NXCD, xcd = wgid % NXCD, off = wgid / NXCD; wgid = (xcd < r ? xcd * (q + 1) : r * (q + 1) + (xcd - r) * q) + off; }
        const int nig = WGM * nN, gid = wgid / nig, fm = gid * WGM, gsz = (nM - fm) < WGM ? (nM - fm) : WGM;
        u.pm = fm + ((wgid % nig) % gsz); u.pn = (wgid % nig) / gsz; return true;
    }
    __device__ __forceinline__ void a_ready(const Unit&) const {}
    __device__ __forceinline__ void done(const Unit&) const {}
};
__device__ __forceinline__ void mma16(f32x4& c, const half8& b, const half8& a) { c = __builtin_amdgcn_mfma_f32_16x16x32_f16(b, a, c, 0, 0, 0); }
__device__ __forceinline__ void mma16(i32x4& c, const half8& b, const half8& a) { c = __builtin_amdgcn_mfma_i32_16x16x64_i8(__builtin_bit_cast(i32x4, b), __builtin_bit_cast(i32x4, a), c, 0, 0, 0); }
template <class Epi, class Sched, bool ALIGN_EPI, bool SP2>
__device__ __forceinline__ void gemm_phase(LAS unsigned char* lds, const Gemm g, const Sched& S, const Epi& E) {
    int tid = threadIdx.x; asm volatile("" : "+v"(tid));
    const int wid = __builtin_amdgcn_readfirstlane(tid >> 6), lane = tid & 63, wr = wid >> 2, wc = wid & 3, fr = lane & 15, fq = lane >> 4;
    const int K = g.K, nt = K / BK;
    unsigned voffA[2], voffB[2];
#pragma unroll
    for (int i = 0; i < 2; ++i) { int R, C; stage_rc(tid * 16 + i * 8192, R, C); const int Rb = Epi::PERM ? ((R & ~31) + perm32(R & 31)) : R;
        voffA[i] = (unsigned)(R * K + C) * 2u; voffB[i] = (unsigned)(Rb * K + C) * 2u; }
    const size_t kstep = (size_t)(BK * 2);
    const size_t hstep = (size_t)HALF * K * 2;
    const size_t tstep = 2 * hstep;
    const unsigned ldsw = (unsigned)wid * 1024u;
    const int aoff = lds_byte(wr * 64 + fr, fq * 8), boff = lds_byte(wc * 32 + fr, fq * 8);
#define PG8_SA(b, h) (((b) * 2 + (h)) * HTB)
#define PG8_SB(b, h) ((4 + (b) * 2 + (h)) * HTB)
#define PG8_STAGE(bufoff, gbase, voff) do { _Pragma("unroll") for (int _i = 0; _i < 2; ++_i) \
        __builtin_amdgcn_global_load_lds((const unsigned*)((const char*)(gbase) + (voff)[_i]), (LAS unsigned*)(lds + (bufoff) + ldsw + _i * 8192), 16, 0, 0); } while (0)
#define PG8_LDA(dst, b, h) do { _Pragma("unroll") for (int m = 0; m < 4; ++m) _Pragma("unroll") for (int k = 0; k < 2; ++k) dst[m][k] = *(const LAS half8*)(lds + PG8_SA(b, h) + aoff + m * 2048 + k * 1024); } while (0)
#define PG8_LDB(dst, b, h) do { _Pragma("unroll") for (int n = 0; n < 2; ++n) _Pragma("unroll") for (int k = 0; k < 2; ++k) dst[n][k] = *(const LAS half8*)(lds + PG8_SB(b, h) + boff + n * 2048 + k * 1024); } while (0)
#define PG8_MMA(ai, bj, At, Bt) do { __builtin_amdgcn_s_setprio(1); _Pragma("unroll") for (int m = 0; m < 4; ++m) _Pragma("unroll") for (int n = 0; n < 2; ++n) _Pragma("unroll") for (int k = 0; k < 2; ++k) \
        mma16(acc[ai][bj][m][n], Bt[n][k], At[m][k]); __builtin_amdgcn_s_setprio(0); } while (0)
#define PG8_WAIT_V(n) asm volatile("s_waitcnt vmcnt(" #n ")" ::: "memory")
#define PG8_WAIT_L(n) asm volatile("s_waitcnt lgkmcnt(" #n ")" ::: "memory")
#define PG8_BAR __builtin_amdgcn_s_barrier()
#define PG8_SCHED __builtin_amdgcn_sched_barrier(0)
    Unit cur, nxt; int ui = 0;
    if (!S.next(0, cur)) return;
    typedef typename Epi::acc_t acc_t;
    acc_t acc[2][2][4][2];
#pragma unroll
    for (int a = 0; a < 2; ++a)
#pragma unroll
        for (int b = 0; b < 2; ++b)
#pragma unroll
            for (int m = 0; m < 4; ++m)
#pragma unroll
                for (int n = 0; n < 2; ++n) acc[a][b][m][n] = (acc_t){0, 0, 0, 0};
    half8 At[4][2], B0[2][2], B1[2][2];
    const char* cA = (const char*)g.A + (size_t)cur.pm * tstep; const char* cB = (const char*)g.Bt + (size_t)cur.pn * tstep;
    S.a_ready(cur);
    if constexpr (SP2) {
        PG8_STAGE(PG8_SB(0, 0), cB, voffB); PG8_STAGE(PG8_SB(0, 1), cB + hstep, voffB); PG8_STAGE(PG8_SA(0, 0), cA, voffA); PG8_STAGE(PG8_SA(0, 1), cA + hstep, voffA);
        if (wr == 1) PG8_BAR;
        PG8_WAIT_V(2); PG8_BAR;
        PG8_STAGE(PG8_SB(1, 0), cB + kstep, voffB); PG8_STAGE(PG8_SA(1, 0), cA + kstep, voffA); PG8_STAGE(PG8_SB(1, 1), cB + hstep + kstep, voffB);
        PG8_WAIT_V(6); PG8_BAR;
    } else {
        PG8_STAGE(PG8_SB(0, 0), cB, voffB); PG8_STAGE(PG8_SA(0, 0), cA, voffA); PG8_STAGE(PG8_SB(0, 1), cB + hstep, voffB); PG8_STAGE(PG8_SA(0, 1), cA + hstep, voffA);
        if (wr == 1) PG8_BAR;
        PG8_WAIT_V(4); PG8_BAR;
        PG8_STAGE(PG8_SB(1, 0), cB + kstep, voffB); PG8_STAGE(PG8_SA(1, 0), cA + kstep, voffA); PG8_STAGE(PG8_SB(1, 1), cB + hstep + kstep, voffB);
        PG8_WAIT_V(6); PG8_BAR;
    }
    for (;;) {
        const bool has_next = S.next(ui + 1, nxt);
        const char* nA = has_next ? (const char*)g.A + (size_t)nxt.pm * tstep : cA; const char* nB = has_next ? (const char*)g.Bt + (size_t)nxt.pn * tstep : cB;
        for (int t = 0; t < nt; t += 2) {
            const bool last = (t == nt - 2);
            const char* a1 = cA + (size_t)(t + 1) * kstep;
            const char* a2 = last ? nA : cA + (size_t)(t + 2) * kstep; const char* b2 = last ? nB : cB + (size_t)(t + 2) * kstep;
            const char* a3 = a2 + kstep; const char* b3 = b2 + kstep;
            if (last && has_next) S.a_ready(nxt);
            if constexpr (Epi::MIDK) { if (t == nt / 2) E.midk(acc, cur, wr, fr); }
            if constexpr (SP2) {
            PG8_LDB(B0, 0, 0); PG8_LDB(B1, 0, 1); PG8_SCHED; PG8_LDA(At, 0, 0); PG8_STAGE(PG8_SA(1, 1), a1 + hstep, voffA);
            PG8_WAIT_V(8); PG8_WAIT_L(0); PG8_BAR; PG8_MMA(0, 0, At, B0); PG8_MMA(0, 1, At, B1); PG8_BAR; PG8_SCHED;
            PG8_LDA(At, 0, 1); PG8_STAGE(PG8_SB(0, 0), b2, voffB); PG8_STAGE(PG8_SB(0, 1), b2 + hstep, voffB); PG8_STAGE(PG8_SA(0, 0), a2, voffA);
            PG8_WAIT_V(8); PG8_WAIT_L(0); PG8_BAR; PG8_MMA(1, 0, At, B0); PG8_MMA(1, 1, At, B1); PG8_BAR; PG8_SCHED;
            PG8_LDB(B0, 1, 0); PG8_LDB(B1, 1, 1); PG8_SCHED; PG8_LDA(At, 1, 0); PG8_STAGE(PG8_SA(0, 1), a2 + hstep, voffA);
            PG8_WAIT_V(8); PG8_WAIT_L(0); PG8_BAR; PG8_MMA(0, 0, At, B0); PG8_MMA(0, 1, At, B1); PG8_BAR; PG8_SCHED;
            PG8_LDA(At, 1, 1); PG8_STAGE(PG8_SB(1, 0), b3, voffB); PG8_STAGE(PG8_SB(1, 1), b3 + hstep, voffB); PG8_STAGE(PG8_SA(1, 0), a3, voffA);
            PG8_WAIT_V(8); PG8_WAIT_L(0); PG8_BAR; PG8_MMA(1, 0, At, B0); PG8_MMA(1, 1, At, B1); PG8_BAR; PG8_SCHED;
            } else {
            PG8_LDB(B0, 0, 0); PG8_SCHED; PG8_LDA(At, 0, 0); PG8_STAGE(PG8_SA(1, 1), a1 + hstep, voffA);
            PG8_WAIT_L(8); PG8_BAR; PG8_WAIT_L(0); PG8_MMA(0, 0, At, B0); PG8_BAR; PG8_SCHED;
            PG8_LDB(B1, 0, 1); PG8_STAGE(PG8_SB(0, 0), b2, voffB);
            PG8_BAR; PG8_WAIT_L(0); PG8_MMA(0, 1, At, B1); PG8_BAR;
            PG8_LDA(At, 0, 1); PG8_STAGE(PG8_SA(0, 0), a2, voffA);
            PG8_BAR; PG8_WAIT_L(0); PG8_MMA(1, 0, At, B0); PG8_BAR; PG8_SCHED;
            PG8_STAGE(PG8_SB(0, 1), b2 + hstep, voffB);
            PG8_WAIT_V(6); PG8_BAR; PG8_MMA(1, 1, At, B1); PG8_BAR;
            PG8_LDB(B0, 1, 0); PG8_SCHED; PG8_LDA(At, 1, 0); PG8_STAGE(PG8_SA(0, 1), a2 + hstep, voffA);
            PG8_WAIT_L(8); PG8_BAR; PG8_WAIT_L(0); PG8_MMA(0, 0, At, B0); PG8_BAR; PG8_SCHED;
            PG8_LDB(B1, 1, 1); PG8_STAGE(PG8_SB(1, 0), b3, voffB);
            PG8_BAR; PG8_WAIT_L(0); PG8_MMA(0, 1, At, B1); PG8_BAR;
            PG8_LDA(At, 1, 1); PG8_STAGE(PG8_SA(1, 0), a3, voffA);
            PG8_BAR; PG8_WAIT_L(0); PG8_MMA(1, 0, At, B0); PG8_BAR; PG8_SCHED;
            PG8_STAGE(PG8_SB(1, 1), b3 + hstep, voffB);
            PG8_WAIT_V(6); PG8_BAR; PG8_MMA(1, 1, At, B1); PG8_BAR;
            }
        }
        if constexpr (ALIGN_EPI) { if (wr == 0) PG8_BAR; }
        if constexpr (!Epi::AFTER_DRAIN) { E(acc, cur, wr, wc, fr, fq); S.done(cur); }
        if (!has_next) break;
#pragma unroll
        for (int a = 0; a < 2; ++a)
#pragma unroll
            for (int b = 0; b < 2; ++b)
#pragma unroll
                for (int m = 0; m < 4; ++m)
#pragma unroll
                    for (int n = 0; n < 2; ++n) acc[a][b][m][n] = (acc_t){0, 0, 0, 0};
        cur = nxt; cA = nA; cB = nB; ++ui;
        if constexpr (ALIGN_EPI) { if (wr == 1) PG8_BAR; }
    }
    PG8_WAIT_V(0);
    if constexpr (!ALIGN_EPI) { if (wr == 0) PG8_BAR; }
    PG8_BAR;
    if constexpr (Epi::AFTER_DRAIN) { E.fused(acc, cur, wr, wc, fr, fq, lds); S.done(cur); }
#undef PG8_SA
#undef PG8_SB
#undef PG8_STAGE
#undef PG8_LDA
#undef PG8_LDB
#undef PG8_MMA
#undef PG8_WAIT_V
#undef PG8_WAIT_L
#undef PG8_BAR
#undef PG8_SCHED
}

struct EpiProjF {
    static constexpr bool PERM = true, AFTER_DRAIN = false, MIDK = false; typedef f32x4 acc_t;
    f16* P; f16* kix; float* wix; const float* rope; f16* ksbc; f16* vsbc; f16* kdsc; f16* vdsc;
    __device__ __forceinline__ void operator()(const f32x4 (&acc)[2][2][4][2], const Unit& u, int wr, int wc, int fr, int fq) const {
        const int row0 = u.pm * BM + wr * 64 + fr;
#pragma unroll
        for (int bj = 0; bj < 2; ++bj) {
            const int cbase = u.pn * BM + bj * HALF;
            if (cbase >= 5504) continue;
            const bool r128 = (cbase >= C_QDS && cbase < C_VDS) && (wc == 0);
            const bool r64 = (cbase >= C_QIX) && ((wc & 1) == 0) && (cbase != C_KIX || wc == 0);
            const float sc = (cbase < 1024 || (cbase >= C_QDS && cbase < C_KDS)) ? QSCALE : 1.f;
#pragma unroll
            for (int ai = 0; ai < 2; ++ai)
#pragma unroll
                for (int m = 0; m < 4; ++m) {
                    const int row = row0 + ai * HALF + m * 16;
                    float v[8];
#pragma unroll
                    for (int n = 0; n < 2; ++n)
#pragma unroll
                        for (int j = 0; j < 4; ++j) v[n * 4 + j] = acc[ai][bj][m][n][j];
                    if (r128) {
                        const float* rp = rope + (size_t)row * 48 + 2 * (8 * (fq & 1));
#pragma unroll
                        for (int e = 0; e < 8; ++e) { const float o = __shfl_xor(v[e], 32); const float cs = rp[2 * e], sn = rp[2 * e + 1];
                            v[e] = fq < 2 ? v[e] * cs - o * sn : v[e] * cs + o * sn; }
                    }
                    if (r64) {
                        const float* rp = rope + (size_t)row * 48 + 32;
#pragma unroll
                        for (int e = 0; e < 8; ++e) { const float o = __shfl_xor(v[e], 16); const float cs = rp[2 * e], sn = rp[2 * e + 1];
                            const float r = fq == 0 ? v[e] * cs - o * sn : v[e] * cs + o * sn; v[e] = fq < 2 ? r : v[e]; }
                    }
                    u32x4 w; w.x = pk_h2(v[0] * sc, v[1] * sc); w.y = pk_h2(v[2] * sc, v[3] * sc); w.z = pk_h2(v[4] * sc, v[5] * sc); w.w = pk_h2(v[6] * sc, v[7] * sc);
                    {
                        f16* dst = P + (size_t)row * NINP + cbase;
                        const int bb = row / SEQ, ss = row % SEQ;
                        if (cbase >= C_KSB && cbase < C_VSB) dst = ksbc + ((size_t)(bb * NH + (cbase - C_KSB) / HD) * SEQ + ss) * HD;
                        else if (cbase >= C_VSB && cbase < C_QDS) dst = vsbc + ((size_t)(bb * NH + (cbase - C_VSB) / HD) * SEQ + ss) * HD;
                        else if (cbase == C_KDS) dst = kdsc + (size_t)row * HD;
                        else if (cbase == C_VDS) dst = vdsc + (size_t)row * HD;
                        *(u32x4*)(dst + wc * 32 + 8 * fq) = w; }
                    if (cbase == C_KIX) {
                        if (wc < 2) *(u32x4*)(kix + (size_t)row * 64 + wc * 32 + 8 * fq) = w;
                        if (wc == 2 && fq < 2) { float* wp = wix + (size_t)row * 16 + 8 * fq;
                            *(f32x4*)wp = (f32x4){v[0] * IDX_SCALE, v[1] * IDX_SCALE, v[2] * IDX_SCALE, v[3] * IDX_SCALE};
                            *(f32x4*)(wp + 4) = (f32x4){v[4] * IDX_SCALE, v[5] * IDX_SCALE, v[6] * IDX_SCALE, v[7] * IDX_SCALE}; }
                    }
                }
        }
    }
};
struct EpiResidF {
    static constexpr bool PERM = false, AFTER_DRAIN = false, MIDK = false; typedef f32x4 acc_t;
    const float* base; const float* gate; float* out;
    __device__ __forceinline__ void operator()(const f32x4 (&acc)[2][2][4][2], const Unit& u, int wr, int wc, int fr, int fq) const {
        const int row0 = u.pm * BM + wr * 64 + fr, col0 = u.pn * BM + wc * 32 + 4 * fq;
        const float* gp = gate + (size_t)(u.pm / (SEQ / BM)) * MODW + col0;
        f32x4 gv[2][2];
#pragma unroll
        for (int bj = 0; bj < 2; ++bj)
#pragma unroll
            for (int n = 0; n < 2; ++n) gv[bj][n] = *(const f32x4*)(gp + bj * HALF + n * 16);
#pragma unroll
        for (int ai = 0; ai < 2; ++ai)
#pragma unroll
            for (int m = 0; m < 4; ++m) { const size_t off = (size_t)(row0 + ai * HALF + m * 16) * DM + col0;
#pragma unroll
                for (int bj = 0; bj < 2; ++bj)
#pragma unroll
                    for (int n = 0; n < 2; ++n) { const f32x4 bs = *(const f32x4*)(base + off + bj * HALF + n * 16);
                        *(f32x4*)(out + off + bj * HALF + n * 16) = bs + gv[bj][n] * acc[ai][bj][m][n]; }
                asm volatile("" ::: "memory"); }
    }
};
__device__ __forceinline__ float silu_fast(float v) { return v * __builtin_amdgcn_rcpf(1.f + __expf(-v)); }
struct EpiUpConv {
    static constexpr bool PERM = true, AFTER_DRAIN = false, MIDK = false; typedef i32x4 acc_t;
    const float* cw; const float* cb; f16* act; float* uh; const float* sa; const float* sbw;
    __device__ __forceinline__ void operator()(i32x4 (&acc)[2][2][4][2], const Unit& u, int wr, int wc, int fr_in, int fq_in) const {
        int tix = threadIdx.x; asm volatile("" : "+v"(tix));
        const int fr = tix & 15, fq = (tix >> 4) & 3; (void)fr_in; (void)fq_in;
        const int lane = fr + 16 * fq;
        int ch0 = u.pn * HALF + wc * 32 + 8 * fq;
        {
            f32x4 sbv[2][2];
#pragma unroll
            for (int gv = 0; gv < 2; ++gv)
#pragma unroll
                for (int n = 0; n < 2; ++n) sbv[gv][n] = *(const f32x4*)(sbw + gv * DFF + ch0 + 4 * n) * (2.f / 127.f);
#pragma unroll
            for (int ai = 0; ai < 2; ++ai)
#pragma unroll
                for (int m = 0; m < 4; ++m) { const float rs = sa[u.pm * BM + ai * HALF + wr * 64 + m * 16 + fr];
#pragma unroll
                    for (int gv = 0; gv < 2; ++gv)
#pragma unroll
                        for (int n = 0; n < 2; ++n) { const i32x4 t = acc[ai][gv][m][n];
                            const f32x4 f = (f32x4){(float)t.x, (float)t.y, (float)t.z, (float)t.w} * rs * sbv[gv][n]; acc[ai][gv][m][n] = __builtin_bit_cast(i32x4, f); } }
        }
#define UF(ai, gv, m, n) __builtin_bit_cast(f32x4, acc[ai][gv][m][n])
        const int src1 = (lane & 48) | ((fr - 1) & 15), src2 = (lane & 48) | ((fr - 2) & 15);
#pragma unroll
        for (int n = 0; n < 2; ++n) {
            asm volatile("" : "+v"(ch0));
            f32x4 w0[2], w1[2], w2[2], bb[2];
#pragma unroll
            for (int gv = 0; gv < 2; ++gv) { const int c = gv * DFF + ch0 + 4 * n;
                w0[gv] = *(const f32x4*)(cw + c); w1[gv] = *(const f32x4*)(cw + NUP + c); w2[gv] = *(const f32x4*)(cw + 2 * NUP + c); bb[gv] = *(const f32x4*)(cb + c); }
#pragma unroll
            for (int ai = 0; ai < 2; ++ai) {
                const int chunk = u.pm * 4 + ai * 2 + wr;
#pragma unroll
                for (int m = 0; m < 4; ++m) {
                    const int row = u.pm * BM + ai * HALF + wr * 64 + m * 16 + fr;
                    f32x4 uc[2];
#pragma unroll
                    for (int gv = 0; gv < 2; ++gv) {
                        const f32x4 cur = UF(ai, gv, m, n); const f32x4 prv = UF(ai, gv, m > 0 ? m - 1 : 0, n);
                        f32x4 p1, p2;
#pragma unroll
                        for (int j = 0; j < 4; ++j) { const float t1 = fr == 15 ? prv[j] : cur[j], t2 = fr >= 14 ? prv[j] : cur[j]; p1[j] = __shfl(t1, src1); p2[j] = __shfl(t2, src2); }
                        uc[gv] = bb[gv] + w0[gv] * p2 + w1[gv] * p1 + w2[gv] * cur;
                    }
                    if (m > 0 || fr >= 2) { u32x2 w; w.x = pk_h2(silu_fast(uc[0].x) * uc[1].x, silu_fast(uc[0].y) * uc[1].y); w.y = pk_h2(silu_fast(uc[0].z) * uc[1].z, silu_fast(uc[0].w) * uc[1].w);
                        *(u32x2*)(act + (size_t)row * DFF + ch0 + 4 * n) = w; }
                    if ((m == 0 && fr < 2) || (m == 3 && fr >= 14)) { const int slot = m == 0 ? fr : fr - 12; float* up = uh + (size_t)(chunk * 4 + slot) * NUP + ch0 + 4 * n;
#pragma unroll
                        for (int gv = 0; gv < 2; ++gv) *(f32x4*)(up + gv * DFF) = UF(ai, gv, m, n); }
                }
            }
        }
    }
#undef UF
};
template <int MODE> struct AccSel { typedef f32x4 type; };
template <> struct AccSel<0> { typedef i32x4 type; };
template <int MODE> struct EpiResidNorm {
    static constexpr bool PERM = true, AFTER_DRAIN = true, MIDK = (MODE == 1); typedef typename AccSel<MODE>::type acc_t;
    const float* base; const float* gate; const float* g; const float* shsc; float* xout; f16* h; float* xch; unsigned* cnt; const float* ssq; float* xch2; float* sa; const float* maxsh;
    __device__ __forceinline__ void midk(f32x4 (&acc)[2][2][4][2], const Unit& u, int wr, int fr) const {
#pragma unroll
        for (int ai = 0; ai < 2; ++ai)
#pragma unroll
            for (int m = 0; m < 4; ++m) { const float* sp = ssq + (size_t)(u.pm * BM + ai * HALF + wr * 64 + m * 16 + fr) * NH;
                const f32x4 s0 = *(const f32x4*)sp, s1 = *(const f32x4*)(sp + 4);
                const float rs = rsqrtf((((s0.x + s0.y) + (s0.z + s0.w)) + ((s1.x + s1.y) + (s1.z + s1.w))) * (1.f / 1024.f) + EPS);
#pragma unroll
                for (int bj = 0; bj < 2; ++bj)
#pragma unroll
                    for (int n = 0; n < 2; ++n) acc[ai][bj][m][n] *= rs; }
    }
    __device__ __forceinline__ void fused(acc_t (&acc)[2][2][4][2], const Unit& u, int wr, int wc, int fr_in, int fq_in, LAS unsigned char* lds) const {
        int tix = threadIdx.x; asm volatile("" : "+v"(tix));
        const int fr = tix & 15, fq = (tix >> 4) & 3; (void)fr_in; (void)fq_in;
        LAS float* PT = (LAS float*)(lds + XTRA_OFF);
        LAS float* ST = (LAS float*)(lds + XTRA_OFF + 4096);
        const int bt = u.pm / (SEQ / BM);
        const int row0 = u.pm * BM + wr * 64 + fr, col0 = u.pn * BM + wc * 32 + 8 * fq;
#define XF(ai, bj, m, n) __builtin_bit_cast(f32x4, acc[ai][bj][m][n])
#define XS(ai, bj, m, n, v) acc[ai][bj][m][n] = __builtin_bit_cast(acc_t, (f32x4)(v))
        if (MODE == 0) {
            f32x4 sdv[2][2];
#pragma unroll
            for (int bj = 0; bj < 2; ++bj)
#pragma unroll
                for (int n = 0; n < 2; ++n) sdv[bj][n] = *(const f32x4*)(maxsh + col0 + bj * HALF + 4 * n) * (2.f / 127.f);
#pragma unroll
            for (int ai = 0; ai < 2; ++ai)
#pragma unroll
                for (int m = 0; m < 4; ++m) { const float rsa = sa[row0 + ai * HALF + m * 16];
#pragma unroll
                    for (int bj = 0; bj < 2; ++bj)
#pragma unroll
                        for (int n = 0; n < 2; ++n) { const i32x4 t = __builtin_bit_cast(i32x4, acc[ai][bj][m][n]);
                            XS(ai, bj, m, n, ((f32x4){(float)t.x, (float)t.y, (float)t.z, (float)t.w} * rsa * sdv[bj][n])); } }
        }
        {   const float* gp = gate + (size_t)bt * MODW + col0;
            f32x4 gv[2][2];
#pragma unroll
            for (int bj = 0; bj < 2; ++bj)
#pragma unroll
                for (int n = 0; n < 2; ++n) gv[bj][n] = *(const f32x4*)(gp + bj * HALF + 4 * n);
            int tok = 0;
#pragma unroll
            for (int ai = 0; ai < 2; ++ai)
#pragma unroll
                for (int m = 0; m < 4; ++m) { const size_t off = (size_t)(row0 + ai * HALF + m * 16 + tok) * DM + col0;
#pragma unroll
                    for (int bj = 0; bj < 2; ++bj) {
                        if (MODE == 1) {
#pragma unroll
                            for (int n = 0; n < 2; ++n) XS(ai, bj, m, n, *(const f32x4*)(base + off + bj * HALF + 4 * n) + gv[bj][n] * XF(ai, bj, m, n));
                        } else {
                            const half8 b8 = *(const half8*)((const f16*)base + off + bj * HALF);
                            XS(ai, bj, m, 0, ((f32x4){(float)b8[0], (float)b8[1], (float)b8[2], (float)b8[3]} + gv[bj][0] * XF(ai, bj, m, 0)));
                            XS(ai, bj, m, 1, ((f32x4){(float)b8[4], (float)b8[5], (float)b8[6], (float)b8[7]} + gv[bj][1] * XF(ai, bj, m, 1)));
                        } }
                    asm volatile("" : "+v"(tok) : "v"(acc[ai][0][m][0].x), "v"(acc[ai][0][m][1].x), "v"(acc[ai][1][m][0].x), "v"(acc[ai][1][m][1].x) : "memory"); }
        }
#pragma unroll
        for (int ai = 0; ai < 2; ++ai)
#pragma unroll
            for (int m = 0; m < 4; ++m) { float q = 0.f;
#pragma unroll
                for (int bj = 0; bj < 2; ++bj)
#pragma unroll
                    for (int n = 0; n < 2; ++n) { const f32x4 x = XF(ai, bj, m, n); q += (x.x * x.x + x.y * x.y) + (x.z * x.z + x.w * x.w); }
                q += __shfl_xor(q, 16); q += __shfl_xor(q, 32);
                if (fq == 0) PT[(ai * HALF + wr * 64 + m * 16 + fr) * 4 + wc] = q; }
        if (MODE == 1) {
            LAS float* PT2 = (LAS float*)(lds + XTRA_OFF + 8192);
            float mxa[2][4];
#pragma unroll
            for (int ai = 0; ai < 2; ++ai)
#pragma unroll
                for (int m = 0; m < 4; ++m) mxa[ai][m] = 0.f;
#pragma unroll
            for (int bj = 0; bj < 2; ++bj) {
                f32x4 av[2];
#pragma unroll
                for (int n = 0; n < 2; ++n) { const int c = col0 + bj * HALF + 4 * n; av[n] = *(const f32x4*)(g + c) * (*(const f32x4*)(shsc + (size_t)bt * MODW + DM + c) + 1.f); }
#pragma unroll
                for (int ai = 0; ai < 2; ++ai)
#pragma unroll
                    for (int m = 0; m < 4; ++m)
#pragma unroll
                        for (int n = 0; n < 2; ++n) { const f32x4 t = __builtin_elementwise_abs(XF(ai, bj, m, n) * av[n]); mxa[ai][m] = fmaxf(mxa[ai][m], fmaxf(fmaxf(t.x, t.y), fmaxf(t.z, t.w))); }
            }
#pragma unroll
            for (int ai = 0; ai < 2; ++ai)
#pragma unroll
                for (int m = 0; m < 4; ++m) { float q = mxa[ai][m]; q = fmaxf(q, __shfl_xor(q, 16)); q = fmaxf(q, __shfl_xor(q, 32));
                    if (fq == 0) PT2[(ai * HALF + wr * 64 + m * 16 + fr) * 4 + wc] = q; }
        }
        __syncthreads();
        const int tid = threadIdx.x;
        float* slot = xch + ((size_t)u.pm * 8 + u.pn) * BM;
        if (tid < BM) { const f32x4 p4 = *(const LAS f32x4*)(PT + tid * 4); __hip_atomic_store(slot + tid, (p4.x + p4.y) + (p4.z + p4.w), __ATOMIC_RELAXED, __HIP_MEMORY_SCOPE_AGENT);
            if (MODE == 1) { const f32x4 m4 = *(const LAS f32x4*)((LAS float*)(lds + XTRA_OFF + 8192) + tid * 4);
                __hip_atomic_store(xch2 + ((size_t)u.pm * 8 + u.pn) * BM + tid, fmaxf(fmaxf(m4.x, m4.y), fmaxf(m4.z, m4.w)), __ATOMIC_RELAXED, __HIP_MEMORY_SCOPE_AGENT); } }
        asm volatile("s_waitcnt vmcnt(0)" ::: "memory");
        __syncthreads();
        if (tid == 0) {
            __hip_atomic_fetch_add(cnt + 64 * u.pm, 1u, __ATOMIC_RELAXED, __HIP_MEMORY_SCOPE_AGENT);
            unsigned sp = 0;
            while (__hip_atomic_load(cnt + 64 * u.pm, __ATOMIC_RELAXED, __HIP_MEMORY_SCOPE_AGENT) < 8u) { __builtin_amdgcn_s_sleep(1); if (++sp > (1u << 22)) break; }
        }
        __syncthreads();
        if (tid < BM) { const float* sp = xch + (size_t)u.pm * 8 * BM + tid; float tot = 0.f;
#pragma unroll
            for (int j = 0; j < 8; ++j) tot += __hip_atomic_load(sp + j * BM, __ATOMIC_RELAXED, __HIP_MEMORY_SCOPE_AGENT);
            const float rstd = rsqrtf(tot * (1.f / DM) + EPS); ST[tid] = rstd;
            if (MODE == 1) { const float* mp = xch2 + (size_t)u.pm * 8 * BM + tid; float mxr = 0.f;
#pragma unroll
                for (int j = 0; j < 8; ++j) mxr = fmaxf(mxr, __hip_atomic_load(mp + j * BM, __ATOMIC_RELAXED, __HIP_MEMORY_SCOPE_AGENT));
                const float bound = fmaxf(rstd * mxr + maxsh[bt], 1e-20f);
                ST[BM + tid] = 127.f / bound; if (u.pn == 0) sa[u.pm * BM + tid] = bound * (1.f / 127.f); } }
        __syncthreads();
#pragma unroll
        for (int bj = 0; bj < 2; ++bj) {
            f32x4 gg[2], sh[2], sc[2];
#pragma unroll
            for (int n = 0; n < 2; ++n) { const int c = col0 + bj * HALF + 4 * n; gg[n] = *(const f32x4*)(g + c);
                if (MODE == 1) { sh[n] = *(const f32x4*)(shsc + (size_t)bt * MODW + c); sc[n] = *(const f32x4*)(shsc + (size_t)bt * MODW + DM + c) + 1.f; } }
#pragma unroll
            for (int ai = 0; ai < 2; ++ai)
#pragma unroll
                for (int m = 0; m < 4; ++m) { const int rl = ai * HALF + wr * 64 + m * 16 + fr; const float rs = ST[rl]; const size_t off = (size_t)(u.pm * BM + rl) * DM + col0 + bj * HALF;
                    if (MODE == 0) {
#pragma unroll
                        for (int n = 0; n < 2; ++n) *(f32x4*)(xout + off + 4 * n) = (XF(ai, bj, m, n) * rs) * gg[n];
                    } else {
                        const f32x4 y0 = ((XF(ai, bj, m, 0) * rs) * gg[0]) * sc[0] + sh[0], y1 = ((XF(ai, bj, m, 1) * rs) * gg[1]) * sc[1] + sh[1];
                        { const f32x4 x0 = XF(ai, bj, m, 0), x1 = XF(ai, bj, m, 1); u32x4 xw; xw.x = pk_h2(x0.x, x0.y); xw.y = pk_h2(x0.z, x0.w); xw.z = pk_h2(x1.x, x1.y); xw.w = pk_h2(x1.z, x1.w);
                          *(u32x4*)((f16*)xout + off) = xw; }
                        {   const float qs = ST[BM + rl];
                            u32x2 w8; w8.x = q8x4(y0.x * qs, y0.y * qs, y0.z * qs, y0.w * qs); w8.y = q8x4(y1.x * qs, y1.y * qs, y1.z * qs, y1.w * qs);
                            *(u32x2*)((signed char*)h + off) = w8; }
                    }
                    asm volatile("" ::: "memory"); }
        }
    }
#undef XF
#undef XS
};
}


namespace att {
typedef short v4i16_t __attribute__((ext_vector_type(4)));
__device__ __forceinline__ int sw16(int row) { return ((row & 3) << 2) | ((row >> 2) & 3); }
__device__ __forceinline__ int crow(int i, int h) { return (i & 3) + 8 * (i >> 2) + 4 * h; }
__device__ __forceinline__ half4 tr_read(LAS unsigned char* p) { return __builtin_bit_cast(half4, __builtin_amdgcn_ds_read_tr16_b64_v4i16((LAS v4i16_t*)p)); }
__device__ __forceinline__ half8 cat8(half4 a, half4 b) { return __builtin_shufflevector(a, b, 0, 1, 2, 3, 4, 5, 6, 7); }
__device__ __forceinline__ half8 cvt8(const f32x16& x, int s) {
    half8 r;
#pragma unroll
    for (int j = 0; j < 8; ++j) r[j] = (f16)x[8 * s + j];
    return r;
}
struct TileRegs { u32x4 v[8]; };
template <class RowOff> __device__ __forceinline__ void tile_fetch(TileRegs& t, const unsigned char* base, RowOff roff, int lane) {
#pragma unroll
    for (int i = 0; i < 8; ++i) { const int row = (lane >> 4) + 4 * i; const unsigned off = (unsigned)roff(row) + 16u * (unsigned)(lane & 15); t.v[i] = *(const u32x4*)(base + off); }
}
__device__ __forceinline__ void tile_put(const TileRegs& t, LAS unsigned char* tile, int lane) {
#pragma unroll
    for (int i = 0; i < 8; ++i) { const int row = (lane >> 4) + 4 * i; *(LAS u32x4*)(tile + 256 * row + 16 * ((lane & 15) ^ sw16(row))) = t.v[i]; }
}
__device__ __forceinline__ void fetch_rows8(TileRegs& t, const unsigned char* base, const unsigned (&offs)[8], int lane) {
#pragma unroll
    for (int i = 0; i < 8; ++i) t.v[i] = *(const u32x4*)(base + (offs[i] + 16u * (unsigned)(lane & 15)));
}
__device__ __forceinline__ void put_rows8(const TileRegs& t, LAS unsigned char* tile, int lane) {
#pragma unroll
    for (int i = 0; i < 8; ++i) { const int row = 8 * (lane >> 4) + i; *(LAS u32x4*)(tile + 256 * row + 16 * ((lane & 15) ^ sw16(row))) = t.v[i]; }
}
__device__ __forceinline__ void sel_offs8(unsigned (&offs)[8], const LAS unsigned short* sel, int j0, int cnt) {
    const u32x4 w = *(const LAS u32x4*)(sel + j0);
    const unsigned e[8] = {w.x & 0xffffu, w.x >> 16, w.y & 0xffffu, w.y >> 16, w.z & 0xffffu, w.z >> 16, w.w & 0xffffu, w.w >> 16};
#pragma unroll
    for (int i = 0; i < 8; ++i) offs[i] = (j0 + i < cnt ? e[i] : 0u) << 8;
}
__device__ __forceinline__ f32x16 qk_tile(LAS unsigned char* ktile, const half8 (&qf)[8], int lane) {
    const int r = lane & 31, h = lane >> 5, swr = sw16(r);
    f32x16 z;
#pragma unroll
    for (int i = 0; i < 16; ++i) z[i] = 0.f;
#pragma unroll
    for (int st = 0; st < 8; ++st) { const half8 kf = *(const LAS half8*)(ktile + 256 * r + 16 * ((2 * st + h) ^ swr)); z = __builtin_amdgcn_mfma_f32_32x32x16_f16(kf, qf[st], z, 0, 0, 0); }
    return z;
}
__device__ __forceinline__ void tr_addrs(int (&va)[4][2], int lane) {
    const int q = (lane & 15) >> 2, p = lane & 3, g = lane >> 4, h = g >> 1, g1 = g & 1;
#pragma unroll
    for (int mt = 0; mt < 4; ++mt)
#pragma unroll
        for (int sec = 0; sec < 2; ++sec) { const int key = 8 * sec + 4 * h + q, sw = (q << 2) | (2 * sec + h), ch = 4 * mt + 2 * g1 + (p >> 1);
            va[mt][sec] = 256 * key + 16 * (ch ^ sw) + 8 * (p & 1); }
}
__device__ __forceinline__ void pv_tile(f32x16 (&o)[4], LAS unsigned char* vtile, const int (&va)[4][2], const half8 (&wf)[2]) {
#pragma unroll
    for (int ks = 0; ks < 2; ++ks)
#pragma unroll
        for (int mt = 0; mt < 4; ++mt) { const half8 vf = cat8(tr_read(vtile + va[mt][0] + 4096 * ks), tr_read(vtile + va[mt][1] + 4096 * ks));
            o[mt] = __builtin_amdgcn_mfma_f32_32x32x16_f16(vf, wf[ks], o[mt], 0, 0, 0); }
}

__device__ __forceinline__ void sb_item(const f16* __restrict__ P, const f16* __restrict__ ksbc, const f16* __restrict__ vsbc, f16* __restrict__ merged, float* __restrict__ ssq, LAS unsigned char* reg, int b, int hd, int qb, int lane) {
    const int c = lane & 31, h = lane >> 5, t0 = 32 * qb;
    LAS unsigned char* ktile = reg; LAS unsigned char* vtile = reg + 8192;
    half8 qf[8];
    { const f16* qp = P + (size_t)(b * SEQ + t0 + c) * NINP + C_QSB + hd * HD + 8 * h;
#pragma unroll
      for (int st = 0; st < 8; ++st) qf[st] = *(const half8*)(qp + 16 * st); }
    half8 uf[2];
#pragma unroll
    for (int ks = 0; ks < 2; ++ks)
#pragma unroll
        for (int j = 0; j < 8; ++j) uf[ks][j] = (16 * ks + 8 * (j >> 2) + 4 * h + (j & 3)) > c ? (f16)1.f : (f16)0.f;
    int va[4][2]; tr_addrs(va, lane);
    f32x16 o[4];
#pragma unroll
    for (int mt = 0; mt < 4; ++mt)
#pragma unroll
        for (int i = 0; i < 16; ++i) o[mt][i] = 0.f;
    float R = 0.f;
    const unsigned char* kbase = (const unsigned char*)(ksbc + (size_t)(b * NH + hd) * SEQ * HD);
    const unsigned char* vbase = (const unsigned char*)(vsbc + (size_t)(b * NH + hd) * SEQ * HD);
    TileRegs tk, tv;
    tile_fetch(tk, kbase, [&](int row) { return (size_t)(32 * qb + row) * (HD * 2); }, lane);
    for (int kt = qb; kt >= 0; --kt) {
        const int s0 = 32 * kt;
        tile_put(tk, ktile, lane);
        tile_fetch(tv, vbase, [&](int row) { return (size_t)(s0 + row) * (HD * 2); }, lane);
        f32x16 z = qk_tile(ktile, qf, lane);
        f32x16 l, a;
        float lsum = 0.f;
        const bool diag = (kt == qb);
#pragma unroll
        for (int i = 0; i < 16; ++i) { const float zi = z[i]; const float sp = fmaxf(zi, 0.f) + __logf(1.f + __expf(-fabsf(zi)));
            const bool ok = !diag || crow(i, h) < c;
            l[i] = ok ? -sp : 0.f; a[i] = zi - sp; lsum += l[i]; z[i] = ok ? 1.f : 0.f; }
        half8 lf[2] = {cvt8(l, 0), cvt8(l, 1)};
        f32x16 cs;
#pragma unroll
        for (int i = 0; i < 16; ++i) cs[i] = 0.f;
        cs = __builtin_amdgcn_mfma_f32_32x32x16_f16(uf[0], lf[0], cs, 0, 0, 0);
        cs = __builtin_amdgcn_mfma_f32_32x32x16_f16(uf[1], lf[1], cs, 0, 0, 0);
        f32x16 w;
#pragma unroll
        for (int i = 0; i < 16; ++i) w[i] = z[i] != 0.f ? __expf((a[i] + cs[i]) + R) : 0.f;
        half8 wf[2] = {cvt8(w, 0), cvt8(w, 1)};
        tile_put(tv, vtile, lane);
        { const int sn = 32 * (kt > 0 ? kt - 1 : 0); tile_fetch(tk, kbase, [&](int row) { return (size_t)(sn + row) * (HD * 2); }, lane); }
        pv_tile(o, vtile, va, wf);
        R += lsum + __shfl_xor(lsum, 32);
        if (__all(R < -104.f)) break;
    }
    float sq = 0.f;
#pragma unroll
    for (int mt = 0; mt < 4; ++mt)
#pragma unroll
        for (int gI = 0; gI < 4; ++gI) { const f32x16& x = o[mt]; const int i0 = 4 * gI;
            sq += (x[i0] * x[i0] + x[i0 + 1] * x[i0 + 1]) + (x[i0 + 2] * x[i0 + 2] + x[i0 + 3] * x[i0 + 3]);
            u32x2 w2; w2.x = pk_h2(x[i0], x[i0 + 1]); w2.y = pk_h2(x[i0 + 2], x[i0 + 3]);
            *(LAS u32x2*)(reg + 272 * c + 2 * (32 * mt + 8 * gI + 4 * h)) = w2; }
    sq += __shfl_xor(sq, 32);
    if (lane < 32) ssq[(size_t)(b * SEQ + t0 + c) * NH + hd] = sq;
#pragma unroll
    for (int it = 0; it < 8; ++it) { const int row = (lane >> 4) + 4 * it;
        const u32x4 v = *(const LAS u32x4*)(reg + 272 * row + 16 * (lane & 15));
        *(u32x4*)(merged + (size_t)(b * SEQ + t0 + row) * DM + hd * HD + 8 * (lane & 15)) = v; }
}

constexpr int X_HIST = 0, X_SEL = 16384, X_CVAL = 20480, X_CIDX = 22528, X_MM = 24576, X_WSM = 25600;
__device__ __forceinline__ int mbcnt64(unsigned long long m) { return __builtin_amdgcn_mbcnt_hi((unsigned)(m >> 32), __builtin_amdgcn_mbcnt_lo((unsigned)m, 0u)); }
__device__ __forceinline__ float wave_min(float v) {
#pragma unroll
    for (int o = 1; o < 64; o <<= 1) v = fminf(v, __shfl_xor(v, o));
    return v; }
__device__ __forceinline__ float wave_max(float v) {
#pragma unroll
    for (int o = 1; o < 64; o <<= 1) v = fmaxf(v, __shfl_xor(v, o));
    return v; }
__device__ __forceinline__ int binof(float v, float lo, float scale) { const int bq = (int)((v - lo) * scale); return bq > 1023 ? 1023 : bq; }
__device__ __forceinline__ bool topk_fast(const LAS float* sc, int n, float lo, float hi, LAS unsigned* hist, LAS unsigned short* sel, LAS float* cval, LAS unsigned short* cidx, LAS unsigned* ctr, int lane) {
    const float range = hi - lo;
    if (!(range > 1e-30f)) return false;
    const float scale = 512.f / range;
#pragma unroll
    for (int k = 0; k < 8; ++k) hist[lane * 8 + k] = 0u;
    if (lane < 2) ctr[lane] = 0u;
    const int nfull = n >> 8;
    for (int j = 0; j < nfull; ++j) { const f32x4 v4 = *(const LAS f32x4*)(sc + 256 * j + 4 * lane);
#pragma unroll
        for (int e = 0; e < 4; ++e) { int bq = (int)((v4[e] - lo) * scale); bq = bq > 511 ? 511 : bq; (void)__hip_atomic_fetch_add(hist + bq, 1u, __ATOMIC_RELAXED, __HIP_MEMORY_SCOPE_WORKGROUP); } }
    if ((nfull << 8) < n) { const int i0 = 256 * nfull + 4 * lane; const f32x4 v4 = *(const LAS f32x4*)(sc + i0);
#pragma unroll
        for (int e = 0; e < 4; ++e) if (i0 + e < n) { int bq = (int)((v4[e] - lo) * scale); bq = bq > 511 ? 511 : bq; (void)__hip_atomic_fetch_add(hist + bq, 1u, __ATOMIC_RELAXED, __HIP_MEMORY_SCOPE_WORKGROUP); } }
    unsigned wd[8]; int lsum = 0;
#pragma unroll
    for (int k = 0; k < 8; ++k) { wd[k] = hist[lane * 8 + k]; lsum += (int)wd[k]; }
    int incl = lsum;
#pragma unroll
    for (int d = 1; d < 64; d <<= 1) { const int t = __shfl_down(incl, d); if (lane + d < 64) incl += t; }
    const int excl = incl - lsum;
    const bool mine = (excl < TOPK) && (incl >= TOPK);
    int fb = 0, fabove = 0, fcnt = 0, run = excl; bool found = false;
#pragma unroll
    for (int k = 7; k >= 0; --k) { const int cb = (int)wd[k]; const bool hit = !found && (run + cb >= TOPK);
        if (hit) { fb = 8 * lane + k; fabove = run; fcnt = cb; found = true; } if (!found) run += cb; }
    const unsigned long long bm = __ballot(mine);
    const int src = bm ? __builtin_ctzll(bm) : 0;
    const int bstar = __shfl(fb, src), above = __shfl(fabove, src), cntb = __shfl(fcnt, src);
    const int need = TOPK - above;
    const bool all = (cntb == need);
    if (!all && cntb > 64) return false;
    const float T0 = (float)bstar, T1 = all ? T0 : (bstar == 511 ? 3.0e38f : (float)(bstar + 1));
    const unsigned selb = (unsigned)(size_t)sel, trash = (unsigned)(size_t)(cidx + 64 + lane);
    const int nblk = (n + 255) >> 8; int nsel = 0;
    for (int j = 0; j < nblk; ++j) { const int i0 = 256 * j + 4 * lane; const f32x4 v4 = *(const LAS f32x4*)(sc + i0);
        float x[4]; unsigned tk[4]; bool cd[4]; bool anyc = false;
#pragma unroll
        for (int e = 0; e < 4; ++e) { x[e] = (v4[e] - lo) * scale; const bool in = i0 + e < n; tk[e] = (in && x[e] >= T1) ? 1u : 0u; cd[e] = in && !(x[e] >= T1) && x[e] >= T0; anyc = anyc || cd[e]; }
#pragma unroll
        for (int e = 0; e < 4; ++e) { const unsigned long long bt = __ballot(tk[e] != 0u);
            const unsigned addr = tk[e] ? selb + 2u * (unsigned)(nsel + mbcnt64(bt)) : trash; *(LAS unsigned short*)(size_t)addr = (unsigned short)(i0 + e); nsel += __builtin_popcountll(bt); }
        if (__any(anyc)) {
#pragma unroll
            for (int e = 0; e < 4; ++e) if (cd[e]) { const unsigned k = __hip_atomic_fetch_add(ctr + 1, 1u, __ATOMIC_RELAXED, __HIP_MEMORY_SCOPE_WORKGROUP); cval[k] = v4[e]; cidx[k] = (unsigned short)(i0 + e); } }
    }
    if (!all) {
        const float my = lane < cntb ? cval[lane] : 0.f; const int myi = lane < cntb ? (int)cidx[lane] : 0; int rank = 0;
        for (int k = 0; k < cntb; ++k) { const float o = cval[k]; const int oi = (int)cidx[k]; rank += (o > my || (o == my && oi < myi)) ? 1 : 0; }
        const bool take = lane < cntb && rank < need;
        const unsigned long long bt = __ballot(take);
        if (take) sel[above + mbcnt64(bt)] = (unsigned short)myi;
    }
    return true;
}
__device__ __forceinline__ void topk_select(const LAS float* sc, int n, float lo, float hi, LAS unsigned* hist, LAS unsigned short* sel, LAS float* cval, LAS unsigned short* cidx, int lane) {
    int need = TOPK, mode = 2, bstar = 0; float scale = 0.f;
    const int nit = (n + 255) >> 8;
    for (int level = 0; level < 8; ++level) {
        const float range = hi - lo;
        if (!(range > 1e-30f)) { mode = 2; bstar = 0; scale = 0.f; break; }
        scale = 1024.f / range;
#pragma unroll
        for (int k = 0; k < 8; ++k) hist[lane * 8 + k] = 0u;
        for (int j = 0; j < nit; ++j) { const int i0 = 256 * j + 4 * lane; const f32x4 v4 = *(const LAS f32x4*)(sc + i0);
#pragma unroll
            for (int e = 0; e < 4; ++e) { const float v = v4[e];
                if (i0 + e < n && v >= lo && v <= hi) { const int bq = binof(v, lo, scale); (void)__hip_atomic_fetch_add(hist + (bq >> 1), 1u << (16 * (bq & 1)), __ATOMIC_RELAXED, __HIP_MEMORY_SCOPE_WORKGROUP); } } }
        unsigned wd[8]; int lsum = 0;
#pragma unroll
        for (int k = 0; k < 8; ++k) { wd[k] = hist[lane * 8 + k]; lsum += (int)(wd[k] & 0xffffu) + (int)(wd[k] >> 16); }
        int incl = lsum;
#pragma unroll
        for (int d = 1; d < 64; d <<= 1) { const int t = __shfl_down(incl, d); if (lane + d < 64) incl += t; }
        const int excl = incl - lsum;
        const bool mine = (excl < need) && (incl >= need);
        int fb = 0, fabove = 0, fcnt = 0, run = excl; bool found = false;
#pragma unroll
        for (int k = 15; k >= 0; --k) { const int cb = (int)((wd[k >> 1] >> (16 * (k & 1))) & 0xffffu); const bool hit = !found && (run + cb >= need);
            if (hit) { fb = 16 * lane + k; fabove = run; fcnt = cb; found = true; } if (!found) run += cb; }
        const unsigned long long bm = __ballot(mine);
        const int src = bm ? __builtin_ctzll(bm) : 0;
        bstar = __shfl(fb, src); const int above = __shfl(fabove, src), cntb = __shfl(fcnt, src);
        need -= above;
        if (cntb == need) { mode = 1; break; }
        if (cntb <= 64) { mode = 0; break; }
        float cl = 3.0e38f, chh = -3.0e38f;
        for (int i = lane; i < n; i += 64) { const float v = sc[i]; if (v >= lo && v <= hi && binof(v, lo, scale) == bstar) { cl = fminf(cl, v); chh = fmaxf(chh, v); } }
        lo = wave_min(cl); hi = wave_max(chh); mode = 2; bstar = 0; scale = 0.f;
    }
    int nsel = 0, ncand = 0;
    if (mode == 2) {
        for (int i0 = 0; i0 < n; i0 += 64) {
            const int i = i0 + lane; const bool in = i < n; const float v = in ? sc[i] : 0.f;
            const bool inr = in && v >= lo && v <= hi; const int bq = binof(v, lo, scale);
            const bool cand = inr && bq == bstar;
            const unsigned long long bc = __ballot(cand);
            const bool take = (in && (v > hi || (inr && bq > bstar))) || (cand && (ncand + mbcnt64(bc)) < need);
            const unsigned long long bt = __ballot(take);
            if (take) sel[nsel + mbcnt64(bt)] = (unsigned short)i;
            nsel += __builtin_popcountll(bt); ncand += __builtin_popcountll(bc);
        }
        return;
    }
    for (int j = 0; j < nit; ++j) { const int i0 = 256 * j + 4 * lane; const f32x4 v4 = *(const LAS f32x4*)(sc + i0);
#pragma unroll
        for (int e = 0; e < 4; ++e) { const float v = v4[e]; const int i = i0 + e; const bool in = i < n;
            const bool inr = in && v >= lo && v <= hi; const int bq = binof(v, lo, scale);
            const bool cand = inr && bq == bstar;
            const bool take = (in && (v > hi || (inr && bq > bstar))) || (mode == 1 && cand);
            const unsigned long long bt = __ballot(take);
            if (take) sel[nsel + mbcnt64(bt)] = (unsigned short)i;
            nsel += __builtin_popcountll(bt);
            if (mode == 0) { const unsigned long long bc = __ballot(cand);
                if (cand) { const int k = ncand + mbcnt64(bc); cval[k] = v; cidx[k] = (unsigned short)i; }
                ncand += __builtin_popcountll(bc); } } }
    if (mode == 0) {
        const float my = lane < ncand ? cval[lane] : 0.f; const int myi = lane < ncand ? (int)cidx[lane] : 0; int rank = 0;
        for (int k = 0; k < ncand; ++k) { const float o = cval[k]; const int oi = (int)cidx[k]; rank += (o > my || (o == my && oi < myi)) ? 1 : 0; }
        const bool take = lane < ncand && rank < need;
        const unsigned long long bt = __ballot(take);
        if (take) sel[nsel + mbcnt64(bt)] = (unsigned short)myi;
    }
}
template <int VAR> __device__ __forceinline__ void dsa_round(const f16* __restrict__ P, const f16* __restrict__ kdsc, const f16* __restrict__ vdsc, const f16* __restrict__ kix, const float* __restrict__ wix, const float* __restrict__ dsg, f16* __restrict__ merged,
                                          LAS unsigned char* lds, int b, int t0, int nb, int nt0, int wave, int lane_in, int flags) {
    int lane = lane_in; asm volatile("" : "+v"(lane));
    int c = lane & 31, h = lane >> 5;
    LAS float* MM = (LAS float*)(lds + XTRA_OFF + X_MM);
    LAS float* WSM = (LAS float*)(lds + XTRA_OFF + X_WSM);
    {
        half8 aix[4][4];
#pragma unroll
        for (int p = 0; p < 4; ++p) {
            const int query = t0 + 2 * p + ((c >> 2) & 1), head = (c & 3) + 4 * (c >> 3);
            const f16* ap = P + (size_t)(b * SEQ + query) * NINP + C_QIX + head * IXD + 8 * h;
#pragma unroll
            for (int st = 0; st < 4; ++st) aix[p][st] = *(const half8*)(ap + 16 * st);
        }
        float wv[4][16];
#pragma unroll
        for (int p = 0; p < 4; ++p) { const float* wp = wix + (size_t)(b * SEQ + t0 + 2 * p + h) * 16;
#pragma unroll
            for (int i4 = 0; i4 < 4; ++i4) { const f32x4 w4 = *(const f32x4*)(wp + 4 * i4); wv[p][4 * i4] = 0.5f * w4.x; wv[p][4 * i4 + 1] = 0.5f * w4.y; wv[p][4 * i4 + 2] = 0.5f * w4.z; wv[p][4 * i4 + 3] = 0.5f * w4.w; } }
        float mn[4], mx[4];
#pragma unroll
        for (int p = 0; p < 4; ++p) { mn[p] = 3.0e38f; mx[p] = -3.0e38f; }
        const int ntile = (t0 + 8 + 31) >> 5;
        half8 kf[4], kn[4];
        const f16* kp0 = kix + (size_t)(b * SEQ + c) * IXD + 8 * h;
        auto kload = [&](half8 (&dst)[4], int jt) {
#pragma unroll
            for (int st = 0; st < 4; ++st) dst[st] = *(const half8*)(kp0 + (unsigned)(32 * jt * IXD + 16 * st)); };
        auto body = [&](const half8 (&kk)[4], int jt) {
            f32x16 acc[4];
#pragma unroll
            for (int p = 0; p < 4; ++p)
#pragma unroll
                for (int i = 0; i < 16; ++i) acc[p][i] = 0.f;
#pragma unroll
            for (int st = 0; st < 4; ++st)
#pragma unroll
                for (int p = 0; p < 4; ++p) acc[p] = __builtin_amdgcn_mfma_f32_32x32x16_f16(aix[p][st], kk[st], acc[p], 0, 0, 0);
#pragma unroll
            for (int p = 0; p < 4; ++p) {
                float scv = 0.f;
#pragma unroll
                for (int i = 0; i < 16; ++i) scv = __builtin_fmaf(wv[p][i], acc[p][i] + __builtin_fabsf(acc[p][i]), scv);
                *(LAS float*)(lds + (2 * p + h) * 16384 + 4 * (32 * jt + c)) = scv;
                mn[p] = fminf(mn[p], scv); mx[p] = fmaxf(mx[p], scv);
            } };
        const int jlast = ntile - 1;
        kload(kf, wave < jlast ? wave : jlast);
        if (!(flags & 16)) for (int jt = wave; jt < ntile; jt += 2 * NWAVES) {
            const int j1 = jt + NWAVES < jlast ? jt + NWAVES : jlast, j2 = jt + 2 * NWAVES < jlast ? jt + 2 * NWAVES : jlast;
            kload(kn, j1);
            __builtin_amdgcn_sched_barrier(0);
            body(kf, jt);
            kload(kf, j2);
            __builtin_amdgcn_sched_barrier(0);
            body(kn, j1);

        }
#pragma unroll
        for (int p = 0; p < 4; ++p) {
#pragma unroll
            for (int o = 1; o < 32; o <<= 1) { mn[p] = fminf(mn[p], __shfl_xor(mn[p], o)); mx[p] = fmaxf(mx[p], __shfl_xor(mx[p], o)); }
            if (c == 0) { MM[(wave * 8 + 2 * p + h) * 2] = mn[p]; MM[(wave * 8 + 2 * p + h) * 2 + 1] = mx[p]; }
        }
    }
    __syncthreads();
    if (flags & 8) { __syncthreads(); return; }
    const int t = t0 + wave, n = t + 1;
    LAS unsigned char* reg = lds + wave * 16384;
    LAS unsigned short* sel = (LAS unsigned short*)(lds + XTRA_OFF + X_SEL + wave * 512);
    int cnt;
    if (n <= TOPK) { for (int i = lane; i < n; i += 64) sel[i] = (unsigned short)i; cnt = n; }
    else { cnt = TOPK;
        float lo = 3.0e38f, hi = -3.0e38f;
#pragma unroll
        for (int w = 0; w < NWAVES; ++w) { lo = fminf(lo, MM[(w * 8 + wave) * 2]); hi = fmaxf(hi, MM[(w * 8 + wave) * 2 + 1]); }
        LAS unsigned* hist = (LAS unsigned*)(lds + XTRA_OFF + X_HIST + wave * 2048); LAS float* cval = (LAS float*)(lds + XTRA_OFF + X_CVAL + wave * 256);
        LAS unsigned short* cidx = (LAS unsigned short*)(lds + XTRA_OFF + X_CIDX + wave * 256);
        if (!topk_fast((const LAS float*)reg, n, lo, hi, hist, sel, cval, cidx, (LAS unsigned*)(lds + XTRA_OFF + X_WSM + wave * 8), lane))
            topk_select((const LAS float*)reg, n, lo, hi, hist, sel, cval, cidx, lane); }
    if (flags & 4) { __syncthreads(); return; }
    asm volatile("" : "+v"(lane));
    const int cc = lane & 15, g = lane >> 4;
    LAS unsigned char* ktile = reg; LAS unsigned char* vtile = reg + 8192;
    half8 qf[4];
    { const f16* qp = P + (size_t)(b * SEQ + t) * NINP + C_QDS + (cc & 7) * HD + 8 * g;
#pragma unroll
      for (int st = 0; st < 4; ++st) { half8 v = *(const half8*)(qp + 32 * st);
#pragma unroll
          for (int j = 0; j < 8; ++j) v[j] = cc < 8 ? v[j] : (f16)0.f;
          qf[st] = v; } }
    int ka[4], va[8];
    { const int swr = sw16(cc);
#pragma unroll
      for (int st = 0; st < 4; ++st) ka[st] = 256 * cc + 16 * ((4 * st + g) ^ swr);
      const int q = cc >> 2, p = cc & 3, swk = (q << 2) | g;
#pragma unroll
      for (int mt = 0; mt < 8; ++mt) va[mt] = 256 * (4 * g + q) + 16 * ((2 * mt + (p >> 1)) ^ swk) + 8 * (p & 1); }
    f32x4 o[8];
#pragma unroll
    for (int mt = 0; mt < 8; ++mt) o[mt] = (f32x4){0.f, 0.f, 0.f, 0.f};
    float mrun = -1.0e30f, lrun = 0.f;
    const unsigned char* kbase = (const unsigned char*)(kdsc + (size_t)(b * SEQ) * HD);
    const unsigned char* vbase = (const unsigned char*)(vdsc + (size_t)(b * SEQ) * HD);
    const int nch = (cnt + 31) >> 5;
    TileRegs tk, tv;
    unsigned offs[8];
    sel_offs8(offs, sel, 8 * g, cnt);
    fetch_rows8(tk, kbase, offs, lane);
    for (int ch = 0; ch < nch; ++ch) {
        put_rows8(tk, ktile, lane);
        fetch_rows8(tv, vbase, offs, lane);
        f32x4 z0 = {0.f, 0.f, 0.f, 0.f}, z1 = z0;
#pragma unroll
        for (int st = 0; st < 4; ++st) {
            const half8 k0 = *(const LAS half8*)(ktile + ka[st]), k1 = *(const LAS half8*)(ktile + ka[st] + 4096);
            z0 = __builtin_amdgcn_mfma_f32_16x16x32_f16(k0, qf[st], z0, 0, 0, 0);
            z1 = __builtin_amdgcn_mfma_f32_16x16x32_f16(k1, qf[st], z1, 0, 0, 0); }
        float mx = -1.0e30f;
#pragma unroll
        for (int r = 0; r < 4; ++r) { if (32 * ch + 4 * g + r >= cnt) z0[r] = -1.0e30f; if (32 * ch + 16 + 4 * g + r >= cnt) z1[r] = -1.0e30f; mx = fmaxf(mx, fmaxf(z0[r], z1[r])); }
        if (__any(mx > mrun + 8.f)) {
            mx = fmaxf(mx, __shfl_xor(mx, 16)); mx = fmaxf(mx, __shfl_xor(mx, 32));
            const float mnew = fmaxf(mrun, mx), alpha = __expf(mrun - mnew);
            lrun *= alpha; mrun = mnew;
#pragma unroll
            for (int mt = 0; mt < 8; ++mt) o[mt] *= alpha;
        }
        half8 pf;
#pragma unroll
        for (int r = 0; r < 4; ++r) { const float p0 = __expf(z0[r] - mrun), p1 = __expf(z1[r] - mrun); lrun += p0 + p1; pf[r] = (f16)p0; pf[4 + r] = (f16)p1; }
        put_rows8(tv, vtile, lane);
        { const int chn = ch + 1 < nch ? ch + 1 : ch; sel_offs8(offs, sel, 32 * chn + 8 * g, cnt); fetch_rows8(tk, kbase, offs, lane); }
#pragma unroll
        for (int mt = 0; mt < 8; ++mt) { const half8 vf = cat8(tr_read(vtile + va[mt]), tr_read(vtile + va[mt] + 4096));
            o[mt] = __builtin_amdgcn_mfma_f32_16x16x32_f16(vf, pf, o[mt], 0, 0, 0); }
    }
    lrun += __shfl_xor(lrun, 16); lrun += __shfl_xor(lrun, 32);
    const float inv = 1.f / lrun;
    float sq = 0.f;
#pragma unroll
    for (int mt = 0; mt < 8; ++mt) { o[mt] *= inv; sq += (o[mt].x * o[mt].x + o[mt].y * o[mt].y) + (o[mt].z * o[mt].z + o[mt].w * o[mt].w); }
    sq = cc < 8 ? sq : 0.f;
    const float rstd = rsqrtf(wave_sum(sq) * (1.f / 1024.f) + EPS);
    if (cc < 8) {
#pragma unroll
        for (int mt = 0; mt < 8; ++mt) { const int d = 16 * mt + 4 * g; const f32x4 gg = *(const f32x4*)(dsg + cc * HD + d);
            u32x2 w2; w2.x = pk_h2(o[mt].x * rstd * gg.x, o[mt].y * rstd * gg.y); w2.y = pk_h2(o[mt].z * rstd * gg.z, o[mt].w * rstd * gg.w);
            *(u32x2*)(merged + (size_t)(b * SEQ + t) * DM + 1024 + cc * HD + d) = w2; }
    }
    if (nt0 >= 0) {
        int nb2 = nb, nt2 = nt0; asm volatile("" : "+s"(nb2), "+s"(nt2));
        int tid2 = threadIdx.x; asm volatile("" : "+v"(tid2)); const f16* rowp = P + (size_t)(nb2 * SEQ + nt2 + (tid2 >> 5 & 7)) * NINP;
        const void* src = tid2 < 256 ? (const void*)(rowp + C_QIX + (tid2 & 31) * 32) : (const void*)(rowp + C_QDS + (tid2 & 31) * 32);
        __builtin_amdgcn_global_load_lds((const unsigned*)src, (LAS unsigned*)(lds + XTRA_OFF + 26624 + (tid2 >> 6) * 0), 4, 0, 0);
        if (tid2 < 32) __builtin_amdgcn_global_load_lds((const unsigned*)(wix + (size_t)(nb2 * SEQ + nt2) * 16 + tid2 * 4), (LAS unsigned*)(lds + XTRA_OFF + 26624 + 256), 4, 0, 0);
    }
    __syncthreads();
}
}

#define XB_TMO      128
#define XB_XCNT(j)  (256  + 64 * (j))
#define XB_XSUB(j)  (1280 + 64 * (j))
#define XB_XGEN(j)  (2304 + 64 * (j))
#define XB_TOP      3328
#define XB_TOPGEN   3392
#define XCD_BAR_WORDS 3456
#define XB_SPIN_CAP (1u << 18)
__device__ __forceinline__ unsigned xb_ld(unsigned* p)              { return __hip_atomic_load(p, __ATOMIC_RELAXED, __HIP_MEMORY_SCOPE_AGENT); }
__device__ __forceinline__ unsigned xb_add(unsigned* p, unsigned v) { return __hip_atomic_fetch_add(p, v, __ATOMIC_RELAXED, __HIP_MEMORY_SCOPE_AGENT); }
__device__ __forceinline__ unsigned xb_xcc_id() { return (unsigned)__builtin_amdgcn_s_getreg((3 << 11) | 20) & 0xFu; }
#define XB_SPIN(cond, bar) do { unsigned _sp = 0; while (cond) { __builtin_amdgcn_s_sleep(1); \
    if ((++_sp & 255u) == 0u) { if (xb_ld(&(bar)[XB_TMO])) break; if (_sp > XB_SPIN_CAP) { atomicAdd(&(bar)[XB_TMO], 1u); break; } } } } while (0)
struct XcdBarrier { unsigned* bar; unsigned x; volatile LAS unsigned* st; };
__device__ __forceinline__ XcdBarrier xcd_barrier_post(unsigned* bar, volatile LAS unsigned* st) {
    XcdBarrier b; b.bar = bar; b.x = xb_xcc_id(); b.st = st;
    if (threadIdx.x == 0) (void)xb_add(&bar[XB_XCNT(b.x)], 1u);
    return b;
}
__device__ __forceinline__ void xcd_barrier_complete(unsigned* bar, unsigned x, unsigned& nloc, unsigned& nx) {
    const unsigned G = gridDim.x * gridDim.y * gridDim.z;
    unsigned sum, cnt, mine, sp = 0u;
    for (;;) {
        sum = 0u; cnt = 0u; mine = 0u;
#pragma unroll
        for (unsigned j = 0; j < 16; ++j) { const unsigned c = xb_ld(&bar[XB_XCNT(j)]); sum += c; cnt += (c > 0u) ? 1u : 0u; mine = (j == x) ? c : mine; }
        if (sum == G) break;
        __builtin_amdgcn_s_sleep(1);
        if ((++sp & 255u) == 0u) { if (xb_ld(&bar[XB_TMO])) break; if (sp > XB_SPIN_CAP) { atomicAdd(&bar[XB_TMO], 1u); break; } }
    }
    nloc = mine > 0u ? mine : 1u; nx = cnt > 0u ? cnt : 1u;
}
__device__ __forceinline__ void xcd_barrier(const XcdBarrier& b) {
    asm volatile("s_waitcnt vmcnt(0)" ::: "memory");
    __syncthreads();
    if (threadIdx.x == 0) {
        unsigned* bar = b.bar;
        __builtin_amdgcn_s_waitcnt(0);
        unsigned nloc = b.st[0], nx = b.st[1];
        if (nloc == 0u) { xcd_barrier_complete(bar, b.x, nloc, nx); b.st[0] = nloc; b.st[1] = nx; }
        const unsigned old = xb_add(&bar[XB_XSUB(b.x)], 1u);
        const unsigned gen = old / nloc;
        if (old + 1u == (gen + 1u) * nloc) {
            __builtin_amdgcn_fence(__ATOMIC_RELEASE, "agent");
            asm volatile("s_waitcnt vmcnt(0)" ::: "memory");
            const unsigned og = xb_add(&bar[XB_TOP], 1u);
            const unsigned tg = og / nx;
            if (og + 1u == (tg + 1u) * nx) xb_add(&bar[XB_TOPGEN], 1u);
            else XB_SPIN(xb_ld(&bar[XB_TOPGEN]) == tg, bar);
            __builtin_amdgcn_fence(__ATOMIC_ACQUIRE, "agent");
            xb_add(&bar[XB_XGEN(b.x)], 1u);
            asm volatile("s_waitcnt vmcnt(0)" ::: "memory");
        } else {
            XB_SPIN(xb_ld(&bar[XB_XGEN(b.x)]) == gen, bar);
            __builtin_amdgcn_fence(__ATOMIC_ACQUIRE, "agent");
            asm volatile("s_waitcnt vmcnt(0)" ::: "memory");
        }
    }
    __syncthreads();
}

struct Args {
    const float* x; const float* c; const int* pos; const float* w_ada; const float* b_ada; const float* n1g; const float* w_in; const float* sbg; const float* dsg;
    const float* w_out; const float* n2g; const float* w_up; const float* conv_w; const float* conv_b; const float* w_down; const float* fng;
    float* out; unsigned char* ws; int ph_lo, ph_hi, region, pad;
};

struct TrItem { const float* W; f16* WT; const float* gk; const float* q8; int K, N, k0, n0, up, pitch; };
__device__ __forceinline__ TrItem tr_decode(const Args& a, int r, bool fold) {
    constexpr int NB_IN = NINP / 32, I_IN = (DM / 64) * (NINP / 32), I_OUT = (DM / 64) * (DM / 32), I_UP = (DM / 64) * (NUP / 32);
    TrItem t; int nblk;
    t.gk = nullptr; t.q8 = nullptr; t.pitch = 0;
    if (r < I_IN) { t.W = a.w_in; t.WT = (f16*)(a.ws + WS_WTIN); t.K = DM; t.N = NIN; nblk = NB_IN; t.up = 0; }
    else if ((r -= I_IN) < I_OUT) { t.W = a.w_out; t.WT = (f16*)(a.ws + WS_WTOUT); t.K = DM; t.N = DM; nblk = DM / 32; t.up = 0; t.gk = fold ? a.sbg : nullptr; }
    else if ((r -= I_OUT) < I_UP) { t.W = a.w_up; t.WT = (f16*)(a.ws + WS_WTUP); t.K = DM; t.N = NUP; nblk = NUP / 32; t.up = 1; t.q8 = (const float*)((const unsigned*)(a.ws + WS_CTL) + CW_SBMAX); }
    else { r -= I_UP; t.W = a.w_down; t.WT = (f16*)(a.ws + WS_WTDN); t.K = DFF; t.N = DM; nblk = DM / 32; t.up = 0; t.q8 = (const float*)((const unsigned*)(a.ws + WS_CTL) + CW_SDMAX); t.pitch = DFFP; }
    t.k0 = 64 * (r / nblk); t.n0 = 32 * (r % nblk); return t;
}
__device__ __forceinline__ void tr_load(const TrItem& t, f32x4 (&v)[8], int lane) {
    const int n = t.n0 + 4 * (lane & 7); const bool ok = n < t.N;
    const float* p = t.W + (size_t)(t.k0 + (lane >> 3)) * t.N + (ok ? n : 0);
#pragma unroll
    for (int i = 0; i < 8; ++i) { const f32x4 x = __builtin_nontemporal_load((const f32x4*)(p + (size_t)(8 * i) * t.N)); v[i] = ok ? x : (f32x4){0.f, 0.f, 0.f, 0.f}; }
}
__device__ __forceinline__ void tr_store(const TrItem& t, const f32x4 (&v)[8], LAS float* scr, int lane) {
#pragma unroll
    for (int i = 0; i < 8; ++i) { LAS float* d = scr + ((lane >> 3) + 8 * i) * 33 + 4 * (lane & 7); d[0] = v[i].x; d[1] = v[i].y; d[2] = v[i].z; d[3] = v[i].w; }
    asm volatile("s_waitcnt lgkmcnt(0)" ::: "memory");
    const int c = lane & 7;
    f32x4 g0 = {1.f, 1.f, 1.f, 1.f}, g1 = g0;
    if (t.gk && t.k0 < 1024) { g0 = *(const f32x4*)(t.gk + t.k0 + 8 * c); g1 = *(const f32x4*)(t.gk + t.k0 + 8 * c + 4); }
#pragma unroll
    for (int j = 0; j < 4; ++j) { const int nn = (lane >> 3) + 8 * j; const LAS float* sp = scr + (8 * c) * 33 + nn;
        int n = t.n0 + nn;
        if (t.q8) {
            const float inv = 63.5f * __builtin_amdgcn_rcpf(fmaxf(t.q8[n], 1e-20f));
            u32x2 o; o.x = q8x4(sp[0 * 33] * inv, sp[1 * 33] * inv, sp[2 * 33] * inv, sp[3 * 33] * inv); o.y = q8x4(sp[4 * 33] * inv, sp[5 * 33] * inv, sp[6 * 33] * inv, sp[7 * 33] * inv);
            if (t.up) n = n < DFF ? (n / 128) * 256 + (n % 128) : ((n - DFF) / 128) * 256 + 128 + ((n - DFF) % 128);
            *(u32x2*)((unsigned char*)t.WT + (size_t)n * (t.pitch ? t.pitch : t.K) + t.k0 + 8 * c) = o;
        } else {
        u32x4 o; o.x = pk_h2(sp[0 * 33] * g0.x, sp[1 * 33] * g0.y); o.y = pk_h2(sp[2 * 33] * g0.z, sp[3 * 33] * g0.w); o.z = pk_h2(sp[4 * 33] * g1.x, sp[5 * 33] * g1.y); o.w = pk_h2(sp[6 * 33] * g1.z, sp[7 * 33] * g1.w);
        if (t.up) n = n < DFF ? (n / 128) * 256 + (n % 128) : ((n - DFF) / 128) * 256 + 128 + ((n - DFF) % 128);
        *(u32x4*)(t.WT + (size_t)n * t.K + t.k0 + 8 * c) = o; } }
    asm volatile("s_waitcnt lgkmcnt(0)" ::: "memory");
}
constexpr int ADA_KC = 32, ADA_ROWS = DM / ADA_KC;
__device__ __forceinline__ void p0_ada_item(const float* __restrict__ w_ada, const float* __restrict__ b_ada, const LAS float* sil, float* __restrict__ modp, float* __restrict__ mod, unsigned* cnt, int item, int lane) {
    const int kc = item / 48, jc = item % 48, j0 = jc * 256 + lane * 4;
    f32x4 a0 = {0.f, 0.f, 0.f, 0.f}, a1 = {0.f, 0.f, 0.f, 0.f};
    const float* wp = w_ada + (size_t)(kc * ADA_ROWS) * MODW + j0;
#pragma unroll 32
    for (int k = 0; k < ADA_ROWS; ++k) { const f32x4 w = __builtin_nontemporal_load((const f32x4*)(wp + (size_t)k * MODW)); const float s0 = sil[kc * ADA_ROWS + k], s1 = sil[DM + kc * ADA_ROWS + k]; a0 += w * s0; a1 += w * s1; }
    { float* p0 = modp + (size_t)(kc * 2 + 0) * MODW + j0; float* p1 = modp + (size_t)(kc * 2 + 1) * MODW + j0;
#pragma unroll
      for (int e = 0; e < 4; ++e) { __hip_atomic_store(p0 + e, a0[e], __ATOMIC_RELAXED, __HIP_MEMORY_SCOPE_AGENT); __hip_atomic_store(p1 + e, a1[e], __ATOMIC_RELAXED, __HIP_MEMORY_SCOPE_AGENT); } }
    asm volatile("s_waitcnt vmcnt(0)" ::: "memory");
    unsigned old = 0u;
    if (lane == 0) old = __hip_atomic_fetch_add(cnt + 64 * jc, 1u, __ATOMIC_RELAXED, __HIP_MEMORY_SCOPE_AGENT);
    old = (unsigned)__builtin_amdgcn_readfirstlane((int)old);
    if (old == (unsigned)(ADA_KC - 1)) {
        const f32x4 bias = *(const f32x4*)(b_ada + j0);
        f32x4 s0 = bias, s1 = bias;
#pragma unroll 4
        for (int k2 = 0; k2 < ADA_KC; ++k2) { const float* p0 = modp + (size_t)(k2 * 2 + 0) * MODW + j0; const float* p1 = modp + (size_t)(k2 * 2 + 1) * MODW + j0;
#pragma unroll
            for (int e = 0; e < 4; ++e) { s0[e] += __hip_atomic_load(p0 + e, __ATOMIC_RELAXED, __HIP_MEMORY_SCOPE_AGENT); s1[e] += __hip_atomic_load(p1 + e, __ATOMIC_RELAXED, __HIP_MEMORY_SCOPE_AGENT); } }
        *(f32x4*)(mod + j0) = s0; *(f32x4*)(mod + MODW + j0) = s1;
    }
}
__device__ __forceinline__ void tr_run(const Args& a, LAS float* scr, int base, int it0, int stride, int cnt, int lane, bool fold) {
    if (cnt <= 0) return;
    f32x4 v0[8], v1[8], v2[8];
    TrItem c0 = tr_decode(a, base + it0, fold), c1 = c0, c2 = c0;
    tr_load(c0, v0, lane);
    if (cnt > 1) { c1 = tr_decode(a, base + it0 + stride, fold); tr_load(c1, v1, lane); }
    for (int q = 0; q < cnt; ++q) {
        if (q + 2 < cnt) { c2 = tr_decode(a, base + it0 + (q + 2) * stride, fold); tr_load(c2, v2, lane); }
        tr_store(c0, v0, scr, lane);
        c0 = c1; c1 = c2;
#pragma unroll
        for (int i = 0; i < 8; ++i) { v0[i] = v1[i]; v1[i] = v2[i]; }
    }
}
constexpr int UP_DEFER = 4992;
constexpr int TR_I_IN = (DM / 64) * (NINP / 32), TR_I_OUT = (DM / 64) * (DM / 32), TR_I_UP = (DM / 64) * (NUP / 32), TR_I_DN = (DFF / 64) * (DM / 32);
__device__ __forceinline__ void tr_deferred(const Args& a, LAS unsigned char* lds, int base, int nitems, int nwg, int G, int wave, int lane) {
    const int busy = nwg % G;
    const int nidle = busy ? G - busy : G, me = busy ? (int)blockIdx.x - busy : (int)blockIdx.x;
    if (me < 0) return;
    const int it0 = me * NWAVES + wave, stride = nidle * NWAVES;
    tr_run(a, (LAS float*)(lds + wave * 16384), base, it0, stride, (nitems - it0 + stride - 1) / stride, lane, false);
}
__device__ __forceinline__ void phase0(const Args& a, LAS unsigned char* lds, int vcu, int G, int wave, int lane, bool fold) {
    unsigned char* ws = a.ws;
    LAS float* sil = (LAS float*)(lds + XTRA_OFF);
    for (int e = threadIdx.x; e < BATCH * DM; e += NWAVES * 64) sil[e] = silu_f(a.c[e]);
    __syncthreads();
    LAS float* scr = (LAS float*)(lds + wave * 16384);
    const int gw = vcu * NWAVES + wave, NGW = G * NWAVES;
    float* modp = (float*)(ws + WS_MODP);
    constexpr int NADA = ADA_KC * 48, HW = 6, HS = 2, NITEMS = TR_I_IN;
    if (wave < HW) for (int it = vcu * HW + wave; it < NADA; it += G * HW) p0_ada_item(a.w_ada, a.b_ada, sil, modp, (float*)(ws + WS_MOD), (unsigned*)(ws + WS_CTL) + CW_ADA, it, lane);
    const int nheavy = G * HW, nlight = G * (NWAVES - HW);
    const int nh_items = nheavy * HS < NITEMS ? nheavy * HS : NITEMS;
    int it0, stride, cnt;
    if (wave < HW) { it0 = (NITEMS - nh_items) + (vcu * HW + wave) * HS; stride = 1; cnt = HS; if (it0 + cnt > NITEMS) cnt = NITEMS - it0 > 0 ? NITEMS - it0 : 0; }
    else { it0 = vcu * (NWAVES - HW) + (wave - HW); stride = nlight; cnt = (NITEMS - nh_items - it0 + stride - 1) / stride; if (cnt < 0) cnt = 0; }
    tr_run(a, scr, 0, it0, stride, cnt, lane, fold);
    { unsigned* sbmax = (unsigned*)(ws + WS_CTL) + CW_SBMAX;
      for (int e = (vcu * NWAVES + wave) * 64 + lane; e < NUP * 16; e += NGW * 64) { const int n = e % NUP, rg = e / NUP; float mx = 0.f;
#pragma unroll
          for (int k = 0; k < 8; ++k) mx = fmaxf(mx, fabsf(a.w_up[(size_t)(rg * 8 + k) * NUP + n]));
          (void)__hip_atomic_fetch_max(sbmax + n, __builtin_bit_cast(unsigned, mx), __ATOMIC_RELAXED, __HIP_MEMORY_SCOPE_AGENT); } }
    { unsigned* sdmax = (unsigned*)(ws + WS_CTL) + CW_SDMAX;
      for (int e = (vcu * NWAVES + wave) * 64 + lane; e < DM * 16; e += NGW * 64) { const int n = e % DM, rg = e / DM; float mx = 0.f;
#pragma unroll
          for (int k = 0; k < 8; ++k) mx = fmaxf(mx, fabsf(a.w_down[(size_t)(rg * 8 + k) * DM + n]));
          (void)__hip_atomic_fetch_max(sdmax + n, __builtin_bit_cast(unsigned, mx), __ATOMIC_RELAXED, __HIP_MEMORY_SCOPE_AGENT); } }
    float* rope = (float*)(ws + WS_ROPE);
    for (int idx = (vcu * NWAVES + wave) * 64 + lane; idx < MTOK * 24; idx += NGW * 64) {
        const int m = idx / 24, i = idx % 24;
        const float inv = i < 16 ? INV128[i] : INV64[i - 16];
        const float ang = (float)a.pos[m] * inv;
        const double rev = (double)ang * 0.15915494309189535;
        const float r = (float)((rev - floor(rev)) * 6.283185307179586);
        *(float2*)(rope + (size_t)idx * 2) = make_float2(cosf(r), sinf(r));
    }
}
__device__ __forceinline__ void hrows(const float* __restrict__ x, const float* __restrict__ g, const LAS float* S1, f16* __restrict__ H, int gw, int NGW, int lane) {
    for (int m0 = gw; m0 < MTOK; m0 += 2 * NGW) {
        const int m1 = m0 + NGW < MTOK ? m0 + NGW : m0;
        f32x4 v[2][8];
#pragma unroll
        for (int r = 0; r < 2; ++r) { const f32x4* xr = (const f32x4*)(x + (size_t)(r ? m1 : m0) * DM) + lane;
#pragma unroll
            for (int j = 0; j < 8; ++j) v[r][j] = __builtin_nontemporal_load(xr + 64 * j); }
#pragma unroll
        for (int r = 0; r < 2; ++r) {
            const int m = r ? m1 : m0; const int b = m / SEQ;
            float ss = 0.f;
#pragma unroll
            for (int j = 0; j < 8; ++j) ss += (v[r][j].x * v[r][j].x + v[r][j].y * v[r][j].y) + (v[r][j].z * v[r][j].z + v[r][j].w * v[r][j].w);
            const float rstd = rsqrtf(wave_sum(ss) * (1.f / DM) + EPS);
            u32x2* o8 = (u32x2*)(H + (size_t)m * DM) + lane;
#pragma unroll
            for (int j = 0; j < 8; ++j) { const int k = 4 * (lane + 64 * j);
                const f32x4 gg = *(const f32x4*)(g + k); const f32x4 sh = *(const LAS f32x4*)(S1 + b * 4096 + k), sc = *(const LAS f32x4*)(S1 + b * 4096 + 2048 + k);
                const f32x4 y = ((v[r][j] * rstd) * gg) * (sc + 1.f) + sh;
                u32x2 w; w.x = pk_h2(y.x, y.y); w.y = pk_h2(y.z, y.w); o8[64 * j] = w; }
        }
    }
}
__device__ __forceinline__ void hrows1(const float* __restrict__ x, const float* __restrict__ g, const LAS float* S1, f16* __restrict__ H, int gw, int NGW, int lane) {
    for (int m = gw; m < MTOK; m += NGW) {
        const int b = m / SEQ;
        const f32x4* xr = (const f32x4*)(x + (size_t)m * DM) + lane;
        f32x4 v[8]; float ss = 0.f;
#pragma unroll
        for (int j = 0; j < 8; ++j) { v[j] = xr[64 * j]; ss += (v[j].x * v[j].x + v[j].y * v[j].y) + (v[j].z * v[j].z + v[j].w * v[j].w); }
        const float rstd = rsqrtf(wave_sum(ss) * (1.f / DM) + EPS);
        u32x2* o8 = (u32x2*)(H + (size_t)m * DM) + lane;
#pragma unroll
        for (int j = 0; j < 8; ++j) { const int k = 4 * (lane + 64 * j);
            const f32x4 gg = *(const f32x4*)(g + k); const f32x4 sh = *(const LAS f32x4*)(S1 + b * 4096 + k), sc = *(const LAS f32x4*)(S1 + b * 4096 + 2048 + k);
            const f32x4 y = ((v[j] * rstd) * gg) * (sc + 1.f) + sh;
            u32x2 w; w.x = pk_h2(y.x, y.y); w.y = pk_h2(y.z, y.w); o8[64 * j] = w; }
    }
}
__device__ __forceinline__ void phase1(const Args& a, LAS unsigned char* lds, int vcu, int G, int wave, int lane) {
    unsigned char* ws = a.ws;
    const float* mod = (const float*)(ws + WS_MOD);
    LAS float* S1 = (LAS float*)lds;
    for (int e = threadIdx.x; e < 2 * 4096; e += NWAVES * 64) { const int b = e >> 12, j = e & 4095; S1[e] = mod[(size_t)b * MODW + j]; }
    __syncthreads();
    if (blockIdx.x == 0 && wave == 0) {
#pragma unroll
        for (int b = 0; b < BATCH; ++b) { float mx = 0.f;
            for (int j = lane; j < DM; j += 64) mx = fmaxf(mx, fabsf(mod[(size_t)b * MODW + 3 * DM + j]));
#pragma unroll
            for (int o = 1; o < 64; o <<= 1) mx = fmaxf(mx, __shfl_xor(mx, o));
            if (lane == 0) ((float*)(ws + WS_MAXSH))[b] = mx; } }
    hrows(a.x, a.n1g, S1, (f16*)(ws + WS_H), vcu * NWAVES + wave, G * NWAVES, lane);
}

__global__ void __launch_bounds__(NWAVES * 64, 2) mega(Args a) {
    extern __shared__ __attribute__((aligned(16))) unsigned char lds_raw[];
    LAS unsigned char* lds = (LAS unsigned char*)lds_raw;
    volatile LAS unsigned* MISC = (volatile LAS unsigned*)(lds + MISC_OFF);
    int tid = threadIdx.x; const int wave = __builtin_amdgcn_readfirstlane(tid >> 6); int lane = tid & 63;
#define FRESH() do { tid = threadIdx.x; asm volatile("" : "+v"(tid)); lane = tid & 63; } while (0)
    const int G = gridDim.x; const bool fuse = true;
    const int vcu = (G % 8 == 0) ? (blockIdx.x % 8) * (G / 8) + blockIdx.x / 8 : blockIdx.x;
    if (tid < 64) MISC[tid] = 0u;
    __syncthreads();
    unsigned* ctl = (unsigned*)(a.ws + WS_CTL);
    XcdBarrier bar = xcd_barrier_post(ctl + CW_BAR + a.region * XCD_BAR_WORDS, MISC + 8);
    const int lo = a.ph_lo, hi = a.ph_hi;
#define IN(k) (lo <= (k) && (k) < hi)
#define SEAM(k) do { if (IN(k) && IN((k) + 1)) xcd_barrier(bar); } while (0)
    if (IN(0)) { FRESH(); phase0(a, lds, vcu, G, wave, lane, fuse); } SEAM(0);
    if (IN(1)) { FRESH(); phase1(a, lds, vcu, G, wave, lane); } SEAM(1);
    if (IN(2)) { FRESH();
        pg8::Gemm g{(const f16*)(a.ws + WS_H), (const f16*)(a.ws + WS_WTIN), MTOK, NINP, DM}; pg8::StaticOrder S; S.init(MTOK, NINP, G, (int)blockIdx.x);
        pg8::EpiProjF E{(f16*)(a.ws + WS_PROJ), (f16*)(a.ws + WS_KIX), (float*)(a.ws + WS_WIX), (const float*)(a.ws + WS_ROPE), (f16*)(a.ws + WS_KSBC), (f16*)(a.ws + WS_VSBC), (f16*)(a.ws + WS_KDSC), (f16*)(a.ws + WS_VDSC)};
        pg8::gemm_phase<pg8::EpiProjF, pg8::StaticOrder, true, true>(lds, g, S, E);
        FRESH(); tr_deferred(a, lds, TR_I_IN + TR_I_OUT, UP_DEFER, (MTOK / 256) * (NINP / 256), G, wave, lane);
    } SEAM(2);
    if (IN(3)) { FRESH();
        const f16* P = (const f16*)(a.ws + WS_PROJ);
        auto up_share = [&]() {
            int l2 = threadIdx.x; asm volatile("" : "+v"(l2)); l2 &= 63;
            const int it0 = vcu * NWAVES + wave, stride = G * NWAVES, nit = TR_I_UP - UP_DEFER;
            tr_run(a, (LAS float*)(lds + wave * 16384), TR_I_IN + TR_I_OUT + UP_DEFER, it0, stride, (nit - it0 + stride - 1) / stride, l2, false);
            tr_run(a, (LAS float*)(lds + wave * 16384), TR_I_IN, it0, stride, (TR_I_OUT - it0 + stride - 1) / stride, l2, fuse); };
        if (wave < 4) up_share();
        if (!(a.pad & 1)) for (int it = vcu * NWAVES + wave; it < BATCH * NH * (SEQ / 32); it += G * NWAVES) {
            const int qb = it % (SEQ / 32), hd = (it / (SEQ / 32)) % NH, b = it / ((SEQ / 32) * NH);
            att::sb_item(P, (const f16*)(a.ws + WS_KSBC), (const f16*)(a.ws + WS_VSBC), (f16*)(a.ws + WS_MERGED), (float*)(a.ws + WS_SSQ), lds + wave * 16384, b, hd, qb, lane);
        }
        if (wave >= 4) up_share();
        __syncthreads();
        if (!(a.pad & 2)) for (int k = vcu; k < BATCH * (SEQ / 8); k += G) {
            auto decode = [&](int kk, int& bb, int& tt0) { bb = kk / (SEQ / 8); const int r = kk % (SEQ / 8); tt0 = 8 * (r < SEQ / 16 ? r : (SEQ / 8 - 1) - (r - SEQ / 16)); };
            int b, t0, nb = 0, nt0 = -1; decode(k, b, t0);
            if (k + G < BATCH * (SEQ / 8)) decode(k + G, nb, nt0);
            att::dsa_round<0>(P, (const f16*)(a.ws + WS_KDSC), (const f16*)(a.ws + WS_VDSC), (const f16*)(a.ws + WS_KIX), (const float*)(a.ws + WS_WIX), a.dsg, (f16*)(a.ws + WS_MERGED), lds, b, t0, nb, nt0, wave, lane, a.pad);
        }
    } SEAM(3);
    if (IN(5)) { FRESH();
        pg8::Gemm g{(const f16*)(a.ws + WS_MERGED), (const f16*)(a.ws + WS_WTOUT), MTOK, DM, DM}; pg8::StaticOrder S; S.init(MTOK, DM, G, (int)blockIdx.x);
        const float* mod = (const float*)(a.ws + WS_MOD);
        pg8::EpiResidNorm<1> E{a.x, mod + 2 * DM, a.n2g, mod + 3 * DM, (float*)(a.ws + WS_X1), (f16*)(a.ws + WS_H), (float*)(a.ws + WS_XCH), ctl + CW_XCNT, (const float*)(a.ws + WS_SSQ), (float*)(a.ws + WS_XCH2), (float*)(a.ws + WS_SA), (const float*)(a.ws + WS_MAXSH)};
        pg8::gemm_phase<pg8::EpiResidNorm<1>, pg8::StaticOrder, false, true>(lds, g, S, E);
    } SEAM(6);
    if (IN(7)) { FRESH();
        pg8::Gemm g{(const f16*)(a.ws + WS_H), (const f16*)(a.ws + WS_WTUP), MTOK, NUP, DM / 2}; pg8::StaticOrder S; S.init(MTOK, NUP, G, (int)blockIdx.x);
        pg8::EpiUpConv E{a.conv_w, a.conv_b, (f16*)(a.ws + WS_ACT), (float*)(a.ws + WS_UH), (const float*)(a.ws + WS_SA), (const float*)((const unsigned*)(a.ws + WS_CTL) + CW_SBMAX)};
        pg8::gemm_phase<pg8::EpiUpConv, pg8::StaticOrder, true, true>(lds, g, S, E);
        FRESH(); tr_deferred(a, lds, TR_I_IN + TR_I_OUT + TR_I_UP, TR_I_DN, (MTOK / 256) * (NUP / 256), G, wave, lane);
        for (int e = blockIdx.x * (NWAVES * 64) + tid; e < DM * 8; e += G * NWAVES * 64) *(u32x4*)(a.ws + WS_WTDN + (size_t)(e >> 3) * DFFP + DFF + 16 * (e & 7)) = (u32x4){0u, 0u, 0u, 0u};
    } SEAM(7);
    if (IN(8)) { FRESH();
        const float* uh = (const float*)(a.ws + WS_UH); f16* act = (f16*)(a.ws + WS_ACT); unsigned char* act8 = (unsigned char*)(a.ws + WS_ACT8); float* sact = (float*)(a.ws + WS_SACT);
        for (int blk = vcu; blk < MTOK / 32; blk += G) {
            const int mb = blk * 32;
            if ((mb & 63) == 0) {
                const int chunk = mb >> 6; const bool first = (chunk % (SEQ / 64)) == 0;
                for (int e = tid; e < DFF / 4; e += NWAVES * 64) { const int ch = 4 * e;
                    f32x4 r0, r1;
#pragma unroll
                    for (int gv = 0; gv < 2; ++gv) { const int c = gv * DFF + ch; const f32x4 z4 = {0.f, 0.f, 0.f, 0.f};
                        const f32x4 um2 = first ? z4 : *(const f32x4*)(uh + (size_t)((chunk - 1) * 4 + 2) * NUP + c), um1 = first ? z4 : *(const f32x4*)(uh + (size_t)((chunk - 1) * 4 + 3) * NUP + c);
                        const f32x4 u0 = *(const f32x4*)(uh + (size_t)(chunk * 4 + 0) * NUP + c), u1 = *(const f32x4*)(uh + (size_t)(chunk * 4 + 1) * NUP + c);
                        const f32x4 k0 = *(const f32x4*)(a.conv_w + c), k1 = *(const f32x4*)(a.conv_w + NUP + c), k2 = *(const f32x4*)(a.conv_w + 2 * NUP + c), bz = *(const f32x4*)(a.conv_b + c);
                        const f32x4 y0 = bz + k0 * um2 + k1 * um1 + k2 * u0, y1 = bz + k0 * um1 + k1 * u0 + k2 * u1;
                        if (gv == 0) {
#pragma unroll
                            for (int j = 0; j < 4; ++j) { r0[j] = pg8::silu_fast(y0[j]); r1[j] = pg8::silu_fast(y1[j]); }
                        } else { r0 *= y0; r1 *= y1; } }
                    u32x2 w0, w1; w0.x = pk_h2(r0.x, r0.y); w0.y = pk_h2(r0.z, r0.w); w1.x = pk_h2(r1.x, r1.y); w1.y = pk_h2(r1.z, r1.w);
                    *(u32x2*)(act + (size_t)mb * DFF + ch) = w0; *(u32x2*)(act + (size_t)(mb + 1) * DFF + ch) = w1; }
                asm volatile("s_waitcnt vmcnt(0)" ::: "memory");
            }
            __syncthreads();
#pragma unroll 1
            for (int pr = 0; pr < 2; ++pr) {
                const int m0 = mb + wave * 4 + 2 * pr;
                half8 v[2][11]; float mx[2] = {0.f, 0.f};
#pragma unroll
                for (int r = 0; r < 2; ++r)
#pragma unroll
                    for (int j = 0; j < 11; ++j) { const int cidx = lane + 64 * j;
                        v[r][j] = cidx < DFF / 8 ? *(const half8*)(act + (size_t)(m0 + r) * DFF + 8 * cidx) : (half8){0, 0, 0, 0, 0, 0, 0, 0}; }
#pragma unroll
                for (int r = 0; r < 2; ++r) {
#pragma unroll
                    for (int j = 0; j < 11; ++j)
#pragma unroll
                        for (int e = 0; e < 8; ++e) mx[r] = fmaxf(mx[r], fabsf((float)v[r][j][e]));
#pragma unroll
                    for (int o = 1; o < 64; o <<= 1) mx[r] = fmaxf(mx[r], __shfl_xor(mx[r], o));
                    mx[r] = fmaxf(mx[r], 1e-20f); const float qs = 127.f / mx[r];
                    unsigned char* orow = act8 + (size_t)(m0 + r) * DFFP;
#pragma unroll
                    for (int j = 0; j < 11; ++j) { const int cidx = lane + 64 * j;
                        if (cidx < DFF / 8) { u32x2 w; w.x = q8x4((float)v[r][j][0] * qs, (float)v[r][j][1] * qs, (float)v[r][j][2] * qs, (float)v[r][j][3] * qs);
                            w.y = q8x4((float)v[r][j][4] * qs, (float)v[r][j][5] * qs, (float)v[r][j][6] * qs, (float)v[r][j][7] * qs); *(u32x2*)(orow + 8 * cidx) = w; } }
                    if (lane < 8) *(u32x4*)(orow + DFF + 16 * lane) = (u32x4){0u, 0u, 0u, 0u};
                    if (lane == 0) sact[m0 + r] = mx[r] * (1.f / 127.f);
                }
            }
            __syncthreads();
        }
    } SEAM(8);
    if (IN(9)) { FRESH();
        pg8::Gemm g{(const f16*)(a.ws + WS_ACT8), (const f16*)(a.ws + WS_WTDN), MTOK, DM, DFFP / 2}; pg8::StaticOrder S; S.init(MTOK, DM, G, (int)blockIdx.x);
        const float* mod = (const float*)(a.ws + WS_MOD);
        pg8::EpiResidNorm<0> E{(const float*)(a.ws + WS_X1), mod + 5 * DM, a.fng, nullptr, a.out, nullptr, (float*)(a.ws + WS_XCH) + 32 * 8 * 256, ctl + CW_XCNT + 32 * 64, nullptr, nullptr, (float*)(a.ws + WS_SACT), (const float*)((const unsigned*)(a.ws + WS_CTL) + CW_SDMAX)};
        pg8::gemm_phase<pg8::EpiResidNorm<0>, pg8::StaticOrder, false, true>(lds, g, S, E);
    }
#undef IN
#undef SEAM
}

extern "C" void kernel_launch(void* const* d_in, const int* in_sizes, int n_in, void* d_out, int out_size, void* d_ws, size_t ws_size, hipStream_t stream) {
    if (n_in != 16 || ws_size < WS_END) { fprintf(stderr, "kernel_launch: unexpected n_in %d / ws %zu\n", n_in, ws_size); return; }
    const float* x = (const float*)d_in[0]; const float* c = (const float*)d_in[1]; const int* pos = (const int*)d_in[2];
    const float* w_ada = (const float*)d_in[3]; const float* b_ada = (const float*)d_in[4]; const float* n1g = (const float*)d_in[5];
    const float* w_in = (const float*)d_in[6]; const float* sbg = (const float*)d_in[7]; const float* dsg = (const float*)d_in[8];
    const float* w_out = (const float*)d_in[9]; const float* n2g = (const float*)d_in[10]; const float* w_up = (const float*)d_in[11];
    const float* conv_w = (const float*)d_in[12]; const float* conv_b = (const float*)d_in[13]; const float* w_down = (const float*)d_in[14];
    const float* fng = (const float*)d_in[15];
    unsigned char* ws = (unsigned char*)d_ws; float* out = (float*)d_out;
    static int grid = 0;
    if (grid == 0) {
        int dev = 0, cus = 0;
        if (hipGetDevice(&dev) != hipSuccess || hipDeviceGetAttribute(&cus, hipDeviceAttributeMultiprocessorCount, dev) != hipSuccess) { fprintf(stderr, "kernel_launch: device query failed\n"); grid = -1; return; }
        if (hipFuncSetAttribute((const void*)mega, hipFuncAttributeMaxDynamicSharedMemorySize, LDS_BYTES) != hipSuccess) { fprintf(stderr, "kernel_launch: hipFuncSetAttribute failed\n"); grid = -1; return; }
        int per_cu = 0; (void)hipOccupancyMaxActiveBlocksPerMultiprocessor(&per_cu, (const void*)mega, NWAVES * 64, LDS_BYTES); (void)hipGetLastError();
        if (per_cu < 1) fprintf(stderr, "kernel_launch: occupancy query reports %d blocks/CU\n", per_cu);
        grid = cus;
        if (cus != (MTOK / 256) * (DM / 256)) { fprintf(stderr, "kernel_launch: built for a %d-CU device (one out-projection / down-projection unit per workgroup); found %d CUs; nothing launched\n", (MTOK / 256) * (DM / 256), cus); grid = -1; }
    }
    if (grid < 0) return;
    (void)hipMemsetAsync(ws + WS_CTL, 0, 1 * MiB, stream);
    Args a{};
    a.x = x; a.c = c; a.pos = pos; a.w_ada = w_ada; a.b_ada = b_ada; a.n1g = n1g; a.w_in = w_in; a.sbg = sbg; a.dsg = dsg; a.w_out = w_out; a.n2g = n2g; a.w_up = w_up;
    a.conv_w = conv_w; a.conv_b = conv_b; a.w_down = w_down; a.fng = fng; a.out = out; a.ws = ws;
    auto run = [&](int lo, int hi, int region) { a.ph_lo = lo; a.ph_hi = hi; a.region = region; hipLaunchKernelGGL(mega, dim3(grid), dim3(NWAVES * 64), LDS_BYTES, stream, a); };
    run(0, 11, 0);
#ifdef PROBE_LO
    a.pad = PROBE_FLAGS; run(PROBE_LO, PROBE_HI, 1);
#endif
}
```

```cpp
#include <hip/hip_runtime.h>
#include <cstdio>

typedef _Float16 f16;

constexpr int BATCH = 2, SEQ = 4096, DM = 2048, MTOK = BATCH * SEQ;
constexpr int HD = 128, NH = 8, IXH = 16, IXD = 64, TOPK = 256;
constexpr int DFF = 5504, NUP = 2 * DFF;
constexpr int NIN = 5456, NINP = 5632;
constexpr int C_QSB = 0, C_KSB = 1024, C_VSB = 2048, C_QDS = 3072, C_KDS = 4096, C_VDS = 4224, C_QIX = 4352, C_KIX = 5376, C_WIX = 5440;
constexpr int MODW = 6 * DM;
constexpr float EPS = 1e-6f;
constexpr float QSCALE = 0.08838834764831845f;
constexpr float IDX_SCALE = 0.03125f;

__constant__ float INV128[16] = {1.0f, 0.44036659598350525f, 0.1939227432012558f, 0.08539710193872452f, 0.03760603070259094f, 0.01656043902039528f, 0.007292664609849453f, 0.0032114458736032248f,
                                 0.0014142135623842478f, 0.000622772378847003f, 0.00027424818836152554f, 0.00012076973507646471f, 5.318296098266728e-05f, 2.34199997066753e-05f, 1.0313386155758053e-05f, 4.541670477919979e-06f};
__constant__ float INV64[8] = {1.0f, 0.1939227432012558f, 0.03760603070259094f, 0.007292664609849453f, 0.0014142135623842478f, 0.00027424818836152554f, 5.318296098266728e-05f, 1.0313386155758053e-05f};

constexpr size_t MiB = 1u << 20;
constexpr size_t WS_CTL = 0;
constexpr size_t WS_MOD = 1 * MiB;
constexpr size_t WS_MODP = 380 * MiB;
constexpr size_t WS_ROPE = 4 * MiB;
constexpr size_t WS_XCH = 3 * MiB + 512 * 1024;
constexpr size_t WS_SA = 6 * MiB + 768 * 1024;
constexpr size_t WS_SAH = WS_SA + 160 * 1024;
constexpr size_t WS_H8IN = 135 * MiB;
constexpr size_t WS_WTIN8 = 16 * MiB;
constexpr int IN8_LO = 2048, IN8_HI = 4352, IN8_NB = (IN8_HI - IN8_LO) / 32;
constexpr size_t WS_SACT = WS_SA + 64 * 1024;
constexpr size_t WS_MAXSH = WS_SA + 128 * 1024;
constexpr size_t WS_XCH2 = 383 * MiB;
constexpr size_t WS_SSQ = 6 * MiB + 512 * 1024;
constexpr size_t WS_WIX = 6 * MiB;
constexpr size_t WS_KIX = 7 * MiB;
constexpr size_t WS_WTIN = 8 * MiB;
constexpr size_t WS_WTOUT = 30 * MiB;
constexpr size_t WS_WTUP = 38 * MiB;
constexpr size_t WS_WTDN = 81 * MiB;
constexpr size_t WS_H = 103 * MiB;
constexpr size_t WS_X1 = 135 * MiB;
constexpr size_t WS_PROJ = 199 * MiB;
constexpr size_t WS_ACT = WS_PROJ;
constexpr size_t WS_MERGED = 287 * MiB;
constexpr size_t WS_FREE = 319 * MiB;
constexpr size_t WS_OSB32 = 319 * MiB;
constexpr size_t WS_ODS32 = 351 * MiB;
constexpr size_t WS_U16 = 287 * MiB;
constexpr size_t WS_UH = 8 * MiB;
constexpr size_t WS_ACT8 = 287 * MiB;
constexpr int DFFP = 5632;
constexpr size_t WS_KSBC = 342 * MiB;
constexpr size_t WS_VSBC = 358 * MiB;
constexpr size_t WS_KDSC = 374 * MiB;
constexpr size_t WS_VDSC = 376 * MiB;
constexpr size_t WS_END = 384 * MiB;

__device__ __forceinline__ float wave_sum(float v) {
#pragma unroll
    for (int o = 1; o < 64; o <<= 1) v += __shfl_xor(v, o);
    return v;
}
__device__ __forceinline__ float block_sum256(float v, float* red) {
    v = wave_sum(v);
    __syncthreads();
    if ((threadIdx.x & 63) == 0) red[threadIdx.x >> 6] = v;
    __syncthreads();
    return red[0] + red[1] + red[2] + red[3];
}
__device__ __forceinline__ float silu_f(float v) { return v / (1.f + expf(-v)); }
__device__ __forceinline__ float softplus_f(float z) { return fmaxf(z, 0.f) + log1pf(expf(-fabsf(z))); }

#define LAS __attribute__((address_space(3)))
typedef _Float16 half8 __attribute__((ext_vector_type(8)));
typedef _Float16 half4 __attribute__((ext_vector_type(4)));
typedef _Float16 half2v __attribute__((ext_vector_type(2)));
typedef float f32x4 __attribute__((ext_vector_type(4)));
typedef float f32x16 __attribute__((ext_vector_type(16)));
typedef unsigned u32x4 __attribute__((ext_vector_type(4)));
typedef unsigned u32x2 __attribute__((ext_vector_type(2)));
typedef int i32x4 __attribute__((ext_vector_type(4)));
__device__ __forceinline__ unsigned q8x4(float a, float b, float c, float d) {
    a = __builtin_amdgcn_fmed3f(__builtin_rintf(a), -127.f, 127.f); b = __builtin_amdgcn_fmed3f(__builtin_rintf(b), -127.f, 127.f);
    c = __builtin_amdgcn_fmed3f(__builtin_rintf(c), -127.f, 127.f); d = __builtin_amdgcn_fmed3f(__builtin_rintf(d), -127.f, 127.f);
    const unsigned p01 = __builtin_bit_cast(unsigned, __builtin_amdgcn_cvt_pk_i16((int)a, (int)b)), p23 = __builtin_bit_cast(unsigned, __builtin_amdgcn_cvt_pk_i16((int)c, (int)d));
    return __builtin_amdgcn_perm(p23, p01, 0x06040200u);
}
__device__ __forceinline__ unsigned pk_h2(float lo, float hi) { half2v h = {(f16)lo, (f16)hi}; return __builtin_bit_cast(unsigned, h); }

constexpr int NWAVES = 8;
constexpr int LDS_BYTES = 159744;
constexpr int RING_BYTES = 131072;
constexpr int XTRA_OFF = RING_BYTES;
constexpr int MISC_OFF = LDS_BYTES - 256;
constexpr int CW_TMO = 0, CW_BAR = 4096, CW_XCNT = 32768, CW_ADA = 40960, CW_SBMAX = 49152, CW_SDMAX = 61440, CW_SIMAX = 65536;

namespace pg8 {
constexpr int BM = 256, BK = 64, HALF = 128, HTB = HALF * BK * 2, STAGE_BYTES = 8 * HTB, NXCD = 8, WGM = 8;
__host__ __device__ __forceinline__ int lds_byte(int r, int c) { const int st = (r >> 4) * 2 + (c >> 5), rr = r & 15, cc = c & 31, ob = rr * 64 + cc * 2; return st * 1024 + (ob ^ (((ob >> 9) & 1) << 5)); }
__host__ __device__ __forceinline__ void stage_rc(int b, int& R, int& C) { const int st = b / 1024, sb = b % 1024, swz = sb ^ (((sb >> 9) & 1) << 5); R = (st >> 1) * 16 + swz / 64; C = (st & 1) * 32 + (swz % 64) / 2; }
__host__ __device__ __forceinline__ int perm32(int rho) { const int n = rho >> 4, i = rho & 15; return 8 * (i >> 2) + 4 * n + (i & 3); }
struct Unit { int pm, pn; };
struct Gemm { const f16* A; const f16* Bt; int M, N, K; };
struct StaticOrder {
    int nM, nN, nwg, G, c;
    __host__ __device__ __forceinline__ void init(int M, int N, int G_, int c_) { nM = M / BM; nN = N / BM; nwg = nM * nN; G = G_; c = c_; }
    __host__ __device__ __forceinline__ bool next(int i, Unit& u) const {
        const long L = (long)i * G + c; if (L >= nwg) return false;
        int wgid = (int)L; { const int q = nwg / NXCD, r = nwg % NXCD, xcd = wgid % NXCD, off = wgid / NXCD; wgid = (xcd < r ? xcd * (q + 1) : r * (q + 1) + (xcd - r) * q) + off; }
        const int nig = WGM * nN, gid = wgid / nig, fm = gid * WGM, gsz = (nM - fm) < WGM ? (nM - fm) : WGM;
        u.pm = fm + ((wgid % nig) % gsz); u.pn = (wgid % nig) / gsz; return true;
    }
    __device__ __forceinline__ void a_ready(const Unit&) const {}
    __device__ __forceinline__ void done(const Unit&) const {}
};
struct InOrder {
    int nM, nN, nwg, c, first, mode;
    __host__ __device__ __forceinline__ void init(int M, int ncol, int c_, int mode_) { nM = M / BM; nN = ncol; nwg = nM * nN; c = c_; mode = mode_; }
    __host__ __device__ __forceinline__ bool next(int i, Unit& u) const {
        int L;
        if (mode == 0) { L = i * 256 + c; if (L >= nwg) return false; }
        else { if (c >= 160) { if (i >= 2) return false; L = (c - 160) + 96 * i; } else if (c < 96) { if (i >= 1) return false; L = 192 + c; } else return false; }
        int wgid = L; { const int q = nwg / NXCD, r = nwg % NXCD, xcd = wgid % NXCD, off = wgid / NXCD; wgid = (xcd < r ? xcd * (q + 1) : r * (q + 1) + (xcd - r) * q) + off; }
        const int nig = WGM * nN, gid = wgid / nig, fm = gid * WGM, gsz = (nM - fm) < WGM ? (nM - fm) : WGM;
        u.pm = fm + ((wgid % nig) % gsz); const int pn = (wgid % nig) / gsz;
        u.pn = mode == 0 ? (pn < 8 ? pn : pn + 9) : 8 + pn; return true;
    }
    __device__ __forceinline__ void a_ready(const Unit&) const {}
    __device__ __forceinline__ void done(const Unit&) const {}
};
__device__ __forceinline__ void mma16(f32x4& c, const half8& b, const half8& a) { c = __builtin_amdgcn_mfma_f32_16x16x32_f16(b, a, c, 0, 0, 0); }
__device__ __forceinline__ void mma16(i32x4& c, const half8& b, const half8& a) { c = __builtin_amdgcn_mfma_i32_16x16x64_i8(__builtin_bit_cast(i32x4, b), __builtin_bit_cast(i32x4, a), c, 0, 0, 0); }
template <class Epi, class Sched, bool ALIGN_EPI, bool SP2>
__device__ __forceinline__ void gemm_phase(LAS unsigned char* lds, const Gemm g, const Sched& S, const Epi& E) {
    int tid = threadIdx.x; asm volatile("" : "+v"(tid));
    const int wid = __builtin_amdgcn_readfirstlane(tid >> 6), lane = tid & 63, wr = wid >> 2, wc = wid & 3, fr = lane & 15, fq = lane >> 4;
    const int K = g.K, nt = K / BK;
    unsigned voffA[2], voffB[2];
#pragma unroll
    for (int i = 0; i < 2; ++i) { int R, C; stage_rc(tid * 16 + i * 8192, R, C); const int Rb = Epi::PERM ? ((R & ~31) + perm32(R & 31)) : R;
        voffA[i] = (unsigned)(R * K + C) * 2u; voffB[i] = (unsigned)(Rb * K + C) * 2u; }
    const size_t kstep = (size_t)(BK * 2);
    const size_t hstep = (size_t)HALF * K * 2;
    const size_t tstep = 2 * hstep;
    const unsigned ldsw = (unsigned)wid * 1024u;
    const int aoff = lds_byte(wr * 64 + fr, fq * 8), boff = lds_byte(wc * 32 + fr, fq * 8);
#define PG8_SA(b, h) (((b) * 2 + (h)) * HTB)
#define PG8_SB(b, h) ((4 + (b) * 2 + (h)) * HTB)
#define PG8_STAGE(bufoff, gbase, voff) do { _Pragma("unroll") for (int _i = 0; _i < 2; ++_i) \
        __builtin_amdgcn_global_load_lds((const unsigned*)((const char*)(gbase) + (voff)[_i]), (LAS unsigned*)(lds + (bufoff) + ldsw + _i * 8192), 16, 0, 0); } while (0)
#define PG8_LDA(dst, b, h) do { _Pragma("unroll") for (int m = 0; m < 4; ++m) _Pragma("unroll") for (int k = 0; k < 2; ++k) dst[m][k] = *(const LAS half8*)(lds + PG8_SA(b, h) + aoff + m * 2048 + k * 1024); } while (0)
#define PG8_LDB(dst, b, h) do { _Pragma("unroll") for (int n = 0; n < 2; ++n) _Pragma("unroll") for (int k = 0; k < 2; ++k) dst[n][k] = *(const LAS half8*)(lds + PG8_SB(b, h) + boff + n * 2048 + k * 1024); } while (0)
#define PG8_MMA(ai, bj, At, Bt) do { __builtin_amdgcn_s_setprio(1); _Pragma("unroll") for (int m = 0; m < 4; ++m) _Pragma("unroll") for (int n = 0; n < 2; ++n) _Pragma("unroll") for (int k = 0; k < 2; ++k) \
        mma16(acc[ai][bj][m][n], Bt[n][k], At[m][k]); __builtin_amdgcn_s_setprio(0); } while (0)
#define PG8_WAIT_V(n) asm volatile("s_waitcnt vmcnt(" #n ")" ::: "memory")
#define PG8_WAIT_L(n) asm volatile("s_waitcnt lgkmcnt(" #n ")" ::: "memory")
#define PG8_BAR __builtin_amdgcn_s_barrier()
#define PG8_SCHED __builtin_amdgcn_sched_barrier(0)
    Unit cur, nxt; int ui = 0;
    if (!S.next(0, cur)) return;
    typedef typename Epi::acc_t acc_t;
    acc_t acc[2][2][4][2];
#pragma unroll
    for (int a = 0; a < 2; ++a)
#pragma unroll
        for (int b = 0; b < 2; ++b)
#pragma unroll
            for (int m = 0; m < 4; ++m)
#pragma unroll
                for (int n = 0; n < 2; ++n) acc[a][b][m][n] = (acc_t){0, 0, 0, 0};
    half8 At[4][2], B0[2][2], B1[2][2];
    const char* cA = (const char*)g.A + (size_t)cur.pm * tstep; const char* cB = (const char*)g.Bt + (size_t)cur.pn * tstep;
    S.a_ready(cur);
    if constexpr (SP2) {
        PG8_STAGE(PG8_SB(0, 0), cB, voffB); PG8_STAGE(PG8_SB(0, 1), cB + hstep, voffB); PG8_STAGE(PG8_SA(0, 0), cA, voffA); PG8_STAGE(PG8_SA(0, 1), cA + hstep, voffA);
        if (wr == 1) PG8_BAR;
        PG8_WAIT_V(2); PG8_BAR;
        PG8_STAGE(PG8_SB(1, 0), cB + kstep, voffB); PG8_STAGE(PG8_SA(1, 0), cA + kstep, voffA); PG8_STAGE(PG8_SB(1, 1), cB + hstep + kstep, voffB);
        PG8_WAIT_V(6); PG8_BAR;
    } else {
        PG8_STAGE(PG8_SB(0, 0), cB, voffB); PG8_STAGE(PG8_SA(0, 0), cA, voffA); PG8_STAGE(PG8_SB(0, 1), cB + hstep, voffB); PG8_STAGE(PG8_SA(0, 1), cA + hstep, voffA);
        if (wr == 1) PG8_BAR;
        PG8_WAIT_V(4); PG8_BAR;
        PG8_STAGE(PG8_SB(1, 0), cB + kstep, voffB); PG8_STAGE(PG8_SA(1, 0), cA + kstep, voffA); PG8_STAGE(PG8_SB(1, 1), cB + hstep + kstep, voffB);
        PG8_WAIT_V(6); PG8_BAR;
    }
    for (;;) {
        const bool has_next = S.next(ui + 1, nxt);
        const char* nA = has_next ? (const char*)g.A + (size_t)nxt.pm * tstep : cA; const char* nB = has_next ? (const char*)g.Bt + (size_t)nxt.pn * tstep : cB;
        for (int t = 0; t < nt; t += 2) {
            const bool last = (t == nt - 2);
            const char* a1 = cA + (size_t)(t + 1) * kstep;
            const char* a2 = last ? nA : cA + (size_t)(t + 2) * kstep; const char* b2 = last ? nB : cB + (size_t)(t + 2) * kstep;
            const char* a3 = a2 + kstep; const char* b3 = b2 + kstep;
            if (last && has_next) S.a_ready(nxt);
            if constexpr (Epi::MIDK) { if (t == nt / 2) E.midk(acc, cur, wr, fr); }
            if constexpr (SP2) {
            PG8_LDB(B0, 0, 0); PG8_LDB(B1, 0, 1); PG8_SCHED; PG8_LDA(At, 0, 0); PG8_STAGE(PG8_SA(1, 1), a1 + hstep, voffA);
            PG8_WAIT_V(8); PG8_WAIT_L(0); PG8_BAR; PG8_MMA(0, 0, At, B0); PG8_MMA(0, 1, At, B1); PG8_BAR; PG8_SCHED;
            PG8_LDA(At, 0, 1); PG8_STAGE(PG8_SB(0, 0), b2, voffB); PG8_STAGE(PG8_SB(0, 1), b2 + hstep, voffB); PG8_STAGE(PG8_SA(0, 0), a2, voffA);
            PG8_WAIT_V(8); PG8_WAIT_L(0); PG8_BAR; PG8_MMA(1, 0, At, B0); PG8_MMA(1, 1, At, B1); PG8_BAR; PG8_SCHED;
            PG8_LDB(B0, 1, 0); PG8_LDB(B1, 1, 1); PG8_SCHED; PG8_LDA(At, 1, 0); PG8_STAGE(PG8_SA(0, 1), a2 + hstep, voffA);
            PG8_WAIT_V(8); PG8_WAIT_L(0); PG8_BAR; PG8_MMA(0, 0, At, B0); PG8_MMA(0, 1, At, B1); PG8_BAR; PG8_SCHED;
            PG8_LDA(At, 1, 1); PG8_STAGE(PG8_SB(1, 0), b3, voffB); PG8_STAGE(PG8_SB(1, 1), b3 + hstep, voffB); PG8_STAGE(PG8_SA(1, 0), a3, voffA);
            PG8_WAIT_V(8); PG8_WAIT_L(0); PG8_BAR; PG8_MMA(1, 0, At, B0); PG8_MMA(1, 1, At, B1); PG8_BAR; PG8_SCHED;
            } else {
            PG8_LDB(B0, 0, 0); PG8_SCHED; PG8_LDA(At, 0, 0); PG8_STAGE(PG8_SA(1, 1), a1 + hstep, voffA);
            PG8_WAIT_L(8); PG8_BAR; PG8_WAIT_L(0); PG8_MMA(0, 0, At, B0); PG8_BAR; PG8_SCHED;
            PG8_LDB(B1, 0, 1); PG8_STAGE(PG8_SB(0, 0), b2, voffB);
            PG8_BAR; PG8_WAIT_L(0); PG8_MMA(0, 1, At, B1); PG8_BAR;
            PG8_LDA(At, 0, 1); PG8_STAGE(PG8_SA(0, 0), a2, voffA);
            PG8_BAR; PG8_WAIT_L(0); PG8_MMA(1, 0, At, B0); PG8_BAR; PG8_SCHED;
            PG8_STAGE(PG8_SB(0, 1), b2 + hstep, voffB);
            PG8_WAIT_V(6); PG8_BAR; PG8_MMA(1, 1, At, B1); PG8_BAR;
            PG8_LDB(B0, 1, 0); PG8_SCHED; PG8_LDA(At, 1, 0); PG8_STAGE(PG8_SA(0, 1), a2 + hstep, voffA);
            PG8_WAIT_L(8); PG8_BAR; PG8_WAIT_L(0); PG8_MMA(0, 0, At, B0); PG8_BAR; PG8_SCHED;
            PG8_LDB(B1, 1, 1); PG8_STAGE(PG8_SB(1, 0), b3, voffB);
            PG8_BAR; PG8_WAIT_L(0); PG8_MMA(0, 1, At, B1); PG8_BAR;
            PG8_LDA(At, 1, 1); PG8_STAGE(PG8_SA(1, 0), a3, voffA);
            PG8_BAR; PG8_WAIT_L(0); PG8_MMA(1, 0, At, B0); PG8_BAR; PG8_SCHED;
            PG8_STAGE(PG8_SB(1, 1), b3 + hstep, voffB);
            PG8_WAIT_V(6); PG8_BAR; PG8_MMA(1, 1, At, B1); PG8_BAR;
            }
        }
        if constexpr (ALIGN_EPI) { if (wr == 0) PG8_BAR; }
        if constexpr (!Epi::AFTER_DRAIN) { E(acc, cur, wr, wc, fr, fq); S.done(cur); }
        if (!has_next) break;
#pragma unroll
        for (int a = 0; a < 2; ++a)
#pragma unroll
            for (int b = 0; b < 2; ++b)
#pragma unroll
                for (int m = 0; m < 4; ++m)
#pragma unroll
                    for (int n = 0; n < 2; ++n) acc[a][b][m][n] = (acc_t){0, 0, 0, 0};
        cur = nxt; cA = nA; cB = nB; ++ui;
        if constexpr (ALIGN_EPI) { if (wr == 1) PG8_BAR; }
    }
    PG8_WAIT_V(0);
    if constexpr (!ALIGN_EPI) { if (wr == 0) PG8_BAR; }
    PG8_BAR;
    if constexpr (Epi::AFTER_DRAIN) { E.fused(acc, cur, wr, wc, fr, fq, lds); S.done(cur); }
#undef PG8_SA
#undef PG8_SB
#undef PG8_STAGE
#undef PG8_LDA
#undef PG8_LDB
#undef PG8_MMA
#undef PG8_WAIT_V
#undef PG8_WAIT_L
#undef PG8_BAR
#undef PG8_SCHED
}

template <bool I8> struct AccSelB { typedef f32x4 t; };
template <> struct AccSelB<true> { typedef i32x4 t; };
template <bool I8>
struct EpiProjT {
    static constexpr bool PERM = true, AFTER_DRAIN = false, MIDK = false; typedef typename AccSelB<I8>::t acc_t;
    f16* P; f16* kix; float* wix; const float* rope; f16* ksbc; f16* vsbc; f16* kdsc; f16* vdsc; const float* sah; const float* simax;
    __device__ __forceinline__ void operator()(const acc_t (&acc)[2][2][4][2], const Unit& u, int wr, int wc, int fr, int fq) const {
        const int row0 = u.pm * BM + wr * 64 + fr;
#pragma unroll
        for (int bj = 0; bj < 2; ++bj) {
            const int cbase = u.pn * BM + bj * HALF;
            if (cbase >= 5504) continue;
            f32x4 cs[2] = {{1.f, 1.f, 1.f, 1.f}, {1.f, 1.f, 1.f, 1.f}};
            if constexpr (I8) {
#pragma unroll
                for (int n = 0; n < 2; ++n) cs[n] = *(const f32x4*)(simax + (cbase - IN8_LO) + wc * 32 + 8 * fq + 4 * n) * (2.f / 127.f); }
            const bool r128 = (cbase >= C_QDS && cbase < C_VDS) && (wc == 0);
            const bool r64 = (cbase >= C_QIX) && ((wc & 1) == 0) && (cbase != C_KIX || wc == 0);
            const float sc = (cbase < 1024 || (cbase >= C_QDS && cbase < C_KDS)) ? QSCALE : 1.f;
#pragma unroll
            for (int ai = 0; ai < 2; ++ai)
#pragma unroll
                for (int m = 0; m < 4; ++m) {
                    const int row = row0 + ai * HALF + m * 16;
                    float v[8];
                    if constexpr (I8) { const float rs = sah[row];
#pragma unroll
                        for (int n = 0; n < 2; ++n)
#pragma unroll
                            for (int j = 0; j < 4; ++j) v[n * 4 + j] = (float)acc[ai][bj][m][n][j] * (rs * cs[n][j]);
                    } else {
#pragma unroll
                    for (int n = 0; n < 2; ++n)
#pragma unroll
                        for (int j = 0; j < 4; ++j) v[n * 4 + j] = acc[ai][bj][m][n][j]; }
                    if (r128) {
                        const float* rp = rope + (size_t)row * 48 + 2 * (8 * (fq & 1));
#pragma unroll
                        for (int e = 0; e < 8; ++e) { const float o = __shfl_xor(v[e], 32); const float cs = rp[2 * e], sn = rp[2 * e + 1];
                            v[e] = fq < 2 ? v[e] * cs - o * sn : v[e] * cs + o * sn; }
                    }
                    if (r64) {
                        const float* rp = rope + (size_t)row * 48 + 32;
#pragma unroll
                        for (int e = 0; e < 8; ++e) { const float o = __shfl_xor(v[e], 16); const float cs = rp[2 * e], sn = rp[2 * e + 1];
                            const float r = fq == 0 ? v[e] * cs - o * sn : v[e] * cs + o * sn; v[e] = fq < 2 ? r : v[e]; }
                    }
                    u32x4 w; w.x = pk_h2(v[0] * sc, v[1] * sc); w.y = pk_h2(v[2] * sc, v[3] * sc); w.z = pk_h2(v[4] * sc, v[5] * sc); w.w = pk_h2(v[6] * sc, v[7] * sc);
                    {
                        f16* dst = P + (size_t)row * NINP + cbase;
                        const int bb = row / SEQ, ss = row % SEQ;
                        if (cbase >= C_KSB && cbase < C_VSB) dst = ksbc + ((size_t)(bb * NH + (cbase - C_KSB) / HD) * SEQ + ss) * HD;
                        else if (cbase >= C_VSB && cbase < C_QDS) dst = vsbc + ((size_t)(bb * NH + (cbase - C_VSB) / HD) * SEQ + ss) * HD;
                        else if (cbase == C_KDS) dst = kdsc + (size_t)row * HD;
                        else if (cbase == C_VDS) dst = vdsc + (size_t)row * HD;
                        *(u32x4*)(dst + wc * 32 + 8 * fq) = w; }
                    if (cbase == C_KIX) {
                        if (wc < 2) *(u32x4*)(kix + (size_t)row * 64 + wc * 32 + 8 * fq) = w;
                        if (wc == 2 && fq < 2) { float* wp = wix + (size_t)row * 16 + 8 * fq;
                            *(f32x4*)wp = (f32x4){v[0] * IDX_SCALE, v[1] * IDX_SCALE, v[2] * IDX_SCALE, v[3] * IDX_SCALE};
                            *(f32x4*)(wp + 4) = (f32x4){v[4] * IDX_SCALE, v[5] * IDX_SCALE, v[6] * IDX_SCALE, v[7] * IDX_SCALE}; }
                    }
                }
        }
    }
};
struct EpiResidF {
    static constexpr bool PERM = false, AFTER_DRAIN = false, MIDK = false; typedef f32x4 acc_t;
    const float* base; const float* gate; float* out;
    __device__ __forceinline__ void operator()(const f32x4 (&acc)[2][2][4][2], const Unit& u, int wr, int wc, int fr, int fq) const {
        const int row0 = u.pm * BM + wr * 64 + fr, col0 = u.pn * BM + wc * 32 + 4 * fq;
        const float* gp = gate + (size_t)(u.pm / (SEQ / BM)) * MODW + col0;
        f32x4 gv[2][2];
#pragma unroll
        for (int bj = 0; bj < 2; ++bj)
#pragma unroll
            for (int n = 0; n < 2; ++n) gv[bj][n] = *(const f32x4*)(gp + bj * HALF + n * 16);
#pragma unroll
        for (int ai = 0; ai < 2; ++ai)
#pragma unroll
            for (int m = 0; m < 4; ++m) { const size_t off = (size_t)(row0 + ai * HALF + m * 16) * DM + col0;
#pragma unroll
                for (int bj = 0; bj < 2; ++bj)
#pragma unroll
                    for (int n = 0; n < 2; ++n) { const f32x4 bs = *(const f32x4*)(base + off + bj * HALF + n * 16);
                        *(f32x4*)(out + off + bj * HALF + n * 16) = bs + gv[bj][n] * acc[ai][bj][m][n]; }
                asm volatile("" ::: "memory"); }
    }
};
__device__ __forceinline__ float silu_fast(float v) { return v * __builtin_amdgcn_rcpf(1.f + __expf(-v)); }
struct EpiUpConv {
    static constexpr bool PERM = true, AFTER_DRAIN = false, MIDK = false; typedef i32x4 acc_t;
    const float* cw; const float* cb; f16* act; float* uh; const float* sa; const float* sbw;
    __device__ __forceinline__ void operator()(i32x4 (&acc)[2][2][4][2], const Unit& u, int wr, int wc, int fr_in, int fq_in) const {
        int tix = threadIdx.x; asm volatile("" : "+v"(tix));
        const int fr = tix & 15, fq = (tix >> 4) & 3; (void)fr_in; (void)fq_in;
        const int lane = fr + 16 * fq;
        int ch0 = u.pn * HALF + wc * 32 + 8 * fq;
        {
            f32x4 sbv[2][2];
#pragma unroll
            for (int gv = 0; gv < 2; ++gv)
#pragma unroll
                for (int n = 0; n < 2; ++n) sbv[gv][n] = *(const f32x4*)(sbw + gv * DFF + ch0 + 4 * n) * (2.f / 127.f);
#pragma unroll
            for (int ai = 0; ai < 2; ++ai)
#pragma unroll
                for (int m = 0; m < 4; ++m) { const float rs = sa[u.pm * BM + ai * HALF + wr * 64 + m * 16 + fr];
#pragma unroll
                    for (int gv = 0; gv < 2; ++gv)
#pragma unroll
                        for (int n = 0; n < 2; ++n) { const i32x4 t = acc[ai][gv][m][n];
                            const f32x4 f = (f32x4){(float)t.x, (float)t.y, (float)t.z, (float)t.w} * rs * sbv[gv][n]; acc[ai][gv][m][n] = __builtin_bit_cast(i32x4, f); } }
        }
#define UF(ai, gv, m, n) __builtin_bit_cast(f32x4, acc[ai][gv][m][n])
        const int src1 = (lane & 48) | ((fr - 1) & 15), src2 = (lane & 48) | ((fr - 2) & 15);
#pragma unroll
        for (int n = 0; n < 2; ++n) {
            asm volatile("" : "+v"(ch0));
            f32x4 w0[2], w1[2], w2[2], bb[2];
#pragma unroll
            for (int gv = 0; gv < 2; ++gv) { const int c = gv * DFF + ch0 + 4 * n;
                w0[gv] = *(const f32x4*)(cw + c); w1[gv] = *(const f32x4*)(cw + NUP + c); w2[gv] = *(const f32x4*)(cw + 2 * NUP + c); bb[gv] = *(const f32x4*)(cb + c); }
#pragma unroll
            for (int ai = 0; ai < 2; ++ai) {
                const int chunk = u.pm * 4 + ai * 2 + wr;
#pragma unroll
                for (int m = 0; m < 4; ++m) {
                    const int row = u.pm * BM + ai * HALF + wr * 64 + m * 16 + fr;
                    f32x4 uc[2];
#pragma unroll
                    for (int gv = 0; gv < 2; ++gv) {
                        const f32x4 cur = UF(ai, gv, m, n); const f32x4 prv = UF(ai, gv, m > 0 ? m - 1 : 0, n);
                        f32x4 p1, p2;
#pragma unroll
                        for (int j = 0; j < 4; ++j) { const float t1 = fr == 15 ? prv[j] : cur[j], t2 = fr >= 14 ? prv[j] : cur[j]; p1[j] = __shfl(t1, src1); p2[j] = __shfl(t2, src2); }
                        uc[gv] = bb[gv] + w0[gv] * p2 + w1[gv] * p1 + w2[gv] * cur;
                    }
                    if (m > 0 || fr >= 2) { u32x2 w; w.x = pk_h2(silu_fast(uc[0].x) * uc[1].x, silu_fast(uc[0].y) * uc[1].y); w.y = pk_h2(silu_fast(uc[0].z) * uc[1].z, silu_fast(uc[0].w) * uc[1].w);
                        *(u32x2*)(act + (size_t)row * DFF + ch0 + 4 * n) = w; }
                    if ((m == 0 && fr < 2) || (m == 3 && fr >= 14)) { const int slot = m == 0 ? fr : fr - 12; float* up = uh + (size_t)(chunk * 4 + slot) * NUP + ch0 + 4 * n;
#pragma unroll
                        for (int gv = 0; gv < 2; ++gv) *(f32x4*)(up + gv * DFF) = UF(ai, gv, m, n); }
                }
            }
        }
    }
#undef UF
};
template <int MODE> struct AccSel { typedef f32x4 type; };
template <> struct AccSel<0> { typedef i32x4 type; };
template <int MODE> struct EpiResidNorm {
    static constexpr bool PERM = true, AFTER_DRAIN = true, MIDK = (MODE == 1); typedef typename AccSel<MODE>::type acc_t;
    const float* base; const float* gate; const float* g; const float* shsc; float* xout; f16* h; float* xch; unsigned* cnt; const float* ssq; float* xch2; float* sa; const float* maxsh;
    __device__ __forceinline__ void midk(f32x4 (&acc)[2][2][4][2], const Unit& u, int wr, int fr) const {
#pragma unroll
        for (int ai = 0; ai < 2; ++ai)
#pragma unroll
            for (int m = 0; m < 4; ++m) { const float* sp = ssq + (size_t)(u.pm * BM + ai * HALF + wr * 64 + m * 16 + fr) * NH;
                const f32x4 s0 = *(const f32x4*)sp, s1 = *(const f32x4*)(sp + 4);
                const float rs = rsqrtf((((s0.x + s0.y) + (s0.z + s0.w)) + ((s1.x + s1.y) + (s1.z + s1.w))) * (1.f / 1024.f) + EPS);
#pragma unroll
                for (int bj = 0; bj < 2; ++bj)
#pragma unroll
                    for (int n = 0; n < 2; ++n) acc[ai][bj][m][n] *= rs; }
    }
    __device__ __forceinline__ void fused(acc_t (&acc)[2][2][4][2], const Unit& u, int wr, int wc, int fr_in, int fq_in, LAS unsigned char* lds) const {
        int tix = threadIdx.x; asm volatile("" : "+v"(tix));
        const int fr = tix & 15, fq = (tix >> 4) & 3; (void)fr_in; (void)fq_in;
        LAS float* PT = (LAS float*)(lds + XTRA_OFF);
        LAS float* ST = (LAS float*)(lds + XTRA_OFF + 4096);
        const int bt = u.pm / (SEQ / BM);
        const int row0 = u.pm * BM + wr * 64 + fr, col0 = u.pn * BM + wc * 32 + 8 * fq;
#define XF(ai, bj, m, n) __builtin_bit_cast(f32x4, acc[ai][bj][m][n])
#define XS(ai, bj, m, n, v) acc[ai][bj][m][n] = __builtin_bit_cast(acc_t, (f32x4)(v))
        if (MODE == 0) {
            f32x4 sdv[2][2];
#pragma unroll
            for (int bj = 0; bj < 2; ++bj)
#pragma unroll
                for (int n = 0; n < 2; ++n) sdv[bj][n] = *(const f32x4*)(maxsh + col0 + bj * HALF + 4 * n) * (2.f / 127.f);
#pragma unroll
            for (int ai = 0; ai < 2; ++ai)
#pragma unroll
                for (int m = 0; m < 4; ++m) { const float rsa = sa[row0 + ai * HALF + m * 16];
#pragma unroll
                    for (int bj = 0; bj < 2; ++bj)
#pragma unroll
                        for (int n = 0; n < 2; ++n) { const i32x4 t = __builtin_bit_cast(i32x4, acc[ai][bj][m][n]);
                            XS(ai, bj, m, n, ((f32x4){(float)t.x, (float)t.y, (float)t.z, (float)t.w} * rsa * sdv[bj][n])); } }
        }
        {   const float* gp = gate + (size_t)bt * MODW + col0;
            f32x4 gv[2][2];
#pragma unroll
            for (int bj = 0; bj < 2; ++bj)
#pragma unroll
                for (int n = 0; n < 2; ++n) gv[bj][n] = *(const f32x4*)(gp + bj * HALF + 4 * n);
            int tok = 0;
#pragma unroll
            for (int ai = 0; ai < 2; ++ai)
#pragma unroll
                for (int m = 0; m < 4; ++m) { const size_t off = (size_t)(row0 + ai * HALF + m * 16 + tok) * DM + col0;
#pragma unroll
                    for (int bj = 0; bj < 2; ++bj) {
                        if (MODE == 1) {
#pragma unroll
                            for (int n = 0; n < 2; ++n) XS(ai, bj, m, n, *(const f32x4*)(base + off + bj * HALF + 4 * n) + gv[bj][n] * XF(ai, bj, m, n));
                        } else {
                            const half8 b8 = *(const half8*)((const f16*)base + off + bj * HALF);
                            XS(ai, bj, m, 0, ((f32x4){(float)b8[0], (float)b8[1], (float)b8[2], (float)b8[3]} + gv[bj][0] * XF(ai, bj, m, 0)));
                            XS(ai, bj, m, 1, ((f32x4){(float)b8[4], (float)b8[5], (float)b8[6], (float)b8[7]} + gv[bj][1] * XF(ai, bj, m, 1)));
                        } }
                    asm volatile("" : "+v"(tok) : "v"(acc[ai][0][m][0].x), "v"(acc[ai][0][m][1].x), "v"(acc[ai][1][m][0].x), "v"(acc[ai][1][m][1].x) : "memory"); }
        }
#pragma unroll
        for (int ai = 0; ai < 2; ++ai)
#pragma unroll
            for (int m = 0; m < 4; ++m) { float q = 0.f;
#pragma unroll
                for (int bj = 0; bj < 2; ++bj)
#pragma unroll
                    for (int n = 0; n < 2; ++n) { const f32x4 x = XF(ai, bj, m, n); q += (x.x * x.x + x.y * x.y) + (x.z * x.z + x.w * x.w); }
                q += __shfl_xor(q, 16); q += __shfl_xor(q, 32);
                if (fq == 0) PT[(ai * HALF + wr * 64 + m * 16 + fr) * 4 + wc] = q; }
        if (MODE == 1) {
            LAS float* PT2 = (LAS float*)(lds + XTRA_OFF + 8192);
            float mxa[2][4];
#pragma unroll
            for (int ai = 0; ai < 2; ++ai)
#pragma unroll
                for (int m = 0; m < 4; ++m) mxa[ai][m] = 0.f;
#pragma unroll
            for (int bj = 0; bj < 2; ++bj) {
                f32x4 av[2];
#pragma unroll
                for (int n = 0; n < 2; ++n) { const int c = col0 + bj * HALF + 4 * n; av[n] = *(const f32x4*)(g + c) * (*(const f32x4*)(shsc + (size_t)bt * MODW + DM + c) + 1.f); }
#pragma unroll
                for (int ai = 0; ai < 2; ++ai)
#pragma unroll
                    for (int m = 0; m < 4; ++m)
#pragma unroll
                        for (int n = 0; n < 2; ++n) { const f32x4 t = __builtin_elementwise_abs(XF(ai, bj, m, n) * av[n]); mxa[ai][m] = fmaxf(mxa[ai][m], fmaxf(fmaxf(t.x, t.y), fmaxf(t.z, t.w))); }
            }
#pragma unroll
            for (int ai = 0; ai < 2; ++ai)
#pragma unroll
                for (int m = 0; m < 4; ++m) { float q = mxa[ai][m]; q = fmaxf(q, __shfl_xor(q, 16)); q = fmaxf(q, __shfl_xor(q, 32));
                    if (fq == 0) PT2[(ai * HALF + wr * 64 + m * 16 + fr) * 4 + wc] = q; }
        }
        __syncthreads();
        const int tid = threadIdx.x;
        float* slot = xch + ((size_t)u.pm * 8 + u.pn) * BM;
        if (tid < BM) { const f32x4 p4 = *(const LAS f32x4*)(PT + tid * 4); __hip_atomic_store(slot + tid, (p4.x + p4.y) + (p4.z + p4.w), __ATOMIC_RELAXED, __HIP_MEMORY_SCOPE_AGENT);
            if (MODE == 1) { const f32x4 m4 = *(const LAS f32x4*)((LAS float*)(lds + XTRA_OFF + 8192) + tid * 4);
                __hip_atomic_store(xch2 + ((size_t)u.pm * 8 + u.pn) * BM + tid, fmaxf(fmaxf(m4.x, m4.y), fmaxf(m4.z, m4.w)), __ATOMIC_RELAXED, __HIP_MEMORY_SCOPE_AGENT); } }
        asm volatile("s_waitcnt vmcnt(0)" ::: "memory");
        __syncthreads();
        if (tid == 0) {
            __hip_atomic_fetch_add(cnt + 64 * u.pm, 1u, __ATOMIC_RELAXED, __HIP_MEMORY_SCOPE_AGENT);
            unsigned sp = 0;
            while (__hip_atomic_load(cnt + 64 * u.pm, __ATOMIC_RELAXED, __HIP_MEMORY_SCOPE_AGENT) < 8u) { __builtin_amdgcn_s_sleep(1); if (++sp > (1u << 22)) break; }
        }
        __syncthreads();
        if (tid < BM) { const float* sp = xch + (size_t)u.pm * 8 * BM + tid; float tot = 0.f;
#pragma unroll
            for (int j = 0; j < 8; ++j) tot += __hip_atomic_load(sp + j * BM, __ATOMIC_RELAXED, __HIP_MEMORY_SCOPE_AGENT);
            const float rstd = rsqrtf(tot * (1.f / DM) + EPS); ST[tid] = rstd;
            if (MODE == 1) { const float* mp = xch2 + (size_t)u.pm * 8 * BM + tid; float mxr = 0.f;
#pragma unroll
                for (int j = 0; j < 8; ++j) mxr = fmaxf(mxr, __hip_atomic_load(mp + j * BM, __ATOMIC_RELAXED, __HIP_MEMORY_SCOPE_AGENT));
                const float bound = fmaxf(rstd * mxr + maxsh[bt], 1e-20f);
                ST[BM + tid] = 127.f / bound; if (u.pn == 0) sa[u.pm * BM + tid] = bound * (1.f / 127.f); } }
        __syncthreads();
#pragma unroll
        for (int bj = 0; bj < 2; ++bj) {
            f32x4 gg[2], sh[2], sc[2];
#pragma unroll
            for (int n = 0; n < 2; ++n) { const int c = col0 + bj * HALF + 4 * n; gg[n] = *(const f32x4*)(g + c);
                if (MODE == 1) { sh[n] = *(const f32x4*)(shsc + (size_t)bt * MODW + c); sc[n] = *(const f32x4*)(shsc + (size_t)bt * MODW + DM + c) + 1.f; } }
#pragma unroll
            for (int ai = 0; ai < 2; ++ai)
#pragma unroll
                for (int m = 0; m < 4; ++m) { const int rl = ai * HALF + wr * 64 + m * 16 + fr; const float rs = ST[rl]; const size_t off = (size_t)(u.pm * BM + rl) * DM + col0 + bj * HALF;
                    if (MODE == 0) {
#pragma unroll
                        for (int n = 0; n < 2; ++n) *(f32x4*)(xout + off + 4 * n) = (XF(ai, bj, m, n) * rs) * gg[n];
                    } else {
                        const f32x4 y0 = ((XF(ai, bj, m, 0) * rs) * gg[0]) * sc[0] + sh[0], y1 = ((XF(ai, bj, m, 1) * rs) * gg[1]) * sc[1] + sh[1];
                        { const f32x4 x0 = XF(ai, bj, m, 0), x1 = XF(ai, bj, m, 1); u32x4 xw; xw.x = pk_h2(x0.x, x0.y); xw.y = pk_h2(x0.z, x0.w); xw.z = pk_h2(x1.x, x1.y); xw.w = pk_h2(x1.z, x1.w);
                          *(u32x4*)((f16*)xout + off) = xw; }
                        {   const float qs = ST[BM + rl];
                            u32x2 w8; w8.x = q8x4(y0.x * qs, y0.y * qs, y0.z * qs, y0.w * qs); w8.y = q8x4(y1.x * qs, y1.y * qs, y1.z * qs, y1.w * qs);
                            *(u32x2*)((signed char*)h + off) = w8; }
                    }
                    asm volatile("" ::: "memory"); }
        }
    }
#undef XF
#undef XS
};
}


namespace att {
typedef short v4i16_t __attribute__((ext_vector_type(4)));
__device__ __forceinline__ int sw16(int row) { return ((row & 3) << 2) | ((row >> 2) & 3); }
__device__ __forceinline__ int crow(int i, int h) { return (i & 3) + 8 * (i >> 2) + 4 * h; }
__device__ __forceinline__ half4 tr_read(LAS unsigned char* p) { return __builtin_bit_cast(half4, __builtin_amdgcn_ds_read_tr16_b64_v4i16((LAS v4i16_t*)p)); }
__device__ __forceinline__ half8 cat8(half4 a, half4 b) { return __builtin_shufflevector(a, b, 0, 1, 2, 3, 4, 5, 6, 7); }
__device__ __forceinline__ half8 cvt8(const f32x16& x, int s) {
    half8 r;
#pragma unroll
    for (int j = 0; j < 8; ++j) r[j] = (f16)x[8 * s + j];
    return r;
}
struct TileRegs { u32x4 v[8]; };
template <class RowOff> __device__ __forceinline__ void tile_fetch(TileRegs& t, const unsigned char* base, RowOff roff, int lane) {
#pragma unroll
    for (int i = 0; i < 8; ++i) { const int row = (lane >> 4) + 4 * i; const unsigned off = (unsigned)roff(row) + 16u * (unsigned)(lane & 15); t.v[i] = *(const u32x4*)(base + off); }
}
__device__ __forceinline__ void tile_put(const TileRegs& t, LAS unsigned char* tile, int lane) {
#pragma unroll
    for (int i = 0; i < 8; ++i) { const int row = (lane >> 4) + 4 * i; *(LAS u32x4*)(tile + 256 * row + 16 * ((lane & 15) ^ sw16(row))) = t.v[i]; }
}
__device__ __forceinline__ void fetch_rows8(TileRegs& t, const unsigned char* base, const unsigned (&offs)[8], int lane) {
#pragma unroll
    for (int i = 0; i < 8; ++i) t.v[i] = *(const u32x4*)(base + (offs[i] + 16u * (unsigned)(lane & 15)));
}
__device__ __forceinline__ void put_rows8(const TileRegs& t, LAS unsigned char* tile, int lane) {
#pragma unroll
    for (int i = 0; i < 8; ++i) { const int row = 8 * (lane >> 4) + i; *(LAS u32x4*)(tile + 256 * row + 16 * ((lane & 15) ^ sw16(row))) = t.v[i]; }
}
__device__ __forceinline__ void sel_offs8(unsigned (&offs)[8], const LAS unsigned short* sel, int j0, int cnt) {
    const u32x4 w = *(const LAS u32x4*)(sel + j0);
    const unsigned e[8] = {w.x & 0xffffu, w.x >> 16, w.y & 0xffffu, w.y >> 16, w.z & 0xffffu, w.z >> 16, w.w & 0xffffu, w.w >> 16};
#pragma unroll
    for (int i = 0; i < 8; ++i) offs[i] = (j0 + i < cnt ? e[i] : 0u) << 8;
}
__device__ __forceinline__ f32x16 qk_tile(LAS unsigned char* ktile, const half8 (&qf)[8], int lane) {
    const int r = lane & 31, h = lane >> 5, swr = sw16(r);
    f32x16 z;
#pragma unroll
    for (int i = 0; i < 16; ++i) z[i] = 0.f;
#pragma unroll
    for (int st = 0; st < 8; ++st) { const half8 kf = *(const LAS half8*)(ktile + 256 * r + 16 * ((2 * st + h) ^ swr)); z = __builtin_amdgcn_mfma_f32_32x32x16_f16(kf, qf[st], z, 0, 0, 0); }
    return z;
}
__device__ __forceinline__ void tr_addrs(int (&va)[4][2], int lane) {
    const int q = (lane & 15) >> 2, p = lane & 3, g = lane >> 4, h = g >> 1, g1 = g & 1;
#pragma unroll
    for (int mt = 0; mt < 4; ++mt)
#pragma unroll
        for (int sec = 0; sec < 2; ++sec) { const int key = 8 * sec + 4 * h + q, sw = (q << 2) | (2 * sec + h), ch = 4 * mt + 2 * g1 + (p >> 1);
            va[mt][sec] = 256 * key + 16 * (ch ^ sw) + 8 * (p & 1); }
}
__device__ __forceinline__ void pv_tile(f32x16 (&o)[4], LAS unsigned char* vtile, const int (&va)[4][2], const half8 (&wf)[2]) {
#pragma unroll
    for (int ks = 0; ks < 2; ++ks)
#pragma unroll
        for (int mt = 0; mt < 4; ++mt) { const half8 vf = cat8(tr_read(vtile + va[mt][0] + 4096 * ks), tr_read(vtile + va[mt][1] + 4096 * ks));
            o[mt] = __builtin_amdgcn_mfma_f32_32x32x16_f16(vf, wf[ks], o[mt], 0, 0, 0); }
}

__device__ __forceinline__ void sb_item(const f16* __restrict__ P, const f16* __restrict__ ksbc, const f16* __restrict__ vsbc, f16* __restrict__ merged, float* __restrict__ ssq, LAS unsigned char* reg, int b, int hd, int qb, int lane) {
    const int c = lane & 31, h = lane >> 5, t0 = 32 * qb;
    LAS unsigned char* ktile = reg; LAS unsigned char* vtile = reg + 8192;
    half8 qf[8];
    { const f16* qp = P + (size_t)(b * SEQ + t0 + c) * NINP + C_QSB + hd * HD + 8 * h;
#pragma unroll
      for (int st = 0; st < 8; ++st) qf[st] = *(const half8*)(qp + 16 * st); }
    half8 uf[2];
#pragma unroll
    for (int ks = 0; ks < 2; ++ks)
#pragma unroll
        for (int j = 0; j < 8; ++j) uf[ks][j] = (16 * ks + 8 * (j >> 2) + 4 * h + (j & 3)) > c ? (f16)1.f : (f16)0.f;
    int va[4][2]; tr_addrs(va, lane);
    f32x16 o[4];
#pragma unroll
    for (int mt = 0; mt < 4; ++mt)
#pragma unroll
        for (int i = 0; i < 16; ++i) o[mt][i] = 0.f;
    float R = 0.f;
    const unsigned char* kbase = (const unsigned char*)(ksbc + (size_t)(b * NH + hd) * SEQ * HD);
    const unsigned char* vbase = (const unsigned char*)(vsbc + (size_t)(b * NH + hd) * SEQ * HD);
    TileRegs tk, tv;
    tile_fetch(tk, kbase, [&](int row) { return (size_t)(32 * qb + row) * (HD * 2); }, lane);
    for (int kt = qb; kt >= 0; --kt) {
        const int s0 = 32 * kt;
        tile_put(tk, ktile, lane);
        tile_fetch(tv, vbase, [&](int row) { return (size_t)(s0 + row) * (HD * 2); }, lane);
        f32x16 z = qk_tile(ktile, qf, lane);
        f32x16 l, a;
        float lsum = 0.f;
        const bool diag = (kt == qb);
#pragma unroll
        for (int i = 0; i < 16; ++i) { const float zi = z[i]; const float sp = fmaxf(zi, 0.f) + __logf(1.f + __expf(-fabsf(zi)));
            const bool ok = !diag || crow(i, h) < c;
            l[i] = ok ? -sp : 0.f; a[i] = zi - sp; lsum += l[i]; z[i] = ok ? 1.f : 0.f; }
        half8 lf[2] = {cvt8(l, 0), cvt8(l, 1)};
        f32x16 cs;
#pragma unroll
        for (int i = 0; i < 16; ++i) cs[i] = 0.f;
        cs = __builtin_amdgcn_mfma_f32_32x32x16_f16(uf[0], lf[0], cs, 0, 0, 0);
        cs = __builtin_amdgcn_mfma_f32_32x32x16_f16(uf[1], lf[1], cs, 0, 0, 0);
        f32x16 w;
#pragma unroll
        for (int i = 0; i < 16; ++i) w[i] = z[i] != 0.f ? __expf((a[i] + cs[i]) + R) : 0.f;
        half8 wf[2] = {cvt8(w, 0), cvt8(w, 1)};
        tile_put(tv, vtile, lane);
        { const int sn = 32 * (kt > 0 ? kt - 1 : 0); tile_fetch(tk, kbase, [&](int row) { return (size_t)(sn + row) * (HD * 2); }, lane); }
        pv_tile(o, vtile, va, wf);
        R += lsum + __shfl_xor(lsum, 32);
        if (__all(R < -104.f)) break;
    }
    float sq = 0.f;
#pragma unroll
    for (int mt = 0; mt < 4; ++mt)
#pragma unroll
        for (int gI = 0; gI < 4; ++gI) { const f32x16& x = o[mt]; const int i0 = 4 * gI;
            sq += (x[i0] * x[i0] + x[i0 + 1] * x[i0 + 1]) + (x[i0 + 2] * x[i0 + 2] + x[i0 + 3] * x[i0 + 3]);
            u32x2 w2; w2.x = pk_h2(x[i0], x[i0 + 1]); w2.y = pk_h2(x[i0 + 2], x[i0 + 3]);
            *(LAS u32x2*)(reg + 272 * c + 2 * (32 * mt + 8 * gI + 4 * h)) = w2; }
    sq += __shfl_xor(sq, 32);
    if (lane < 32) ssq[(size_t)(b * SEQ + t0 + c) * NH + hd] = sq;
#pragma unroll
    for (int it = 0; it < 8; ++it) { const int row = (lane >> 4) + 4 * it;
        const u32x4 v = *(const LAS u32x4*)(reg + 272 * row + 16 * (lane & 15));
        *(u32x4*)(merged + (size_t)(b * SEQ + t0 + row) * DM + hd * HD + 8 * (lane & 15)) = v; }
}

constexpr int X_HIST = 0, X_SEL = 16384, X_CVAL = 20480, X_CIDX = 22528, X_MM = 24576, X_WSM = 25600;
__device__ __forceinline__ int mbcnt64(unsigned long long m) { return __builtin_amdgcn_mbcnt_hi((unsigned)(m >> 32), __builtin_amdgcn_mbcnt_lo((unsigned)m, 0u)); }
__device__ __forceinline__ float wave_min(float v) {
#pragma unroll
    for (int o = 1; o < 64; o <<= 1) v = fminf(v, __shfl_xor(v, o));
    return v; }
__device__ __forceinline__ float wave_max(float v) {
#pragma unroll
    for (int o = 1; o < 64; o <<= 1) v = fmaxf(v, __shfl_xor(v, o));
    return v; }
__device__ __forceinline__ int binof(float v, float lo, float scale) { const int bq = (int)((v - lo) * scale); return bq > 1023 ? 1023 : bq; }
__device__ __forceinline__ bool topk_fast(const LAS float* sc, int n, float lo, float hi, LAS unsigned* hist, LAS unsigned short* sel, LAS float* cval, LAS unsigned short* cidx, LAS unsigned* ctr, int lane) {
    const float range = hi - lo;
    if (!(range > 1e-30f)) return false;
    const float scale = 512.f / range;
#pragma unroll
    for (int k = 0; k < 8; ++k) hist[lane * 8 + k] = 0u;
    if (lane < 2) ctr[lane] = 0u;
    const int nfull = n >> 8;
    for (int j = 0; j < nfull; ++j) { const f32x4 v4 = *(const LAS f32x4*)(sc + 256 * j + 4 * lane);
#pragma unroll
        for (int e = 0; e < 4; ++e) { int bq = (int)((v4[e] - lo) * scale); bq = bq > 511 ? 511 : bq; (void)__hip_atomic_fetch_add(hist + bq, 1u, __ATOMIC_RELAXED, __HIP_MEMORY_SCOPE_WORKGROUP); } }
    if ((nfull << 8) < n) { const int i0 = 256 * nfull + 4 * lane; const f32x4 v4 = *(const LAS f32x4*)(sc + i0);
#pragma unroll
        for (int e = 0; e < 4; ++e) if (i0 + e < n) { int bq = (int)((v4[e] - lo) * scale); bq = bq > 511 ? 511 : bq; (void)__hip_atomic_fetch_add(hist + bq, 1u, __ATOMIC_RELAXED, __HIP_MEMORY_SCOPE_WORKGROUP); } }
    unsigned wd[8]; int lsum = 0;
#pragma unroll
    for (int k = 0; k < 8; ++k) { wd[k] = hist[lane * 8 + k]; lsum += (int)wd[k]; }
    int incl = lsum;
#pragma unroll
    for (int d = 1; d < 64; d <<= 1) { const int t = __shfl_down(incl, d); if (lane + d < 64) incl += t; }
    const int excl = incl - lsum;
    const bool mine = (excl < TOPK) && (incl >= TOPK);
    int fb = 0, fabove = 0, fcnt = 0, run = excl; bool found = false;
#pragma unroll
    for (int k = 7; k >= 0; --k) { const int cb = (int)wd[k]; const bool hit = !found && (run + cb >= TOPK);
        if (hit) { fb = 8 * lane + k; fabove = run; fcnt = cb; found = true; } if (!found) run += cb; }
    const unsigned long long bm = __ballot(mine);
    const int src = bm ? __builtin_ctzll(bm) : 0;
    const int bstar = __shfl(fb, src), above = __shfl(fabove, src), cntb = __shfl(fcnt, src);
    const int need = TOPK - above;
    const bool all = (cntb == need);
    if (!all && cntb > 64) return false;
    const float T0 = (float)bstar, T1 = all ? T0 : (bstar == 511 ? 3.0e38f : (float)(bstar + 1));
    const unsigned selb = (unsigned)(size_t)sel, trash = (unsigned)(size_t)(cidx + 64 + lane);
    const int nblk = (n + 255) >> 8; int nsel = 0;
    for (int j = 0; j < nblk; ++j) { const int i0 = 256 * j + 4 * lane; const f32x4 v4 = *(const LAS f32x4*)(sc + i0);
        float x[4]; unsigned tk[4]; bool cd[4]; bool anyc = false;
#pragma unroll
        for (int e = 0; e < 4; ++e) { x[e] = (v4[e] - lo) * scale; const bool in = i0 + e < n; tk[e] = (in && x[e] >= T1) ? 1u : 0u; cd[e] = in && !(x[e] >= T1) && x[e] >= T0; anyc = anyc || cd[e]; }
#pragma unroll
        for (int e = 0; e < 4; ++e) { const unsigned long long bt = __ballot(tk[e] != 0u);
            const unsigned addr = tk[e] ? selb + 2u * (unsigned)(nsel + mbcnt64(bt)) : trash; *(LAS unsigned short*)(size_t)addr = (unsigned short)(i0 + e); nsel += __builtin_popcountll(bt); }
        if (__any(anyc)) {
#pragma unroll
            for (int e = 0; e < 4; ++e) if (cd[e]) { const unsigned k = __hip_atomic_fetch_add(ctr + 1, 1u, __ATOMIC_RELAXED, __HIP_MEMORY_SCOPE_WORKGROUP); cval[k] = v4[e]; cidx[k] = (unsigned short)(i0 + e); } }
    }
    if (!all) {
        const float my = lane < cntb ? cval[lane] : 0.f; const int myi = lane < cntb ? (int)cidx[lane] : 0; int rank = 0;
        for (int k = 0; k < cntb; ++k) { const float o = cval[k]; const int oi = (int)cidx[k]; rank += (o > my || (o == my && oi < myi)) ? 1 : 0; }
        const bool take = lane < cntb && rank < need;
        const unsigned long long bt = __ballot(take);
        if (take) sel[above + mbcnt64(bt)] = (unsigned short)myi;
    }
    return true;
}
__device__ __forceinline__ void topk_select(const LAS float* sc, int n, float lo, float hi, LAS unsigned* hist, LAS unsigned short* sel, LAS float* cval, LAS unsigned short* cidx, int lane) {
    int need = TOPK, mode = 2, bstar = 0; float scale = 0.f;
    const int nit = (n + 255) >> 8;
    for (int level = 0; level < 8; ++level) {
        const float range = hi - lo;
        if (!(range > 1e-30f)) { mode = 2; bstar = 0; scale = 0.f; break; }
        scale = 1024.f / range;
#pragma unroll
        for (int k = 0; k < 8; ++k) hist[lane * 8 + k] = 0u;
        for (int j = 0; j < nit; ++j) { const int i0 = 256 * j + 4 * lane; const f32x4 v4 = *(const LAS f32x4*)(sc + i0);
#pragma unroll
            for (int e = 0; e < 4; ++e) { const float v = v4[e];
                if (i0 + e < n && v >= lo && v <= hi) { const int bq = binof(v, lo, scale); (void)__hip_atomic_fetch_add(hist + (bq >> 1), 1u << (16 * (bq & 1)), __ATOMIC_RELAXED, __HIP_MEMORY_SCOPE_WORKGROUP); } } }
        unsigned wd[8]; int lsum = 0;
#pragma unroll
        for (int k = 0; k < 8; ++k) { wd[k] = hist[lane * 8 + k]; lsum += (int)(wd[k] & 0xffffu) + (int)(wd[k] >> 16); }
        int incl = lsum;
#pragma unroll
        for (int d = 1; d < 64; d <<= 1) { const int t = __shfl_down(incl, d); if (lane + d < 64) incl += t; }
        const int excl = incl - lsum;
        const bool mine = (excl < need) && (incl >= need);
        int fb = 0, fabove = 0, fcnt = 0, run = excl; bool found = false;
#pragma unroll
        for (int k = 15; k >= 0; --k) { const int cb = (int)((wd[k >> 1] >> (16 * (k & 1))) & 0xffffu); const bool hit = !found && (run + cb >= need);
            if (hit) { fb = 16 * lane + k; fabove = run; fcnt = cb; found = true; } if (!found) run += cb; }
        const unsigned long long bm = __ballot(mine);
        const int src = bm ? __builtin_ctzll(bm) : 0;
        bstar = __shfl(fb, src); const int above = __shfl(fabove, src), cntb = __shfl(fcnt, src);
        need -= above;
        if (cntb == need) { mode = 1; break; }
        if (cntb <= 64) { mode = 0; break; }
        float cl = 3.0e38f, chh = -3.0e38f;
        for (int i = lane; i < n; i += 64) { const float v = sc[i]; if (v >= lo && v <= hi && binof(v, lo, scale) == bstar) { cl = fminf(cl, v); chh = fmaxf(chh, v); } }
        lo = wave_min(cl); hi = wave_max(chh); mode = 2; bstar = 0; scale = 0.f;
    }
    int nsel = 0, ncand = 0;
    if (mode == 2) {
        for (int i0 = 0; i0 < n; i0 += 64) {
            const int i = i0 + lane; const bool in = i < n; const float v = in ? sc[i] : 0.f;
            const bool inr = in && v >= lo && v <= hi; const int bq = binof(v, lo, scale);
            const bool cand = inr && bq == bstar;
            const unsigned long long bc = __ballot(cand);
            const bool take = (in && (v > hi || (inr && bq > bstar))) || (cand && (ncand + mbcnt64(bc)) < need);
            const unsigned long long bt = __ballot(take);
            if (take) sel[nsel + mbcnt64(bt)] = (unsigned short)i;
            nsel += __builtin_popcountll(bt); ncand += __builtin_popcountll(bc);
        }
        return;
    }
    for (int j = 0; j < nit; ++j) { const int i0 = 256 * j + 4 * lane; const f32x4 v4 = *(const LAS f32x4*)(sc + i0);
#pragma unroll
        for (int e = 0; e < 4; ++e) { const float v = v4[e]; const int i = i0 + e; const bool in = i < n;
            const bool inr = in && v >= lo && v <= hi; const int bq = binof(v, lo, scale);
            const bool cand = inr && bq == bstar;
            const bool take = (in && (v > hi || (inr && bq > bstar))) || (mode == 1 && cand);
            const unsigned long long bt = __ballot(take);
            if (take) sel[nsel + mbcnt64(bt)] = (unsigned short)i;
            nsel += __builtin_popcountll(bt);
            if (mode == 0) { const unsigned long long bc = __ballot(cand);
                if (cand) { const int k = ncand + mbcnt64(bc); cval[k] = v; cidx[k] = (unsigned short)i; }
                ncand += __builtin_popcountll(bc); } } }
    if (mode == 0) {
        const float my = lane < ncand ? cval[lane] : 0.f; const int myi = lane < ncand ? (int)cidx[lane] : 0; int rank = 0;
        for (int k = 0; k < ncand; ++k) { const float o = cval[k]; const int oi = (int)cidx[k]; rank += (o > my || (o == my && oi < myi)) ? 1 : 0; }
        const bool take = lane < ncand && rank < need;
        const unsigned long long bt = __ballot(take);
        if (take) sel[nsel + mbcnt64(bt)] = (unsigned short)myi;
    }
}
template <int VAR> __device__ __forceinline__ void dsa_round(const f16* __restrict__ P, const f16* __restrict__ kdsc, const f16* __restrict__ vdsc, const f16* __restrict__ kix, const float* __restrict__ wix, const float* __restrict__ dsg, f16* __restrict__ merged,
                                          LAS unsigned char* lds, int b, int t0, int nb, int nt0, int wave, int lane_in, int flags) {
    int lane = lane_in; asm volatile("" : "+v"(lane));
    int c = lane & 31, h = lane >> 5;
    LAS float* MM = (LAS float*)(lds + XTRA_OFF + X_MM);
    LAS float* WSM = (LAS float*)(lds + XTRA_OFF + X_WSM);
    {
        half8 aix[4][4];
#pragma unroll
        for (int p = 0; p < 4; ++p) {
            const int query = t0 + 2 * p + ((c >> 2) & 1), head = (c & 3) + 4 * (c >> 3);
            const f16* ap = P + (size_t)(b * SEQ + query) * NINP + C_QIX + head * IXD + 8 * h;
#pragma unroll
            for (int st = 0; st < 4; ++st) aix[p][st] = *(const half8*)(ap + 16 * st);
        }
        float wv[4][16];
#pragma unroll
        for (int p = 0; p < 4; ++p) { const float* wp = wix + (size_t)(b * SEQ + t0 + 2 * p + h) * 16;
#pragma unroll
            for (int i4 = 0; i4 < 4; ++i4) { const f32x4 w4 = *(const f32x4*)(wp + 4 * i4); wv[p][4 * i4] = 0.5f * w4.x; wv[p][4 * i4 + 1] = 0.5f * w4.y; wv[p][4 * i4 + 2] = 0.5f * w4.z; wv[p][4 * i4 + 3] = 0.5f * w4.w; } }
        float mn[4], mx[4];
#pragma unroll
        for (int p = 0; p < 4; ++p) { mn[p] = 3.0e38f; mx[p] = -3.0e38f; }
        const int ntile = (t0 + 8 + 31) >> 5;
        half8 kf[4], kn[4];
        const f16* kp0 = kix + (size_t)(b * SEQ + c) * IXD + 8 * h;
        auto kload = [&](half8 (&dst)[4], int jt) {
#pragma unroll
            for (int st = 0; st < 4; ++st) dst[st] = *(const half8*)(kp0 + (unsigned)(32 * jt * IXD + 16 * st)); };
        auto body = [&](const half8 (&kk)[4], int jt) {
            f32x16 acc[4];
#pragma unroll
            for (int p = 0; p < 4; ++p)
#pragma unroll
                for (int i = 0; i < 16; ++i) acc[p][i] = 0.f;
#pragma unroll
            for (int st = 0; st < 4; ++st)
#pragma unroll
                for (int p = 0; p < 4; ++p) acc[p] = __builtin_amdgcn_mfma_f32_32x32x16_f16(aix[p][st], kk[st], acc[p], 0, 0, 0);
#pragma unroll
            for (int p = 0; p < 4; ++p) {
                float scv = 0.f;
#pragma unroll
                for (int i = 0; i < 16; ++i) scv = __builtin_fmaf(wv[p][i], acc[p][i] + __builtin_fabsf(acc[p][i]), scv);
                *(LAS float*)(lds + (2 * p + h) * 16384 + 4 * (32 * jt + c)) = scv;
                mn[p] = fminf(mn[p], scv); mx[p] = fmaxf(mx[p], scv);
            } };
        const int jlast = ntile - 1;
        kload(kf, wave < jlast ? wave : jlast);
        if (!(flags & 16)) for (int jt = wave; jt < ntile; jt += 2 * NWAVES) {
            const int j1 = jt + NWAVES < jlast ? jt + NWAVES : jlast, j2 = jt + 2 * NWAVES < jlast ? jt + 2 * NWAVES : jlast;
            kload(kn, j1);
            __builtin_amdgcn_sched_barrier(0);
            body(kf, jt);
            kload(kf, j2);
            __builtin_amdgcn_sched_barrier(0);
            body(kn, j1);

        }
#pragma unroll
        for (int p = 0; p < 4; ++p) {
#pragma unroll
            for (int o = 1; o < 32; o <<= 1) { mn[p] = fminf(mn[p], __shfl_xor(mn[p], o)); mx[p] = fmaxf(mx[p], __shfl_xor(mx[p], o)); }
            if (c == 0) { MM[(wave * 8 + 2 * p + h) * 2] = mn[p]; MM[(wave * 8 + 2 * p + h) * 2 + 1] = mx[p]; }
        }
    }
    __syncthreads();
    if (flags & 8) { __syncthreads(); return; }
    const int t = t0 + wave, n = t + 1;
    LAS unsigned char* reg = lds + wave * 16384;
    LAS unsigned short* sel = (LAS unsigned short*)(lds + XTRA_OFF + X_SEL + wave * 512);
    int cnt;
    if (n <= TOPK) { for (int i = lane; i < n; i += 64) sel[i] = (unsigned short)i; cnt = n; }
    else { cnt = TOPK;
        float lo = 3.0e38f, hi = -3.0e38f;
#pragma unroll
        for (int w = 0; w < NWAVES; ++w) { lo = fminf(lo, MM[(w * 8 + wave) * 2]); hi = fmaxf(hi, MM[(w * 8 + wave) * 2 + 1]); }
        LAS unsigned* hist = (LAS unsigned*)(lds + XTRA_OFF + X_HIST + wave * 2048); LAS float* cval = (LAS float*)(lds + XTRA_OFF + X_CVAL + wave * 256);
        LAS unsigned short* cidx = (LAS unsigned short*)(lds + XTRA_OFF + X_CIDX + wave * 256);
        if (!topk_fast((const LAS float*)reg, n, lo, hi, hist, sel, cval, cidx, (LAS unsigned*)(lds + XTRA_OFF + X_WSM + wave * 8), lane))
            topk_select((const LAS float*)reg, n, lo, hi, hist, sel, cval, cidx, lane); }
    if (flags & 4) { __syncthreads(); return; }
    asm volatile("" : "+v"(lane));
    const int cc = lane & 15, g = lane >> 4;
    LAS unsigned char* ktile = reg; LAS unsigned char* vtile = reg + 8192;
    half8 qf[4];
    { const f16* qp = P + (size_t)(b * SEQ + t) * NINP + C_QDS + (cc & 7) * HD + 8 * g;
#pragma unroll
      for (int st = 0; st < 4; ++st) { half8 v = *(const half8*)(qp + 32 * st);
#pragma unroll
          for (int j = 0; j < 8; ++j) v[j] = cc < 8 ? v[j] : (f16)0.f;
          qf[st] = v; } }
    int ka[4], va[8];
    { const int swr = sw16(cc);
#pragma unroll
      for (int st = 0; st < 4; ++st) ka[st] = 256 * cc + 16 * ((4 * st + g) ^ swr);
      const int q = cc >> 2, p = cc & 3, swk = (q << 2) | g;
#pragma unroll
      for (int mt = 0; mt < 8; ++mt) va[mt] = 256 * (4 * g + q) + 16 * ((2 * mt + (p >> 1)) ^ swk) + 8 * (p & 1); }
    f32x4 o[8];
#pragma unroll
    for (int mt = 0; mt < 8; ++mt) o[mt] = (f32x4){0.f, 0.f, 0.f, 0.f};
    float mrun = -1.0e30f, lrun = 0.f;
    const unsigned char* kbase = (const unsigned char*)(kdsc + (size_t)(b * SEQ) * HD);
    const unsigned char* vbase = (const unsigned char*)(vdsc + (size_t)(b * SEQ) * HD);
    const int nch = (cnt + 31) >> 5;
    TileRegs tk, tv;
    unsigned offs[8];
    sel_offs8(offs, sel, 8 * g, cnt);
    fetch_rows8(tk, kbase, offs, lane);
    for (int ch = 0; ch < nch; ++ch) {
        put_rows8(tk, ktile, lane);
        fetch_rows8(tv, vbase, offs, lane);
        f32x4 z0 = {0.f, 0.f, 0.f, 0.f}, z1 = z0;
#pragma unroll
        for (int st = 0; st < 4; ++st) {
            const half8 k0 = *(const LAS half8*)(ktile + ka[st]), k1 = *(const LAS half8*)(ktile + ka[st] + 4096);
            z0 = __builtin_amdgcn_mfma_f32_16x16x32_f16(k0, qf[st], z0, 0, 0, 0);
            z1 = __builtin_amdgcn_mfma_f32_16x16x32_f16(k1, qf[st], z1, 0, 0, 0); }
        float mx = -1.0e30f;
#pragma unroll
        for (int r = 0; r < 4; ++r) { if (32 * ch + 4 * g + r >= cnt) z0[r] = -1.0e30f; if (32 * ch + 16 + 4 * g + r >= cnt) z1[r] = -1.0e30f; mx = fmaxf(mx, fmaxf(z0[r], z1[r])); }
        if (__any(mx > mrun + 8.f)) {
            mx = fmaxf(mx, __shfl_xor(mx, 16)); mx = fmaxf(mx, __shfl_xor(mx, 32));
            const float mnew = fmaxf(mrun, mx), alpha = __expf(mrun - mnew);
            lrun *= alpha; mrun = mnew;
#pragma unroll
            for (int mt = 0; mt < 8; ++mt) o[mt] *= alpha;
        }
        half8 pf;
#pragma unroll
        for (int r = 0; r < 4; ++r) { const float p0 = __expf(z0[r] - mrun), p1 = __expf(z1[r] - mrun); lrun += p0 + p1; pf[r] = (f16)p0; pf[4 + r] = (f16)p1; }
        put_rows8(tv, vtile, lane);
        { const int chn = ch + 1 < nch ? ch + 1 : ch; sel_offs8(offs, sel, 32 * chn + 8 * g, cnt); fetch_rows8(tk, kbase, offs, lane); }
#pragma unroll
        for (int mt = 0; mt < 8; ++mt) { const half8 vf = cat8(tr_read(vtile + va[mt]), tr_read(vtile + va[mt] + 4096));
            o[mt] = __builtin_amdgcn_mfma_f32_16x16x32_f16(vf, pf, o[mt], 0, 0, 0); }
    }
    lrun += __shfl_xor(lrun, 16); lrun += __shfl_xor(lrun, 32);
    const float inv = 1.f / lrun;
    float sq = 0.f;
#pragma unroll
    for (int mt = 0; mt < 8; ++mt) { o[mt] *= inv; sq += (o[mt].x * o[mt].x + o[mt].y * o[mt].y) + (o[mt].z * o[mt].z + o[mt].w * o[mt].w); }
    sq = cc < 8 ? sq : 0.f;
    const float rstd = rsqrtf(wave_sum(sq) * (1.f / 1024.f) + EPS);
    if (cc < 8) {
#pragma unroll
        for (int mt = 0; mt < 8; ++mt) { const int d = 16 * mt + 4 * g; const f32x4 gg = *(const f32x4*)(dsg + cc * HD + d);
            u32x2 w2; w2.x = pk_h2(o[mt].x * rstd * gg.x, o[mt].y * rstd * gg.y); w2.y = pk_h2(o[mt].z * rstd * gg.z, o[mt].w * rstd * gg.w);
            *(u32x2*)(merged + (size_t)(b * SEQ + t) * DM + 1024 + cc * HD + d) = w2; }
    }
    if (nt0 >= 0) {
        int nb2 = nb, nt2 = nt0; asm volatile("" : "+s"(nb2), "+s"(nt2));
        int tid2 = threadIdx.x; asm volatile("" : "+v"(tid2)); const f16* rowp = P + (size_t)(nb2 * SEQ + nt2 + (tid2 >> 5 & 7)) * NINP;
        const void* src = tid2 < 256 ? (const void*)(rowp + C_QIX + (tid2 & 31) * 32) : (const void*)(rowp + C_QDS + (tid2 & 31) * 32);
        __builtin_amdgcn_global_load_lds((const unsigned*)src, (LAS unsigned*)(lds + XTRA_OFF + 26624 + (tid2 >> 6) * 0), 4, 0, 0);
        if (tid2 < 32) __builtin_amdgcn_global_load_lds((const unsigned*)(wix + (size_t)(nb2 * SEQ + nt2) * 16 + tid2 * 4), (LAS unsigned*)(lds + XTRA_OFF + 26624 + 256), 4, 0, 0);
    }
    __syncthreads();
}
}

#define XB_TMO      128
#define XB_XCNT(j)  (256  + 64 * (j))
#define XB_XSUB(j)  (1280 + 64 * (j))
#define XB_XGEN(j)  (2304 + 64 * (j))
#define XB_TOP      3328
#define XB_TOPGEN   3392
#define XCD_BAR_WORDS 3456
#define XB_SPIN_CAP (1u << 18)
__device__ __forceinline__ unsigned xb_ld(unsigned* p)              { return __hip_atomic_load(p, __ATOMIC_RELAXED, __HIP_MEMORY_SCOPE_AGENT); }
__device__ __forceinline__ unsigned xb_add(unsigned* p, unsigned v) { return __hip_atomic_fetch_add(p, v, __ATOMIC_RELAXED, __HIP_MEMORY_SCOPE_AGENT); }
__device__ __forceinline__ unsigned xb_xcc_id() { return (unsigned)__builtin_amdgcn_s_getreg((3 << 11) | 20) & 0xFu; }
#define XB_SPIN(cond, bar) do { unsigned _sp = 0; while (cond) { __builtin_amdgcn_s_sleep(1); \
    if ((++_sp & 255u) == 0u) { if (xb_ld(&(bar)[XB_TMO])) break; if (_sp > XB_SPIN_CAP) { atomicAdd(&(bar)[XB_TMO], 1u); break; } } } } while (0)
struct XcdBarrier { unsigned* bar; unsigned x; volatile LAS unsigned* st; };
__device__ __forceinline__ XcdBarrier xcd_barrier_post(unsigned* bar, volatile LAS unsigned* st) {
    XcdBarrier b; b.bar = bar; b.x = xb_xcc_id(); b.st = st;
    if (threadIdx.x == 0) (void)xb_add(&bar[XB_XCNT(b.x)], 1u);
    return b;
}
__device__ __forceinline__ void xcd_barrier_complete(unsigned* bar, unsigned x, unsigned& nloc, unsigned& nx) {
    const unsigned G = gridDim.x * gridDim.y * gridDim.z;
    unsigned sum, cnt, mine, sp = 0u;
    for (;;) {
        sum = 0u; cnt = 0u; mine = 0u;
#pragma unroll
        for (unsigned j = 0; j < 16; ++j) { const unsigned c = xb_ld(&bar[XB_XCNT(j)]); sum += c; cnt += (c > 0u) ? 1u : 0u; mine = (j == x) ? c : mine; }
        if (sum == G) break;
        __builtin_amdgcn_s_sleep(1);
        if ((++sp & 255u) == 0u) { if (xb_ld(&bar[XB_TMO])) break; if (sp > XB_SPIN_CAP) { atomicAdd(&bar[XB_TMO], 1u); break; } }
    }
    nloc = mine > 0u ? mine : 1u; nx = cnt > 0u ? cnt : 1u;
}
__device__ __forceinline__ void xcd_barrier(const XcdBarrier& b) {
    asm volatile("s_waitcnt vmcnt(0)" ::: "memory");
    __syncthreads();
    if (threadIdx.x == 0) {
        unsigned* bar = b.bar;
        __builtin_amdgcn_s_waitcnt(0);
        unsigned nloc = b.st[0], nx = b.st[1];
        if (nloc == 0u) { xcd_barrier_complete(bar, b.x, nloc, nx); b.st[0] = nloc; b.st[1] = nx; }
        const unsigned old = xb_add(&bar[XB_XSUB(b.x)], 1u);
        const unsigned gen = old / nloc;
        if (old + 1u == (gen + 1u) * nloc) {
            __builtin_amdgcn_fence(__ATOMIC_RELEASE, "agent");
            asm volatile("s_waitcnt vmcnt(0)" ::: "memory");
            const unsigned og = xb_add(&bar[XB_TOP], 1u);
            const unsigned tg = og / nx;
            if (og + 1u == (tg + 1u) * nx) xb_add(&bar[XB_TOPGEN], 1u);
            else XB_SPIN(xb_ld(&bar[XB_TOPGEN]) == tg, bar);
            __builtin_amdgcn_fence(__ATOMIC_ACQUIRE, "agent");
            xb_add(&bar[XB_XGEN(b.x)], 1u);
            asm volatile("s_waitcnt vmcnt(0)" ::: "memory");
        } else {
            XB_SPIN(xb_ld(&bar[XB_XGEN(b.x)]) == gen, bar);
            __builtin_amdgcn_fence(__ATOMIC_ACQUIRE, "agent");
            asm volatile("s_waitcnt vmcnt(0)" ::: "memory");
        }
    }
    __syncthreads();
}

struct Args {
    const float* x; const float* c; const int* pos; const float* w_ada; const float* b_ada; const float* n1g; const float* w_in; const float* sbg; const float* dsg;
    const float* w_out; const float* n2g; const float* w_up; const float* conv_w; const float* conv_b; const float* w_down; const float* fng;
    float* out; unsigned char* ws; int ph_lo, ph_hi, region, pad;
};

constexpr int TR_IN8_BASE = 1 << 20;
struct TrItem { const float* W; f16* WT; const float* gk; const float* q8; int K, N, k0, n0, up, pitch; };
__device__ __forceinline__ TrItem tr_decode(const Args& a, int r, bool fold) {
    constexpr int NB_IN = NINP / 32, I_IN = (DM / 64) * (NINP / 32 - IN8_NB), I_OUT = (DM / 64) * (DM / 32), I_UP = (DM / 64) * (NUP / 32);
    TrItem t; int nblk;
    t.gk = nullptr; t.q8 = nullptr; t.pitch = 0;
    if (r >= TR_IN8_BASE) {
        const int i = r - TR_IN8_BASE; t.W = a.w_in; t.WT = (f16*)(a.ws + WS_WTIN8); t.K = DM; t.N = NIN; t.up = 2; t.q8 = (const float*)((const unsigned*)(a.ws + WS_CTL) + CW_SIMAX) - IN8_LO;
        t.k0 = 64 * (i / IN8_NB); t.n0 = IN8_LO + 32 * (i % IN8_NB); return t; }
    if (r < I_IN) { t.W = a.w_in; t.WT = (f16*)(a.ws + WS_WTIN); t.K = DM; t.N = NIN; t.up = 0;
        constexpr int NBF = NB_IN - IN8_NB; const int nbi = r % NBF; t.k0 = 64 * (r / NBF); t.n0 = 32 * (nbi < IN8_LO / 32 ? nbi : nbi + IN8_NB); return t; }
    else if ((r -= I_IN) < I_OUT) { t.W = a.w_out; t.WT = (f16*)(a.ws + WS_WTOUT); t.K = DM; t.N = DM; nblk = DM / 32; t.up = 0; t.gk = fold ? a.sbg : nullptr; }
    else if ((r -= I_OUT) < I_UP) { t.W = a.w_up; t.WT = (f16*)(a.ws + WS_WTUP); t.K = DM; t.N = NUP; nblk = NUP / 32; t.up = 1; t.q8 = (const float*)((const unsigned*)(a.ws + WS_CTL) + CW_SBMAX); }
    else { r -= I_UP; t.W = a.w_down; t.WT = (f16*)(a.ws + WS_WTDN); t.K = DFF; t.N = DM; nblk = DM / 32; t.up = 0; t.q8 = (const float*)((const unsigned*)(a.ws + WS_CTL) + CW_SDMAX); t.pitch = DFFP; }
    t.k0 = 64 * (r / nblk); t.n0 = 32 * (r % nblk); return t;
}
__device__ __forceinline__ void tr_load(const TrItem& t, f32x4 (&v)[8], int lane) {
    const int n = t.n0 + 4 * (lane & 7); const bool ok = n < t.N;
    const float* p = t.W + (size_t)(t.k0 + (lane >> 3)) * t.N + (ok ? n : 0);
#pragma unroll
    for (int i = 0; i < 8; ++i) { const f32x4 x = __builtin_nontemporal_load((const f32x4*)(p + (size_t)(8 * i) * t.N)); v[i] = ok ? x : (f32x4){0.f, 0.f, 0.f, 0.f}; }
}
__device__ __forceinline__ void tr_store(const TrItem& t, const f32x4 (&v)[8], LAS float* scr, int lane) {
#pragma unroll
    for (int i = 0; i < 8; ++i) { LAS float* d = scr + ((lane >> 3) + 8 * i) * 33 + 4 * (lane & 7); d[0] = v[i].x; d[1] = v[i].y; d[2] = v[i].z; d[3] = v[i].w; }
    asm volatile("s_waitcnt lgkmcnt(0)" ::: "memory");
    const int c = lane & 7;
    f32x4 g0 = {1.f, 1.f, 1.f, 1.f}, g1 = g0;
    if (t.gk && t.k0 < 1024) { g0 = *(const f32x4*)(t.gk + t.k0 + 8 * c); g1 = *(const f32x4*)(t.gk + t.k0 + 8 * c + 4); }
#pragma unroll
    for (int j = 0; j < 4; ++j) { const int nn = (lane >> 3) + 8 * j; const LAS float* sp = scr + (8 * c) * 33 + nn;
        int n = t.n0 + nn;
        if (t.q8) {
            const float inv = 63.5f * __builtin_amdgcn_rcpf(fmaxf(t.q8[n], 1e-20f));
            u32x2 o; o.x = q8x4(sp[0 * 33] * inv, sp[1 * 33] * inv, sp[2 * 33] * inv, sp[3 * 33] * inv); o.y = q8x4(sp[4 * 33] * inv, sp[5 * 33] * inv, sp[6 * 33] * inv, sp[7 * 33] * inv);
            if (t.up == 2) n -= IN8_LO; else if (t.up) n = n < DFF ? (n / 128) * 256 + (n % 128) : ((n - DFF) / 128) * 256 + 128 + ((n - DFF) % 128);
            *(u32x2*)((unsigned char*)t.WT + (size_t)n * (t.pitch ? t.pitch : t.K) + t.k0 + 8 * c) = o;
        } else {
        u32x4 o; o.x = pk_h2(sp[0 * 33] * g0.x, sp[1 * 33] * g0.y); o.y = pk_h2(sp[2 * 33] * g0.z, sp[3 * 33] * g0.w); o.z = pk_h2(sp[4 * 33] * g1.x, sp[5 * 33] * g1.y); o.w = pk_h2(sp[6 * 33] * g1.z, sp[7 * 33] * g1.w);
        if (t.up) n = n < DFF ? (n / 128) * 256 + (n % 128) : ((n - DFF) / 128) * 256 + 128 + ((n - DFF) % 128);
        *(u32x4*)(t.WT + (size_t)n * t.K + t.k0 + 8 * c) = o; } }
    asm volatile("s_waitcnt lgkmcnt(0)" ::: "memory");
}
constexpr int ADA_KC = 32, ADA_ROWS = DM / ADA_KC;
__device__ __forceinline__ void p0_ada_item(const float* __restrict__ w_ada, const float* __restrict__ b_ada, const LAS float* sil, float* __restrict__ modp, float* __restrict__ mod, unsigned* cnt, int item, int lane) {
    const int kc = item / 48, jc = item % 48, j0 = jc * 256 + lane * 4;
    f32x4 a0 = {0.f, 0.f, 0.f, 0.f}, a1 = {0.f, 0.f, 0.f, 0.f};
    const float* wp = w_ada + (size_t)(kc * ADA_ROWS) * MODW + j0;
#pragma unroll 32
    for (int k = 0; k < ADA_ROWS; ++k) { const f32x4 w = __builtin_nontemporal_load((const f32x4*)(wp + (size_t)k * MODW)); const float s0 = sil[kc * ADA_ROWS + k], s1 = sil[DM + kc * ADA_ROWS + k]; a0 += w * s0; a1 += w * s1; }
    { float* p0 = modp + (size_t)(kc * 2 + 0) * MODW + j0; float* p1 = modp + (size_t)(kc * 2 + 1) * MODW + j0;
#pragma unroll
      for (int e = 0; e < 4; ++e) { __hip_atomic_store(p0 + e, a0[e], __ATOMIC_RELAXED, __HIP_MEMORY_SCOPE_AGENT); __hip_atomic_store(p1 + e, a1[e], __ATOMIC_RELAXED, __HIP_MEMORY_SCOPE_AGENT); } }
    asm volatile("s_waitcnt vmcnt(0)" ::: "memory");
    unsigned old = 0u;
    if (lane == 0) old = __hip_atomic_fetch_add(cnt + 64 * jc, 1u, __ATOMIC_RELAXED, __HIP_MEMORY_SCOPE_AGENT);
    old = (unsigned)__builtin_amdgcn_readfirstlane((int)old);
    if (old == (unsigned)(ADA_KC - 1)) {
        const f32x4 bias = *(const f32x4*)(b_ada + j0);
        f32x4 s0 = bias, s1 = bias;
#pragma unroll 4
        for (int k2 = 0; k2 < ADA_KC; ++k2) { const float* p0 = modp + (size_t)(k2 * 2 + 0) * MODW + j0; const float* p1 = modp + (size_t)(k2 * 2 + 1) * MODW + j0;
#pragma unroll
            for (int e = 0; e < 4; ++e) { s0[e] += __hip_atomic_load(p0 + e, __ATOMIC_RELAXED, __HIP_MEMORY_SCOPE_AGENT); s1[e] += __hip_atomic_load(p1 + e, __ATOMIC_RELAXED, __HIP_MEMORY_SCOPE_AGENT); } }
        *(f32x4*)(mod + j0) = s0; *(f32x4*)(mod + MODW + j0) = s1;
    }
}
__device__ __forceinline__ void tr_run(const Args& a, LAS float* scr, int base, int it0, int stride, int cnt, int lane, bool fold) {
    if (cnt <= 0) return;
    f32x4 v0[8], v1[8], v2[8];
    TrItem c0 = tr_decode(a, base + it0, fold), c1 = c0, c2 = c0;
    tr_load(c0, v0, lane);
    if (cnt > 1) { c1 = tr_decode(a, base + it0 + stride, fold); tr_load(c1, v1, lane); }
    for (int q = 0; q < cnt; ++q) {
        if (q + 2 < cnt) { c2 = tr_decode(a, base + it0 + (q + 2) * stride, fold); tr_load(c2, v2, lane); }
        tr_store(c0, v0, scr, lane);
        c0 = c1; c1 = c2;
#pragma unroll
        for (int i = 0; i < 8; ++i) { v0[i] = v1[i]; v1[i] = v2[i]; }
    }
}
constexpr int UP_DEFER = 4992;
constexpr int TR_I_IN8 = (DM / 64) * IN8_NB;
constexpr int TR_I_IN = (DM / 64) * (NINP / 32 - IN8_NB), TR_I_OUT = (DM / 64) * (DM / 32), TR_I_UP = (DM / 64) * (NUP / 32), TR_I_DN = (DFF / 64) * (DM / 32);
__device__ __forceinline__ void tr_deferred(const Args& a, LAS unsigned char* lds, int base, int nitems, int nwg, int G, int wave, int lane) {
    const int busy = nwg % G;
    const int nidle = busy ? G - busy : G, me = busy ? (int)blockIdx.x - busy : (int)blockIdx.x;
    if (me < 0) return;
    const int it0 = me * NWAVES + wave, stride = nidle * NWAVES;
    tr_run(a, (LAS float*)(lds + wave * 16384), base, it0, stride, (nitems - it0 + stride - 1) / stride, lane, false);
}
__device__ __forceinline__ void phase0(const Args& a, LAS unsigned char* lds, int vcu, int G, int wave, int lane, bool fold) {
    unsigned char* ws = a.ws;
    LAS float* sil = (LAS float*)(lds + XTRA_OFF);
    for (int e = threadIdx.x; e < BATCH * DM; e += NWAVES * 64) sil[e] = silu_f(a.c[e]);
    __syncthreads();
    LAS float* scr = (LAS float*)(lds + wave * 16384);
    const int gw = vcu * NWAVES + wave, NGW = G * NWAVES;
    float* modp = (float*)(ws + WS_MODP);
    constexpr int NADA = ADA_KC * 48, HW = 6, HS = 2, NITEMS = TR_I_IN;
    if (wave < HW) for (int it = vcu * HW + wave; it < NADA; it += G * HW) p0_ada_item(a.w_ada, a.b_ada, sil, modp, (float*)(ws + WS_MOD), (unsigned*)(ws + WS_CTL) + CW_ADA, it, lane);
    const int nheavy = G * HW, nlight = G * (NWAVES - HW);
    const int nh_items = nheavy * HS < NITEMS ? nheavy * HS : NITEMS;
    int it0, stride, cnt;
    if (wave < HW) { it0 = (NITEMS - nh_items) + (vcu * HW + wave) * HS; stride = 1; cnt = HS; if (it0 + cnt > NITEMS) cnt = NITEMS - it0 > 0 ? NITEMS - it0 : 0; }
    else { it0 = vcu * (NWAVES - HW) + (wave - HW); stride = nlight; cnt = (NITEMS - nh_items - it0 + stride - 1) / stride; if (cnt < 0) cnt = 0; }
    tr_run(a, scr, 0, it0, stride, cnt, lane, fold);
    { unsigned* sbmax = (unsigned*)(ws + WS_CTL) + CW_SBMAX;
      for (int e = (vcu * NWAVES + wave) * 64 + lane; e < NUP * 16; e += NGW * 64) { const int n = e % NUP, rg = e / NUP; float mx = 0.f;
#pragma unroll
          for (int k = 0; k < 8; ++k) mx = fmaxf(mx, fabsf(a.w_up[(size_t)(rg * 8 + k) * NUP + n]));
          (void)__hip_atomic_fetch_max(sbmax + n, __builtin_bit_cast(unsigned, mx), __ATOMIC_RELAXED, __HIP_MEMORY_SCOPE_AGENT); } }
    { unsigned* sdmax = (unsigned*)(ws + WS_CTL) + CW_SDMAX;
      for (int e = (vcu * NWAVES + wave) * 64 + lane; e < DM * 16; e += NGW * 64) { const int n = e % DM, rg = e / DM; float mx = 0.f;
#pragma unroll
          for (int k = 0; k < 8; ++k) mx = fmaxf(mx, fabsf(a.w_down[(size_t)(rg * 8 + k) * DM + n]));
          (void)__hip_atomic_fetch_max(sdmax + n, __builtin_bit_cast(unsigned, mx), __ATOMIC_RELAXED, __HIP_MEMORY_SCOPE_AGENT); } }
    { unsigned* simax = (unsigned*)(ws + WS_CTL) + CW_SIMAX;
      for (int e = (vcu * NWAVES + wave) * 64 + lane; e < (IN8_HI - IN8_LO) * 16; e += NGW * 64) { const int n = e % (IN8_HI - IN8_LO), rg = e / (IN8_HI - IN8_LO); float mx = 0.f;
#pragma unroll
          for (int k = 0; k < 8; ++k) mx = fmaxf(mx, fabsf(a.w_in[(size_t)(rg * 8 + k) * NIN + IN8_LO + n]));
          (void)__hip_atomic_fetch_max(simax + n, __builtin_bit_cast(unsigned, mx), __ATOMIC_RELAXED, __HIP_MEMORY_SCOPE_AGENT); } }
    float* rope = (float*)(ws + WS_ROPE);
    for (int idx = (vcu * NWAVES + wave) * 64 + lane; idx < MTOK * 24; idx += NGW * 64) {
        const int m = idx / 24, i = idx % 24;
        const float inv = i < 16 ? INV128[i] : INV64[i - 16];
        const float ang = (float)a.pos[m] * inv;
        const double rev = (double)ang * 0.15915494309189535;
        const float r = (float)((rev - floor(rev)) * 6.283185307179586);
        *(float2*)(rope + (size_t)idx * 2) = make_float2(cosf(r), sinf(r));
    }
}
__device__ __forceinline__ void hrows(const float* __restrict__ x, const float* __restrict__ g, const LAS float* S1, f16* __restrict__ H, unsigned char* __restrict__ H8, float* __restrict__ sah, int gw, int NGW, int lane) {
    for (int m0 = gw; m0 < MTOK; m0 += 2 * NGW) {
        const int m1 = m0 + NGW < MTOK ? m0 + NGW : m0;
        f32x4 v[2][8];
#pragma unroll
        for (int r = 0; r < 2; ++r) { const f32x4* xr = (const f32x4*)(x + (size_t)(r ? m1 : m0) * DM) + lane;
#pragma unroll
            for (int j = 0; j < 8; ++j) v[r][j] = __builtin_nontemporal_load(xr + 64 * j); }
#pragma unroll
        for (int r = 0; r < 2; ++r) {
            const int m = r ? m1 : m0; const int b = m / SEQ;
            float ss = 0.f;
#pragma unroll
            for (int j = 0; j < 8; ++j) ss += (v[r][j].x * v[r][j].x + v[r][j].y * v[r][j].y) + (v[r][j].z * v[r][j].z + v[r][j].w * v[r][j].w);
            const float rstd = rsqrtf(wave_sum(ss) * (1.f / DM) + EPS);
            u32x2* o8 = (u32x2*)(H + (size_t)m * DM) + lane;
            float mx = 0.f;
#pragma unroll
            for (int j = 0; j < 8; ++j) { const int k = 4 * (lane + 64 * j);
                const f32x4 gg = *(const f32x4*)(g + k); const f32x4 sh = *(const LAS f32x4*)(S1 + b * 4096 + k), sc = *(const LAS f32x4*)(S1 + b * 4096 + 2048 + k);
                const f32x4 y = ((v[r][j] * rstd) * gg) * (sc + 1.f) + sh; v[r][j] = y;
                mx = fmaxf(fmaxf(mx, fmaxf(fabsf(y.x), fabsf(y.y))), fmaxf(fabsf(y.z), fabsf(y.w)));
                u32x2 w; w.x = pk_h2(y.x, y.y); w.y = pk_h2(y.z, y.w); o8[64 * j] = w; }
#pragma unroll
            for (int o = 1; o < 64; o <<= 1) mx = fmaxf(mx, __shfl_xor(mx, o));
            mx = fmaxf(mx, 1e-20f);
            const float inv = 127.f * __builtin_amdgcn_rcpf(mx);
            unsigned* q8p = (unsigned*)(H8 + (size_t)m * DM) + lane;
#pragma unroll
            for (int j = 0; j < 8; ++j) q8p[64 * j] = q8x4(v[r][j].x * inv, v[r][j].y * inv, v[r][j].z * inv, v[r][j].w * inv);
            if (lane == 0) sah[m] = mx * (1.f / 127.f);
        }
    }
}
__device__ __forceinline__ void hrows1(const float* __restrict__ x, const float* __restrict__ g, const LAS float* S1, f16* __restrict__ H, int gw, int NGW, int lane) {
    for (int m = gw; m < MTOK; m += NGW) {
        const int b = m / SEQ;
        const f32x4* xr = (const f32x4*)(x + (size_t)m * DM) + lane;
        f32x4 v[8]; float ss = 0.f;
#pragma unroll
        for (int j = 0; j < 8; ++j) { v[j] = xr[64 * j]; ss += (v[j].x * v[j].x + v[j].y * v[j].y) + (v[j].z * v[j].z + v[j].w * v[j].w); }
        const float rstd = rsqrtf(wave_sum(ss) * (1.f / DM) + EPS);
        u32x2* o8 = (u32x2*)(H + (size_t)m * DM) + lane;
#pragma unroll
        for (int j = 0; j < 8; ++j) { const int k = 4 * (lane + 64 * j);
            const f32x4 gg = *(const f32x4*)(g + k); const f32x4 sh = *(const LAS f32x4*)(S1 + b * 4096 + k), sc = *(const LAS f32x4*)(S1 + b * 4096 + 2048 + k);
            const f32x4 y = ((v[j] * rstd) * gg) * (sc + 1.f) + sh;
            u32x2 w; w.x = pk_h2(y.x, y.y); w.y = pk_h2(y.z, y.w); o8[64 * j] = w; }
    }
}
__device__ __forceinline__ void phase1(const Args& a, LAS unsigned char* lds, int vcu, int G, int wave, int lane) {
    unsigned char* ws = a.ws;
    const float* mod = (const float*)(ws + WS_MOD);
    LAS float* S1 = (LAS float*)lds;
    for (int e = threadIdx.x; e < 2 * 4096; e += NWAVES * 64) { const int b = e >> 12, j = e & 4095; S1[e] = mod[(size_t)b * MODW + j]; }
    __syncthreads();
    if (blockIdx.x == 0 && wave == 0) {
#pragma unroll
        for (int b = 0; b < BATCH; ++b) { float mx = 0.f;
            for (int j = lane; j < DM; j += 64) mx = fmaxf(mx, fabsf(mod[(size_t)b * MODW + 3 * DM + j]));
#pragma unroll
            for (int o = 1; o < 64; o <<= 1) mx = fmaxf(mx, __shfl_xor(mx, o));
            if (lane == 0) ((float*)(ws + WS_MAXSH))[b] = mx; } }
    hrows(a.x, a.n1g, S1, (f16*)(ws + WS_H), ws + WS_H8IN, (float*)(ws + WS_SAH), vcu * NWAVES + wave, G * NWAVES, lane);
    { int l2 = threadIdx.x; asm volatile("" : "+v"(l2)); l2 &= 63;
      const int it0 = vcu * NWAVES + wave, stride = G * NWAVES;
      tr_run(a, (LAS float*)(lds + 32768 + wave * 8448), TR_IN8_BASE, it0, stride, (TR_I_IN8 - it0 + stride - 1) / stride, l2, false); }
}

__global__ void __launch_bounds__(NWAVES * 64, 2) mega(Args a) {
    extern __shared__ __attribute__((aligned(16))) unsigned char lds_raw[];
    LAS unsigned char* lds = (LAS unsigned char*)lds_raw;
    volatile LAS unsigned* MISC = (volatile LAS unsigned*)(lds + MISC_OFF);
    int tid = threadIdx.x; const int wave = __builtin_amdgcn_readfirstlane(tid >> 6); int lane = tid & 63;
#define FRESH() do { tid = threadIdx.x; asm volatile("" : "+v"(tid)); lane = tid & 63; } while (0)
    const int G = gridDim.x; const bool fuse = true;
    const int vcu = (G % 8 == 0) ? (blockIdx.x % 8) * (G / 8) + blockIdx.x / 8 : blockIdx.x;
    if (tid < 64) MISC[tid] = 0u;
    __syncthreads();
    unsigned* ctl = (unsigned*)(a.ws + WS_CTL);
    XcdBarrier bar = xcd_barrier_post(ctl + CW_BAR + a.region * XCD_BAR_WORDS, MISC + 8);
    const int lo = a.ph_lo, hi = a.ph_hi;
#define IN(k) (lo <= (k) && (k) < hi)
#define SEAM(k) do { if (IN(k) && IN((k) + 1)) xcd_barrier(bar); } while (0)
    if (IN(0)) { FRESH(); phase0(a, lds, vcu, G, wave, lane, fuse); } SEAM(0);
    if (IN(1)) { FRESH(); phase1(a, lds, vcu, G, wave, lane); } SEAM(1);
    if (IN(2)) { FRESH();
        {   pg8::Gemm g{(const f16*)(a.ws + WS_H), (const f16*)(a.ws + WS_WTIN), MTOK, NINP, DM}; pg8::InOrder S; S.init(MTOK, 13, (int)blockIdx.x, 0);
            pg8::EpiProjT<false> E{(f16*)(a.ws + WS_PROJ), (f16*)(a.ws + WS_KIX), (float*)(a.ws + WS_WIX), (const float*)(a.ws + WS_ROPE), (f16*)(a.ws + WS_KSBC), (f16*)(a.ws + WS_VSBC), (f16*)(a.ws + WS_KDSC), (f16*)(a.ws + WS_VDSC), nullptr, nullptr};
            pg8::gemm_phase<pg8::EpiProjT<false>, pg8::InOrder, true, true>(lds, g, S, E); }
        {   FRESH();
            pg8::Gemm g{(const f16*)(a.ws + WS_H8IN), (const f16*)(a.ws + WS_WTIN8 - (size_t)8 * 256 * DM), MTOK, NINP, DM / 2}; pg8::InOrder S; S.init(MTOK, 9, (int)blockIdx.x, 1);
            pg8::EpiProjT<true> E{(f16*)(a.ws + WS_PROJ), (f16*)(a.ws + WS_KIX), (float*)(a.ws + WS_WIX), (const float*)(a.ws + WS_ROPE), (f16*)(a.ws + WS_KSBC), (f16*)(a.ws + WS_VSBC), (f16*)(a.ws + WS_KDSC), (f16*)(a.ws + WS_VDSC),
                                  (const float*)(a.ws + WS_SAH), (const float*)((const unsigned*)(a.ws + WS_CTL) + CW_SIMAX)};
            pg8::gemm_phase<pg8::EpiProjT<true>, pg8::InOrder, true, true>(lds, g, S, E); }
        FRESH(); if ((int)blockIdx.x >= 96) {
            constexpr int NA = (UP_DEFER * 2) / 3;
            const bool two_f = (int)blockIdx.x < 160;
            const int base = two_f ? 0 : NA, n = two_f ? NA : UP_DEFER - NA, it0 = ((int)blockIdx.x - (two_f ? 96 : 160)) * NWAVES + wave, stride = (two_f ? 64 : 96) * NWAVES;
            tr_run(a, (LAS float*)(lds + wave * 16384), TR_I_IN + TR_I_OUT + base, it0, stride, (n - it0 + stride - 1) / stride, lane, false); }
    } SEAM(2);
    if (IN(3)) { FRESH();
        const f16* P = (const f16*)(a.ws + WS_PROJ);
        auto up_share = [&]() {
            int l2 = threadIdx.x; asm volatile("" : "+v"(l2)); l2 &= 63;
            const int it0 = vcu * NWAVES + wave, stride = G * NWAVES, nit = TR_I_UP - UP_DEFER;
            tr_run(a, (LAS float*)(lds + wave * 16384), TR_I_IN + TR_I_OUT + UP_DEFER, it0, stride, (nit - it0 + stride - 1) / stride, l2, false);
            tr_run(a, (LAS float*)(lds + wave * 16384), TR_I_IN, it0, stride, (TR_I_OUT - it0 + stride - 1) / stride, l2, fuse); };
        if (wave < 4) up_share();
        if (!(a.pad & 1)) for (int it = vcu * NWAVES + wave; it < BATCH * NH * (SEQ / 32); it += G * NWAVES) {
            const int qb = it % (SEQ / 32), hd = (it / (SEQ / 32)) % NH, b = it / ((SEQ / 32) * NH);
            att::sb_item(P, (const f16*)(a.ws + WS_KSBC), (const f16*)(a.ws + WS_VSBC), (f16*)(a.ws + WS_MERGED), (float*)(a.ws + WS_SSQ), lds + wave * 16384, b, hd, qb, lane);
        }
        if (wave >= 4) up_share();
        __syncthreads();
        if (!(a.pad & 2)) for (int k = vcu; k < BATCH * (SEQ / 8); k += G) {
            auto decode = [&](int kk, int& bb, int& tt0) { bb = kk / (SEQ / 8); const int r = kk % (SEQ / 8); tt0 = 8 * (r < SEQ / 16 ? r : (SEQ / 8 - 1) - (r - SEQ / 16)); };
            int b, t0, nb = 0, nt0 = -1; decode(k, b, t0);
            if (k + G < BATCH * (SEQ / 8)) decode(k + G, nb, nt0);
            att::dsa_round<0>(P, (const f16*)(a.ws + WS_KDSC), (const f16*)(a.ws + WS_VDSC), (const f16*)(a.ws + WS_KIX), (const float*)(a.ws + WS_WIX), a.dsg, (f16*)(a.ws + WS_MERGED), lds, b, t0, nb, nt0, wave, lane, a.pad);
        }
    } SEAM(3);
    if (IN(5)) { FRESH();
        pg8::Gemm g{(const f16*)(a.ws + WS_MERGED), (const f16*)(a.ws + WS_WTOUT), MTOK, DM, DM}; pg8::StaticOrder S; S.init(MTOK, DM, G, (int)blockIdx.x);
        const float* mod = (const float*)(a.ws + WS_MOD);
        pg8::EpiResidNorm<1> E{a.x, mod + 2 * DM, a.n2g, mod + 3 * DM, (float*)(a.ws + WS_X1), (f16*)(a.ws + WS_H), (float*)(a.ws + WS_XCH), ctl + CW_XCNT, (const float*)(a.ws + WS_SSQ), (float*)(a.ws + WS_XCH2), (float*)(a.ws + WS_SA), (const float*)(a.ws + WS_MAXSH)};
        pg8::gemm_phase<pg8::EpiResidNorm<1>, pg8::StaticOrder, false, true>(lds, g, S, E);
    } SEAM(6);
    if (IN(7)) { FRESH();
        pg8::Gemm g{(const f16*)(a.ws + WS_H), (const f16*)(a.ws + WS_WTUP), MTOK, NUP, DM / 2}; pg8::StaticOrder S; S.init(MTOK, NUP, G, (int)blockIdx.x);
        pg8::EpiUpConv E{a.conv_w, a.conv_b, (f16*)(a.ws + WS_ACT), (float*)(a.ws + WS_UH), (const float*)(a.ws + WS_SA), (const float*)((const unsigned*)(a.ws + WS_CTL) + CW_SBMAX)};
        pg8::gemm_phase<pg8::EpiUpConv, pg8::StaticOrder, true, true>(lds, g, S, E);
        FRESH(); tr_deferred(a, lds, TR_I_IN + TR_I_OUT + TR_I_UP, TR_I_DN, (MTOK / 256) * (NUP / 256), G, wave, lane);
        for (int e = blockIdx.x * (NWAVES * 64) + tid; e < DM * 8; e += G * NWAVES * 64) *(u32x4*)(a.ws + WS_WTDN + (size_t)(e >> 3) * DFFP + DFF + 16 * (e & 7)) = (u32x4){0u, 0u, 0u, 0u};
    } SEAM(7);
    if (IN(8)) { FRESH();
        const float* uh = (const float*)(a.ws + WS_UH); f16* act = (f16*)(a.ws + WS_ACT); unsigned char* act8 = (unsigned char*)(a.ws + WS_ACT8); float* sact = (float*)(a.ws + WS_SACT);
        for (int blk = vcu; blk < MTOK / 32; blk += G) {
            const int mb = blk * 32;
            if ((mb & 63) == 0) {
                const int chunk = mb >> 6; const bool first = (chunk % (SEQ / 64)) == 0;
                for (int e = tid; e < DFF / 4; e += NWAVES * 64) { const int ch = 4 * e;
                    f32x4 r0, r1;
#pragma unroll
                    for (int gv = 0; gv < 2; ++gv) { const int c = gv * DFF + ch; const f32x4 z4 = {0.f, 0.f, 0.f, 0.f};
                        const f32x4 um2 = first ? z4 : *(const f32x4*)(uh + (size_t)((chunk - 1) * 4 + 2) * NUP + c), um1 = first ? z4 : *(const f32x4*)(uh + (size_t)((chunk - 1) * 4 + 3) * NUP + c);
                        const f32x4 u0 = *(const f32x4*)(uh + (size_t)(chunk * 4 + 0) * NUP + c), u1 = *(const f32x4*)(uh + (size_t)(chunk * 4 + 1) * NUP + c);
                        const f32x4 k0 = *(const f32x4*)(a.conv_w + c), k1 = *(const f32x4*)(a.conv_w + NUP + c), k2 = *(const f32x4*)(a.conv_w + 2 * NUP + c), bz = *(const f32x4*)(a.conv_b + c);
                        const f32x4 y0 = bz + k0 * um2 + k1 * um1 + k2 * u0, y1 = bz + k0 * um1 + k1 * u0 + k2 * u1;
                        if (gv == 0) {
#pragma unroll
                            for (int j = 0; j < 4; ++j) { r0[j] = pg8::silu_fast(y0[j]); r1[j] = pg8::silu_fast(y1[j]); }
                        } else { r0 *= y0; r1 *= y1; } }
                    u32x2 w0, w1; w0.x = pk_h2(r0.x, r0.y); w0.y = pk_h2(r0.z, r0.w); w1.x = pk_h2(r1.x, r1.y); w1.y = pk_h2(r1.z, r1.w);
                    *(u32x2*)(act + (size_t)mb * DFF + ch) = w0; *(u32x2*)(act + (size_t)(mb + 1) * DFF + ch) = w1; }
                asm volatile("s_waitcnt vmcnt(0)" ::: "memory");
            }
            __syncthreads();
#pragma unroll 1
            for (int pr = 0; pr < 2; ++pr) {
                const int m0 = mb + wave * 4 + 2 * pr;
                half8 v[2][11]; float mx[2] = {0.f, 0.f};
#pragma unroll
                for (int r = 0; r < 2; ++r)
#pragma unroll
                    for (int j = 0; j < 11; ++j) { const int cidx = lane + 64 * j;
                        v[r][j] = cidx < DFF / 8 ? *(const half8*)(act + (size_t)(m0 + r) * DFF + 8 * cidx) : (half8){0, 0, 0, 0, 0, 0, 0, 0}; }
#pragma unroll
                for (int r = 0; r < 2; ++r) {
#pragma unroll
                    for (int j = 0; j < 11; ++j)
#pragma unroll
                        for (int e = 0; e < 8; ++e) mx[r] = fmaxf(mx[r], fabsf((float)v[r][j][e]));
#pragma unroll
                    for (int o = 1; o < 64; o <<= 1) mx[r] = fmaxf(mx[r], __shfl_xor(mx[r], o));
                    mx[r] = fmaxf(mx[r], 1e-20f); const float qs = 127.f / mx[r];
                    unsigned char* orow = act8 + (size_t)(m0 + r) * DFFP;
#pragma unroll
                    for (int j = 0; j < 11; ++j) { const int cidx = lane + 64 * j;
                        if (cidx < DFF / 8) { u32x2 w; w.x = q8x4((float)v[r][j][0] * qs, (float)v[r][j][1] * qs, (float)v[r][j][2] * qs, (float)v[r][j][3] * qs);
                            w.y = q8x4((float)v[r][j][4] * qs, (float)v[r][j][5] * qs, (float)v[r][j][6] * qs, (float)v[r][j][7] * qs); *(u32x2*)(orow + 8 * cidx) = w; } }
                    if (lane < 8) *(u32x4*)(orow + DFF + 16 * lane) = (u32x4){0u, 0u, 0u, 0u};
                    if (lane == 0) sact[m0 + r] = mx[r] * (1.f / 127.f);
                }
            }
            __syncthreads();
        }
    } SEAM(8);
    if (IN(9)) { FRESH();
        pg8::Gemm g{(const f16*)(a.ws + WS_ACT8), (const f16*)(a.ws + WS_WTDN), MTOK, DM, DFFP / 2}; pg8::StaticOrder S; S.init(MTOK, DM, G, (int)blockIdx.x);
        const float* mod = (const float*)(a.ws + WS_MOD);
        pg8::EpiResidNorm<0> E{(const float*)(a.ws + WS_X1), mod + 5 * DM, a.fng, nullptr, a.out, nullptr, (float*)(a.ws + WS_XCH) + 32 * 8 * 256, ctl + CW_XCNT + 32 * 64, nullptr, nullptr, (float*)(a.ws + WS_SACT), (const float*)((const unsigned*)(a.ws + WS_CTL) + CW_SDMAX)};
        pg8::gemm_phase<pg8::EpiResidNorm<0>, pg8::StaticOrder, false, true>(lds, g, S, E);
    }
#undef IN
#undef SEAM
}

extern "C" void kernel_launch(void* const* d_in, const int* in_sizes, int n_in, void* d_out, int out_size, void* d_ws, size_t ws_size, hipStream_t stream) {
    if (n_in != 16 || ws_size < WS_END) { fprintf(stderr, "kernel_launch: unexpected n_in %d / ws %zu\n", n_in, ws_size); return; }
    const float* x = (const float*)d_in[0]; const float* c = (const float*)d_in[1]; const int* pos = (const int*)d_in[2];
    const float* w_ada = (const float*)d_in[3]; const float* b_ada = (const float*)d_in[4]; const float* n1g = (const float*)d_in[5];
    const float* w_in = (const float*)d_in[6]; const float* sbg = (const float*)d_in[7]; const float* dsg = (const float*)d_in[8];
    const float* w_out = (const float*)d_in[9]; const float* n2g = (const float*)d_in[10]; const float* w_up = (const float*)d_in[11];
    const float* conv_w = (const float*)d_in[12]; const float* conv_b = (const float*)d_in[13]; const float* w_down = (const float*)d_in[14];
    const float* fng = (const float*)d_in[15];
    unsigned char* ws = (unsigned char*)d_ws; float* out = (float*)d_out;
    static int grid = 0;
    if (grid == 0) {
        int dev = 0, cus = 0;
        if (hipGetDevice(&dev) != hipSuccess || hipDeviceGetAttribute(&cus, hipDeviceAttributeMultiprocessorCount, dev) != hipSuccess) { fprintf(stderr, "kernel_launch: device query failed\n"); grid = -1; return; }
        if (hipFuncSetAttribute((const void*)mega, hipFuncAttributeMaxDynamicSharedMemorySize, LDS_BYTES) != hipSuccess) { fprintf(stderr, "kernel_launch: hipFuncSetAttribute failed\n"); grid = -1; return; }
        int per_cu = 0; (void)hipOccupancyMaxActiveBlocksPerMultiprocessor(&per_cu, (const void*)mega, NWAVES * 64, LDS_BYTES); (void)hipGetLastError();
        if (per_cu < 1) fprintf(stderr, "kernel_launch: occupancy query reports %d blocks/CU\n", per_cu);
        grid = cus;
        if (cus != (MTOK / 256) * (DM / 256)) { fprintf(stderr, "kernel_launch: built for a %d-CU device (one out-projection / down-projection unit per workgroup); found %d CUs; nothing launched\n", (MTOK / 256) * (DM / 256), cus); grid = -1; }
    }
    if (grid < 0) return;
    (void)hipMemsetAsync(ws + WS_CTL, 0, 1 * MiB, stream);
    Args a{};
    a.x = x; a.c = c; a.pos = pos; a.w_ada = w_ada; a.b_ada = b_ada; a.n1g = n1g; a.w_in = w_in; a.sbg = sbg; a.dsg = dsg; a.w_out = w_out; a.n2g = n2g; a.w_up = w_up;
    a.conv_w = conv_w; a.conv_b = conv_b; a.w_down = w_down; a.fng = fng; a.out = out; a.ws = ws;
    auto run = [&](int lo, int hi, int region) { a.ph_lo = lo; a.ph_hi = hi; a.region = region; hipLaunchKernelGGL(mega, dim3(grid), dim3(NWAVES * 64), LDS_BYTES, stream, a); };
    run(0, 11, 0);
#ifdef PROBE_LO
    a.pad = PROBE_FLAGS; run(PROBE_LO, PROBE_HI, 1);
#endif
}
```

```cpp
#include <hip/hip_runtime.h>
#include <cstdio>

typedef _Float16 f16;

constexpr int BATCH = 2, SEQ = 4096, DM = 2048, MTOK = BATCH * SEQ;
constexpr int HD = 128, NH = 8, IXH = 16, IXD = 64, TOPK = 256;
constexpr int DFF = 5504, NUP = 2 * DFF;
constexpr int NIN = 5456, NINP = 5632;
constexpr int C_QSB = 0, C_KSB = 1024, C_VSB = 2048, C_QDS = 3072, C_KDS = 4096, C_VDS = 4224, C_QIX = 4352, C_KIX = 5376, C_WIX = 5440;
constexpr int MODW = 6 * DM;
constexpr float EPS = 1e-6f;
constexpr float QSCALE = 0.08838834764831845f;
constexpr float IDX_SCALE = 0.03125f;

__constant__ float INV128[16] = {1.0f, 0.44036659598350525f, 0.1939227432012558f, 0.08539710193872452f, 0.03760603070259094f, 0.01656043902039528f, 0.007292664609849453f, 0.0032114458736032248f,
                                 0.0014142135623842478f, 0.000622772378847003f, 0.00027424818836152554f, 0.00012076973507646471f, 5.318296098266728e-05f, 2.34199997066753e-05f, 1.0313386155758053e-05f, 4.541670477919979e-06f};
__constant__ float INV64[8] = {1.0f, 0.1939227432012558f, 0.03760603070259094f, 0.007292664609849453f, 0.0014142135623842478f, 0.00027424818836152554f, 5.318296098266728e-05f, 1.0313386155758053e-05f};

constexpr size_t MiB = 1u << 20;
constexpr size_t WS_CTL = 0;
constexpr size_t WS_MOD = 1 * MiB;
constexpr size_t WS_MODP = 380 * MiB;
constexpr size_t WS_ROPE = 4 * MiB;
constexpr size_t WS_XCH = 3 * MiB + 512 * 1024;
constexpr size_t WS_SA = 6 * MiB + 768 * 1024;
constexpr size_t WS_SAH = WS_SA + 160 * 1024;
constexpr size_t WS_H8IN = 135 * MiB;
constexpr size_t WS_WTIN8 = 16 * MiB;
constexpr int IN8_LO = 0, IN8_HI = 4352, IN8_NB = (IN8_HI - IN8_LO) / 32;
constexpr size_t WS_SACT = WS_SA + 64 * 1024;
constexpr size_t WS_MAXSH = WS_SA + 128 * 1024;
constexpr size_t WS_XCH2 = 383 * MiB;
constexpr size_t WS_SSQ = 6 * MiB + 512 * 1024;
constexpr size_t WS_WIX = 6 * MiB;
constexpr size_t WS_KIX = 7 * MiB;
constexpr size_t WS_WTIN = 8 * MiB;
constexpr size_t WS_WTOUT = 30 * MiB;
constexpr size_t WS_WTUP = 38 * MiB;
constexpr size_t WS_WTDN = 81 * MiB;
constexpr size_t WS_H = 103 * MiB;
constexpr size_t WS_X1 = 135 * MiB;
constexpr size_t WS_PROJ = 199 * MiB;
constexpr size_t WS_ACT = WS_PROJ;
constexpr size_t WS_MERGED = 287 * MiB;
constexpr size_t WS_FREE = 319 * MiB;
constexpr size_t WS_OSB32 = 319 * MiB;
constexpr size_t WS_ODS32 = 351 * MiB;
constexpr size_t WS_U16 = 287 * MiB;
constexpr size_t WS_UH = 8 * MiB;
constexpr size_t WS_ACT8 = 287 * MiB;
constexpr int DFFP = 5632;
constexpr size_t WS_KSBC = 342 * MiB;
constexpr size_t WS_VSBC = 358 * MiB;
constexpr size_t WS_KDSC = 374 * MiB;
constexpr size_t WS_VDSC = 376 * MiB;
constexpr size_t WS_KDS8 = 378 * MiB;
constexpr size_t WS_KSC = 379 * MiB;
constexpr size_t WS_CWS = 379 * MiB + 64 * 1024;
constexpr size_t WS_END = 384 * MiB;

__device__ __forceinline__ float wave_sum(float v) {
#pragma unroll
    for (int o = 1; o < 64; o <<= 1) v += __shfl_xor(v, o);
    return v;
}
__device__ __forceinline__ float block_sum256(float v, float* red) {
    v = wave_sum(v);
    __syncthreads();
    if ((threadIdx.x & 63) == 0) red[threadIdx.x >> 6] = v;
    __syncthreads();
    return red[0] + red[1] + red[2] + red[3];
}
__device__ __forceinline__ float silu_f(float v) { return v / (1.f + expf(-v)); }
__device__ __forceinline__ float softplus_f(float z) { return fmaxf(z, 0.f) + log1pf(expf(-fabsf(z))); }

#define LAS __attribute__((address_space(3)))
typedef _Float16 half8 __attribute__((ext_vector_type(8)));
typedef _Float16 half4 __attribute__((ext_vector_type(4)));
typedef _Float16 half2v __attribute__((ext_vector_type(2)));
typedef float f32x4 __attribute__((ext_vector_type(4)));
typedef float f32x16 __attribute__((ext_vector_type(16)));
typedef unsigned u32x4 __attribute__((ext_vector_type(4)));
typedef unsigned u32x2 __attribute__((ext_vector_type(2)));
typedef int i32x4 __attribute__((ext_vector_type(4)));
__device__ __forceinline__ unsigned q8x4(float a, float b, float c, float d) {
    unsigned r = __builtin_amdgcn_cvt_pk_u8_f32(a + 128.f, 0u, 0u);
    r = __builtin_amdgcn_cvt_pk_u8_f32(b + 128.f, 1u, r); r = __builtin_amdgcn_cvt_pk_u8_f32(c + 128.f, 2u, r); r = __builtin_amdgcn_cvt_pk_u8_f32(d + 128.f, 3u, r);
    return r ^ 0x80808080u;
}
__device__ __forceinline__ unsigned pk_h2(float lo, float hi) { half2v h = {(f16)lo, (f16)hi}; return __builtin_bit_cast(unsigned, h); }

constexpr int NWAVES = 8;
constexpr int LDS_BYTES = 159744;
constexpr int RING_BYTES = 131072;
constexpr int XTRA_OFF = RING_BYTES;
constexpr int MISC_OFF = LDS_BYTES - 256;
constexpr int CW_TMO = 0, CW_BAR = 4096, CW_XCNT = 32768, CW_ADA = 40960, CW_SBMAX = 49152, CW_SDMAX = 61440, CW_SIMAX = 65536;

namespace pg8 {
constexpr int BM = 256, BK = 64, HALF = 128, HTB = HALF * BK * 2, STAGE_BYTES = 8 * HTB, NXCD = 8, WGM = 8;
__host__ __device__ __forceinline__ int lds_byte(int r, int c) { const int st = (r >> 4) * 2 + (c >> 5), rr = r & 15, cc = c & 31, ob = rr * 64 + cc * 2; return st * 1024 + (ob ^ (((ob >> 9) & 1) << 5)); }
__host__ __device__ __forceinline__ void stage_rc(int b, int& R, int& C) { const int st = b / 1024, sb = b % 1024, swz = sb ^ (((sb >> 9) & 1) << 5); R = (st >> 1) * 16 + swz / 64; C = (st & 1) * 32 + (swz % 64) / 2; }
__host__ __device__ __forceinline__ int perm32(int rho) { const int n = rho >> 4, i = rho & 15; return 8 * (i >> 2) + 4 * n + (i & 3); }
struct Unit { int pm, pn; };
struct Gemm { const f16* A; const f16* Bt; int M, N, K; };
struct StaticOrder {
    int nM, nN, nwg, G, c;
    __host__ __device__ __forceinline__ void init(int M, int N, int G_, int c_) { nM = M / BM; nN = N / BM; nwg = nM * nN; G = G_; c = c_; }
    __host__ __device__ __forceinline__ bool next(int i, Unit& u) const {
        const long L = (long)i * G + c; if (L >= nwg) return false;
        int wgid = (int)L; { const int q = nwg / NXCD, r = nwg % NXCD, xcd = wgid % NXCD, off = wgid / NXCD; wgid = (xcd < r ? xcd * (q + 1) : r * (q + 1) + (xcd - r) * q) + off; }
        const int nig = WGM * nN, gid = wgid / nig, fm = gid * WGM, gsz = (nM - fm) < WGM ? (nM - fm) : WGM;
        u.pm = fm + ((wgid % nig) % gsz); u.pn = (wgid % nig) / gsz; return true;
    }
    __device__ __forceinline__ void a_ready(const Unit&) const {}
    __device__ __forceinline__ void done(const Unit&) const {}
};
struct InOrder {
    int nM, nN, nwg, c, first, mode;
    __host__ __device__ __forceinline__ void init(int M, int ncol, int c_, int mode_) { nM = M / BM; nN = ncol; nwg = nM * nN; c = c_; mode = mode_; }
    __host__ __device__ __forceinline__ bool next(int i, Unit& u) const {
        int L;
        if (mode == 0) { if (i >= 1 || c >= nwg) return false; L = c; }
        else { if (c < 96) { if (i >= 2) return false; L = c + 160 * i; } else if (c < 160) { if (i >= 1) return false; L = c; } else { if (i >= 3) return false; L = 256 + (c - 160) + 96 * i; } }
        int wgid = L; { const int q = nwg / NXCD, r = nwg % NXCD, xcd = wgid % NXCD, off = wgid / NXCD; wgid = (xcd < r ? xcd * (q + 1) : r * (q + 1) + (xcd - r) * q) + off; }
        const int nig = WGM * nN, gid = wgid / nig, fm = gid * WGM, gsz = (nM - fm) < WGM ? (nM - fm) : WGM;
        u.pm = fm + ((wgid % nig) % gsz); const int pn = (wgid % nig) / gsz;
        u.pn = mode == 0 ? 17 + pn : (pn + 6) % 17; return true;
    }
    __device__ __forceinline__ void a_ready(const Unit&) const {}
    __device__ __forceinline__ void done(const Unit&) const {}
};
__device__ __forceinline__ void mma16(f32x4& c, const half8& b, const half8& a) { c = __builtin_amdgcn_mfma_f32_16x16x32_f16(b, a, c, 0, 0, 0); }
__device__ __forceinline__ void mma16(i32x4& c, const half8& b, const half8& a) { c = __builtin_amdgcn_mfma_i32_16x16x64_i8(__builtin_bit_cast(i32x4, b), __builtin_bit_cast(i32x4, a), c, 0, 0, 0); }
template <class Epi, class Sched, bool ALIGN_EPI, bool SP2>
__device__ __forceinline__ void gemm_phase(LAS unsigned char* lds, const Gemm g, const Sched& S, const Epi& E) {
    int tid = threadIdx.x; asm volatile("" : "+v"(tid));
    const int wid = __builtin_amdgcn_readfirstlane(tid >> 6), lane = tid & 63, wr = wid >> 2, wc = wid & 3, fr = lane & 15, fq = lane >> 4;
    const int K = g.K, nt = K / BK;
    unsigned voffA[2], voffB[2];
#pragma unroll
    for (int i = 0; i < 2; ++i) { int R, C; stage_rc(tid * 16 + i * 8192, R, C); const int Rb = Epi::PERM ? ((R & ~31) + perm32(R & 31)) : R;
        voffA[i] = (unsigned)(R * K + C) * 2u; voffB[i] = (unsigned)(Rb * K + C) * 2u; }
    const size_t kstep = (size_t)(BK * 2);
    const size_t hstep = (size_t)HALF * K * 2;
    const size_t tstep = 2 * hstep;
    const unsigned ldsw = (unsigned)wid * 1024u;
    const int aoff = lds_byte(wr * 64 + fr, fq * 8), boff = lds_byte(wc * 32 + fr, fq * 8);
#define PG8_SA(b, h) (((b) * 2 + (h)) * HTB)
#define PG8_SB(b, h) ((4 + (b) * 2 + (h)) * HTB)
#define PG8_STAGE(bufoff, gbase, voff) do { _Pragma("unroll") for (int _i = 0; _i < 2; ++_i) \
        __builtin_amdgcn_global_load_lds((const unsigned*)((const char*)(gbase) + (voff)[_i]), (LAS unsigned*)(lds + (bufoff) + ldsw + _i * 8192), 16, 0, 0); } while (0)
#define PG8_LDA(dst, b, h) do { _Pragma("unroll") for (int m = 0; m < 4; ++m) _Pragma("unroll") for (int k = 0; k < 2; ++k) dst[m][k] = *(const LAS half8*)(lds + PG8_SA(b, h) + aoff + m * 2048 + k * 1024); } while (0)
#define PG8_LDB(dst, b, h) do { _Pragma("unroll") for (int n = 0; n < 2; ++n) _Pragma("unroll") for (int k = 0; k < 2; ++k) dst[n][k] = *(const LAS half8*)(lds + PG8_SB(b, h) + boff + n * 2048 + k * 1024); } while (0)
#define PG8_MMA(ai, bj, At, Bt) do { __builtin_amdgcn_s_setprio(1); _Pragma("unroll") for (int m = 0; m < 4; ++m) _Pragma("unroll") for (int n = 0; n < 2; ++n) _Pragma("unroll") for (int k = 0; k < 2; ++k) \
        mma16(acc[ai][bj][m][n], Bt[n][k], At[m][k]); __builtin_amdgcn_s_setprio(0); } while (0)
#define PG8_WAIT_V(n) asm volatile("s_waitcnt vmcnt(" #n ")" ::: "memory")
#define PG8_WAIT_L(n) asm volatile("s_waitcnt lgkmcnt(" #n ")" ::: "memory")
#define PG8_BAR __builtin_amdgcn_s_barrier()
#define PG8_SCHED __builtin_amdgcn_sched_barrier(0)
    Unit cur, nxt; int ui = 0;
    if (!S.next(0, cur)) return;
    typedef typename Epi::acc_t acc_t;
    acc_t acc[2][2][4][2];
#pragma unroll
    for (int a = 0; a < 2; ++a)
#pragma unroll
        for (int b = 0; b < 2; ++b)
#pragma unroll
            for (int m = 0; m < 4; ++m)
#pragma unroll
                for (int n = 0; n < 2; ++n) acc[a][b][m][n] = (acc_t){0, 0, 0, 0};
    half8 At[4][2], B0[2][2], B1[2][2];
    const char* cA = (const char*)g.A + (size_t)cur.pm * tstep; const char* cB = (const char*)g.Bt + (size_t)cur.pn * tstep;
    S.a_ready(cur);
    if constexpr (SP2) {
        PG8_STAGE(PG8_SB(0, 0), cB, voffB); PG8_STAGE(PG8_SB(0, 1), cB + hstep, voffB); PG8_STAGE(PG8_SA(0, 0), cA, voffA); PG8_STAGE(PG8_SA(0, 1), cA + hstep, voffA);
        if (wr == 1) PG8_BAR;
        PG8_WAIT_V(2); PG8_BAR;
        PG8_STAGE(PG8_SB(1, 0), cB + kstep, voffB); PG8_STAGE(PG8_SA(1, 0), cA + kstep, voffA); PG8_STAGE(PG8_SB(1, 1), cB + hstep + kstep, voffB);
        PG8_WAIT_V(6); PG8_BAR;
    } else {
        PG8_STAGE(PG8_SB(0, 0), cB, voffB); PG8_STAGE(PG8_SA(0, 0), cA, voffA); PG8_STAGE(PG8_SB(0, 1), cB + hstep, voffB); PG8_STAGE(PG8_SA(0, 1), cA + hstep, voffA);
        if (wr == 1) PG8_BAR;
        PG8_WAIT_V(4); PG8_BAR;
        PG8_STAGE(PG8_SB(1, 0), cB + kstep, voffB); PG8_STAGE(PG8_SA(1, 0), cA + kstep, voffA); PG8_STAGE(PG8_SB(1, 1), cB + hstep + kstep, voffB);
        PG8_WAIT_V(6); PG8_BAR;
    }
    for (;;) {
        const bool has_next = S.next(ui + 1, nxt);
        const char* nA = has_next ? (const char*)g.A + (size_t)nxt.pm * tstep : cA; const char* nB = has_next ? (const char*)g.Bt + (size_t)nxt.pn * tstep : cB;
        for (int t = 0; t < nt; t += 2) {
            const bool last = (t == nt - 2);
            const char* a1 = cA + (size_t)(t + 1) * kstep;
            const char* a2 = last ? nA : cA + (size_t)(t + 2) * kstep; const char* b2 = last ? nB : cB + (size_t)(t + 2) * kstep;
            const char* a3 = a2 + kstep; const char* b3 = b2 + kstep;
            if (last && has_next) S.a_ready(nxt);
            if constexpr (Epi::MIDK) { if (t == nt / 2) E.midk(acc, cur, wr, fr); }
            if constexpr (SP2) {
            PG8_LDB(B0, 0, 0); PG8_LDB(B1, 0, 1); PG8_SCHED; PG8_LDA(At, 0, 0); PG8_STAGE(PG8_SA(1, 1), a1 + hstep, voffA);
            PG8_WAIT_V(8); PG8_WAIT_L(0); PG8_BAR; PG8_MMA(0, 0, At, B0); PG8_MMA(0, 1, At, B1); PG8_BAR; PG8_SCHED;
            PG8_LDA(At, 0, 1); PG8_STAGE(PG8_SB(0, 0), b2, voffB); PG8_STAGE(PG8_SB(0, 1), b2 + hstep, voffB); PG8_STAGE(PG8_SA(0, 0), a2, voffA);
            PG8_WAIT_V(8); PG8_WAIT_L(0); PG8_BAR; PG8_MMA(1, 0, At, B0); PG8_MMA(1, 1, At, B1); PG8_BAR; PG8_SCHED;
            PG8_LDB(B0, 1, 0); PG8_LDB(B1, 1, 1); PG8_SCHED; PG8_LDA(At, 1, 0); PG8_STAGE(PG8_SA(0, 1), a2 + hstep, voffA);
            PG8_WAIT_V(8); PG8_WAIT_L(0); PG8_BAR; PG8_MMA(0, 0, At, B0); PG8_MMA(0, 1, At, B1); PG8_BAR; PG8_SCHED;
            PG8_LDA(At, 1, 1); PG8_STAGE(PG8_SB(1, 0), b3, voffB); PG8_STAGE(PG8_SB(1, 1), b3 + hstep, voffB); PG8_STAGE(PG8_SA(1, 0), a3, voffA);
            PG8_WAIT_V(8); PG8_WAIT_L(0); PG8_BAR; PG8_MMA(1, 0, At, B0); PG8_MMA(1, 1, At, B1); PG8_BAR; PG8_SCHED;
            } else {
            PG8_LDB(B0, 0, 0); PG8_SCHED; PG8_LDA(At, 0, 0); PG8_STAGE(PG8_SA(1, 1), a1 + hstep, voffA);
            PG8_WAIT_L(8); PG8_BAR; PG8_WAIT_L(0); PG8_MMA(0, 0, At, B0); PG8_BAR; PG8_SCHED;
            PG8_LDB(B1, 0, 1); PG8_STAGE(PG8_SB(0, 0), b2, voffB);
            PG8_BAR; PG8_WAIT_L(0); PG8_MMA(0, 1, At, B1); PG8_BAR;
            PG8_LDA(At, 0, 1); PG8_STAGE(PG8_SA(0, 0), a2, voffA);
            PG8_BAR; PG8_WAIT_L(0); PG8_MMA(1, 0, At, B0); PG8_BAR; PG8_SCHED;
            PG8_STAGE(PG8_SB(0, 1), b2 + hstep, voffB);
            PG8_WAIT_V(6); PG8_BAR; PG8_MMA(1, 1, At, B1); PG8_BAR;
            PG8_LDB(B0, 1, 0); PG8_SCHED; PG8_LDA(At, 1, 0); PG8_STAGE(PG8_SA(0, 1), a2 + hstep, voffA);
            PG8_WAIT_L(8); PG8_BAR; PG8_WAIT_L(0); PG8_MMA(0, 0, At, B0); PG8_BAR; PG8_SCHED;
            PG8_LDB(B1, 1, 1); PG8_STAGE(PG8_SB(1, 0), b3, voffB);
            PG8_BAR; PG8_WAIT_L(0); PG8_MMA(0, 1, At, B1); PG8_BAR;
            PG8_LDA(At, 1, 1); PG8_STAGE(PG8_SA(1, 0), a3, voffA);
            PG8_BAR; PG8_WAIT_L(0); PG8_MMA(1, 0, At, B0); PG8_BAR; PG8_SCHED;
            PG8_STAGE(PG8_SB(1, 1), b3 + hstep, voffB);
            PG8_WAIT_V(6); PG8_BAR; PG8_MMA(1, 1, At, B1); PG8_BAR;
            }
        }
        if constexpr (ALIGN_EPI) { if (wr == 0) PG8_BAR; }
        if constexpr (!Epi::AFTER_DRAIN) { E(acc, cur, wr, wc, fr, fq); S.done(cur); }
        if (!has_next) break;
#pragma unroll
        for (int a = 0; a < 2; ++a)
#pragma unroll
            for (int b = 0; b < 2; ++b)
#pragma unroll
                for (int m = 0; m < 4; ++m)
#pragma unroll
                    for (int n = 0; n < 2; ++n) acc[a][b][m][n] = (acc_t){0, 0, 0, 0};
        cur = nxt; cA = nA; cB = nB; ++ui;
        if constexpr (ALIGN_EPI) { if (wr == 1) PG8_BAR; }
    }
    PG8_WAIT_V(0);
    if constexpr (!ALIGN_EPI) { if (wr == 0) PG8_BAR; }
    PG8_BAR;
    if constexpr (Epi::AFTER_DRAIN) { E.fused(acc, cur, wr, wc, fr, fq, lds); S.done(cur); }
#undef PG8_SA
#undef PG8_SB
#undef PG8_STAGE
#undef PG8_LDA
#undef PG8_LDB
#undef PG8_MMA
#undef PG8_WAIT_V
#undef PG8_WAIT_L
#undef PG8_BAR
#undef PG8_SCHED
}

template <bool I8> struct AccSelB { typedef f32x4 t; };
template <> struct AccSelB<true> { typedef i32x4 t; };
template <bool I8>
struct EpiProjT {
    static constexpr bool PERM = true, AFTER_DRAIN = false, MIDK = false; typedef typename AccSelB<I8>::t acc_t;
    f16* P; f16* kix; float* wix; const float* rope; f16* ksbc; f16* vsbc; f16* kdsc; f16* vdsc; const float* sah; const float* simax; unsigned char* kds8; float* ksc; LAS float* xk;
    __device__ __forceinline__ void operator()(const acc_t (&acc)[2][2][4][2], const Unit& u, int wr, int wc, int fr, int fq) const {
        const int row0 = u.pm * BM + wr * 64 + fr;
#pragma unroll
        for (int bj = 0; bj < 2; ++bj) {
            const int cbase = u.pn * BM + bj * HALF;
            if (cbase >= 5504) continue;
            f32x4 cs[2] = {{1.f, 1.f, 1.f, 1.f}, {1.f, 1.f, 1.f, 1.f}};
            if constexpr (I8) {
#pragma unroll
                for (int n = 0; n < 2; ++n) cs[n] = *(const f32x4*)(simax + (cbase - IN8_LO) + wc * 32 + 8 * fq + 4 * n) * (2.f / 127.f); }
            const bool r128 = (cbase >= C_QDS && cbase < C_VDS) && (wc == 0);
            const bool r64 = (cbase >= C_QIX) && ((wc & 1) == 0) && (cbase != C_KIX || wc == 0);
            const float sc = (cbase < 1024 || (cbase >= C_QDS && cbase < C_KDS)) ? QSCALE * 1.4426950408889634f : 1.f;
            if constexpr (I8) { if (cbase == C_KDS) {
#pragma unroll
                for (int ai = 0; ai < 2; ++ai) {
                    float vv[4][8];
#pragma unroll
                    for (int m = 0; m < 4; ++m) { const int row = row0 + ai * HALF + m * 16; const float rs = sah[row];
#pragma unroll
                        for (int n = 0; n < 2; ++n)
#pragma unroll
                            for (int j = 0; j < 4; ++j) vv[m][n * 4 + j] = (float)acc[ai][bj][m][n][j] * (rs * cs[n][j]);
                        if (r128) { const float* rp = rope + (size_t)row * 48 + 2 * (8 * (fq & 1));
#pragma unroll
                            for (int e = 0; e < 8; ++e) { const float o = __shfl_xor(vv[m][e], 32); const float cs2 = rp[2 * e], sn = rp[2 * e + 1];
                                vv[m][e] = fq < 2 ? vv[m][e] * cs2 - o * sn : vv[m][e] * cs2 + o * sn; } }
                        float pm = 0.f;
#pragma unroll
                        for (int e = 0; e < 8; ++e) pm = fmaxf(pm, fabsf(vv[m][e]));
                        pm = fmaxf(pm, __shfl_xor(pm, 16)); pm = fmaxf(pm, __shfl_xor(pm, 32));
                        xk[(wr * 4 + wc) * 128 + ai * 64 + m * 16 + fr] = pm; }
                    asm volatile("s_waitcnt lgkmcnt(0)\n\ts_barrier" ::: "memory");
#pragma unroll
                    for (int m = 0; m < 4; ++m) { const int row = row0 + ai * HALF + m * 16, rl = ai * 64 + m * 16 + fr;
                        const float rm = fmaxf(fmaxf(fmaxf(xk[(wr * 4 + 0) * 128 + rl], xk[(wr * 4 + 1) * 128 + rl]), fmaxf(xk[(wr * 4 + 2) * 128 + rl], xk[(wr * 4 + 3) * 128 + rl])), 1e-20f);
                        const float qs = 127.f / rm;
                        u32x2 q; q.x = q8x4(vv[m][0] * qs, vv[m][1] * qs, vv[m][2] * qs, vv[m][3] * qs); q.y = q8x4(vv[m][4] * qs, vv[m][5] * qs, vv[m][6] * qs, vv[m][7] * qs);
                        *(u32x2*)(kds8 + (size_t)row * HD + wc * 32 + 8 * fq) = q;
                        if (wc == 0 && fq == 0) ksc[row] = rm * (1.f / 127.f); }
                }
                continue; } }
#pragma unroll
            for (int ai = 0; ai < 2; ++ai)
#pragma unroll
                for (int m = 0; m < 4; ++m) {
                    const int row = row0 + ai * HALF + m * 16;
                    float v[8];
                    if constexpr (I8) { const float rs = sah[row];
#pragma unroll
                        for (int n = 0; n < 2; ++n)
#pragma unroll
                            for (int j = 0; j < 4; ++j) v[n * 4 + j] = (float)acc[ai][bj][m][n][j] * (rs * cs[n][j]);
                    } else {
#pragma unroll
                    for (int n = 0; n < 2; ++n)
#pragma unroll
                        for (int j = 0; j < 4; ++j) v[n * 4 + j] = acc[ai][bj][m][n][j]; }
                    if (r128) {
                        const float* rp = rope + (size_t)row * 48 + 2 * (8 * (fq & 1));
#pragma unroll
                        for (int e = 0; e < 8; ++e) { const float o = __shfl_xor(v[e], 32); const float cs = rp[2 * e], sn = rp[2 * e + 1];
                            v[e] = fq < 2 ? v[e] * cs - o * sn : v[e] * cs + o * sn; }
                    }
                    if (r64) {
                        const float* rp = rope + (size_t)row * 48 + 32;
#pragma unroll
                        for (int e = 0; e < 8; ++e) { const float o = __shfl_xor(v[e], 16); const float cs = rp[2 * e], sn = rp[2 * e + 1];
                            const float r = fq == 0 ? v[e] * cs - o * sn : v[e] * cs + o * sn; v[e] = fq < 2 ? r : v[e]; }
                    }
                    u32x4 w; w.x = pk_h2(v[0] * sc, v[1] * sc); w.y = pk_h2(v[2] * sc, v[3] * sc); w.z = pk_h2(v[4] * sc, v[5] * sc); w.w = pk_h2(v[6] * sc, v[7] * sc);
                    {
                        f16* dst = P + (size_t)row * NINP + cbase;
                        const int bb = row / SEQ, ss = row % SEQ;
                        if (cbase >= C_KSB && cbase < C_VSB) dst = ksbc + ((size_t)(bb * NH + (cbase - C_KSB) / HD) * SEQ + ss) * HD;
                        else if (cbase >= C_VSB && cbase < C_QDS) dst = vsbc + ((size_t)(bb * NH + (cbase - C_VSB) / HD) * SEQ + ss) * HD;
                        else if (cbase == C_KDS) dst = kdsc + (size_t)row * HD;
                        else if (cbase == C_VDS) dst = vdsc + (size_t)row * HD;
                        *(u32x4*)(dst + wc * 32 + 8 * fq) = w; }
                    if (cbase == C_KIX) {
                        if (wc < 2) *(u32x4*)(kix + (size_t)(row >> 5) * 2048 + (((2 * wc + (fq >> 1)) * 2 + (fq & 1)) * 32 + (row & 31)) * 8) = w;
                        if (wc == 2 && fq < 2) { float* wp = wix + (size_t)row * 16 + 8 * fq;
                            *(f32x4*)wp = (f32x4){v[0] * IDX_SCALE, v[1] * IDX_SCALE, v[2] * IDX_SCALE, v[3] * IDX_SCALE};
                            *(f32x4*)(wp + 4) = (f32x4){v[4] * IDX_SCALE, v[5] * IDX_SCALE, v[6] * IDX_SCALE, v[7] * IDX_SCALE}; }
                    }
                }
        }
    }
};
struct EpiResidF {
    static constexpr bool PERM = false, AFTER_DRAIN = false, MIDK = false; typedef f32x4 acc_t;
    const float* base; const float* gate; float* out;
    __device__ __forceinline__ void operator()(const f32x4 (&acc)[2][2][4][2], const Unit& u, int wr, int wc, int fr, int fq) const {
        const int row0 = u.pm * BM + wr * 64 + fr, col0 = u.pn * BM + wc * 32 + 4 * fq;
        const float* gp = gate + (size_t)(u.pm / (SEQ / BM)) * MODW + col0;
        f32x4 gv[2][2];
#pragma unroll
        for (int bj = 0; bj < 2; ++bj)
#pragma unroll
            for (int n = 0; n < 2; ++n) gv[bj][n] = *(const f32x4*)(gp + bj * HALF + n * 16);
#pragma unroll
        for (int ai = 0; ai < 2; ++ai)
#pragma unroll
            for (int m = 0; m < 4; ++m) { const size_t off = (size_t)(row0 + ai * HALF + m * 16) * DM + col0;
#pragma unroll
                for (int bj = 0; bj < 2; ++bj)
#pragma unroll
                    for (int n = 0; n < 2; ++n) { const f32x4 bs = *(const f32x4*)(base + off + bj * HALF + n * 16);
                        *(f32x4*)(out + off + bj * HALF + n * 16) = bs + gv[bj][n] * acc[ai][bj][m][n]; }
                asm volatile("" ::: "memory"); }
    }
};
__device__ __forceinline__ float silu_fast(float v) { return v * __builtin_amdgcn_rcpf(1.f + __expf(-v)); }
struct EpiUpConv {
    static constexpr bool PERM = true, AFTER_DRAIN = false, MIDK = false; typedef i32x4 acc_t;
    const float* cw; const float* cb; f16* act; float* uh; const float* sa; const float* sbw;
    __device__ __forceinline__ void operator()(i32x4 (&acc)[2][2][4][2], const Unit& u, int wr, int wc, int fr_in, int fq_in) const {
        int tix = threadIdx.x; asm volatile("" : "+v"(tix));
        const int fr = tix & 15, fq = (tix >> 4) & 3; (void)fr_in; (void)fq_in;
        const int lane = fr + 16 * fq;
        int ch0 = u.pn * HALF + wc * 32 + 8 * fq;
        {
            f32x4 sbv[2][2];
#pragma unroll
            for (int gv = 0; gv < 2; ++gv)
#pragma unroll
                for (int n = 0; n < 2; ++n) sbv[gv][n] = *(const f32x4*)(sbw + gv * DFF + ch0 + 4 * n) * (2.f / 127.f);
#pragma unroll
            for (int ai = 0; ai < 2; ++ai)
#pragma unroll
                for (int m = 0; m < 4; ++m) { const float rs = sa[u.pm * BM + ai * HALF + wr * 64 + m * 16 + fr];
#pragma unroll
                    for (int gv = 0; gv < 2; ++gv)
#pragma unroll
                        for (int n = 0; n < 2; ++n) { const i32x4 t = acc[ai][gv][m][n];
                            const f32x4 f = (f32x4){(float)t.x, (float)t.y, (float)t.z, (float)t.w} * rs * sbv[gv][n]; acc[ai][gv][m][n] = __builtin_bit_cast(i32x4, f); } }
        }
#define UF(ai, gv, m, n) __builtin_bit_cast(f32x4, acc[ai][gv][m][n])
        const int src1 = (lane & 48) | ((fr - 1) & 15), src2 = (lane & 48) | ((fr - 2) & 15);
#pragma unroll
        for (int n = 0; n < 2; ++n) {
            asm volatile("" : "+v"(ch0));
            f32x4 w0[2], w1[2], w2[2], bb[2];
#pragma unroll
            for (int gv = 0; gv < 2; ++gv) { const int c = gv * DFF + ch0 + 4 * n;
                w0[gv] = *(const f32x4*)(cw + c); w1[gv] = *(const f32x4*)(cw + NUP + c); w2[gv] = *(const f32x4*)(cw + 2 * NUP + c); bb[gv] = *(const f32x4*)(cb + c); }
#pragma unroll
            for (int ai = 0; ai < 2; ++ai) {
                const int chunk = u.pm * 4 + ai * 2 + wr;
#pragma unroll
                for (int m = 0; m < 4; ++m) {
                    const int row = u.pm * BM + ai * HALF + wr * 64 + m * 16 + fr;
                    f32x4 uc[2];
#pragma unroll
                    for (int gv = 0; gv < 2; ++gv) {
                        const f32x4 cur = UF(ai, gv, m, n); const f32x4 prv = UF(ai, gv, m > 0 ? m - 1 : 0, n);
                        f32x4 p1, p2;
#pragma unroll
                        for (int j = 0; j < 4; ++j) { const float t1 = fr == 15 ? prv[j] : cur[j], t2 = fr >= 14 ? prv[j] : cur[j]; p1[j] = __shfl(t1, src1); p2[j] = __shfl(t2, src2); }
                        uc[gv] = bb[gv] + w0[gv] * p2 + w1[gv] * p1 + w2[gv] * cur;
                    }
                    if (m > 0 || fr >= 2) { u32x2 w;
#define SGV(q) (uc[0].q * uc[1].q * __builtin_amdgcn_rcpf(1.f + __builtin_amdgcn_exp2f(uc[0].q)))
                        w.x = pk_h2(SGV(x), SGV(y)); w.y = pk_h2(SGV(z), SGV(w));
#undef SGV
                        *(u32x2*)(act + (size_t)row * DFF + ch0 + 4 * n) = w; }
                    if ((m == 0 && fr < 2) || (m == 3 && fr >= 14)) { const int slot = m == 0 ? fr : fr - 12; float* up = uh + (size_t)(chunk * 4 + slot) * NUP + ch0 + 4 * n;
#pragma unroll
                        for (int gv = 0; gv < 2; ++gv) *(f32x4*)(up + gv * DFF) = UF(ai, gv, m, n); }
                }
            }
        }
    }
#undef UF
};
template <int MODE> struct AccSel { typedef f32x4 type; };
template <> struct AccSel<0> { typedef i32x4 type; };
template <int MODE> struct EpiResidNorm {
    static constexpr bool PERM = true, AFTER_DRAIN = true, MIDK = (MODE == 1); typedef typename AccSel<MODE>::type acc_t;
    const float* base; const float* gate; const float* g; const float* shsc; float* xout; f16* h; float* xch; unsigned* cnt; const float* ssq; float* xch2; float* sa; const float* maxsh;
    __device__ __forceinline__ void midk(f32x4 (&acc)[2][2][4][2], const Unit& u, int wr, int fr) const {
#pragma unroll
        for (int ai = 0; ai < 2; ++ai)
#pragma unroll
            for (int m = 0; m < 4; ++m) { const float* sp = ssq + (size_t)(u.pm * BM + ai * HALF + wr * 64 + m * 16 + fr) * NH;
                const f32x4 s0 = *(const f32x4*)sp, s1 = *(const f32x4*)(sp + 4);
                const float rs = rsqrtf((((s0.x + s0.y) + (s0.z + s0.w)) + ((s1.x + s1.y) + (s1.z + s1.w))) * (1.f / 1024.f) + EPS);
#pragma unroll
                for (int bj = 0; bj < 2; ++bj)
#pragma unroll
                    for (int n = 0; n < 2; ++n) acc[ai][bj][m][n] *= rs; }
    }
    __device__ __forceinline__ void fused(acc_t (&acc)[2][2][4][2], const Unit& u, int wr, int wc, int fr_in, int fq_in, LAS unsigned char* lds) const {
        int tix = threadIdx.x; asm volatile("" : "+v"(tix));
        const int fr = tix & 15, fq = (tix >> 4) & 3; (void)fr_in; (void)fq_in;
        LAS float* PT = (LAS float*)(lds + XTRA_OFF);
        LAS float* ST = (LAS float*)(lds + XTRA_OFF + 4096);
        const int bt = u.pm / (SEQ / BM);
        const int row0 = u.pm * BM + wr * 64 + fr, col0 = u.pn * BM + wc * 32 + 8 * fq;
#define XF(ai, bj, m, n) __builtin_bit_cast(f32x4, acc[ai][bj][m][n])
#define XS(ai, bj, m, n, v) acc[ai][bj][m][n] = __builtin_bit_cast(acc_t, (f32x4)(v))
        if (MODE == 0) {
            f32x4 sdv[2][2];
#pragma unroll
            for (int bj = 0; bj < 2; ++bj)
#pragma unroll
                for (int n = 0; n < 2; ++n) sdv[bj][n] = *(const f32x4*)(maxsh + col0 + bj * HALF + 4 * n) * (2.f / 127.f);
#pragma unroll
            for (int ai = 0; ai < 2; ++ai)
#pragma unroll
                for (int m = 0; m < 4; ++m) { const float rsa = sa[row0 + ai * HALF + m * 16];
#pragma unroll
                    for (int bj = 0; bj < 2; ++bj)
#pragma unroll
                        for (int n = 0; n < 2; ++n) { const i32x4 t = __builtin_bit_cast(i32x4, acc[ai][bj][m][n]);
                            XS(ai, bj, m, n, ((f32x4){(float)t.x, (float)t.y, (float)t.z, (float)t.w} * rsa * sdv[bj][n])); } }
        }
        {   const float* gp = gate + (size_t)bt * MODW + col0;
            f32x4 gv[2][2];
#pragma unroll
            for (int bj = 0; bj < 2; ++bj)
#pragma unroll
                for (int n = 0; n < 2; ++n) gv[bj][n] = *(const f32x4*)(gp + bj * HALF + 4 * n);
            int tok = 0;
#pragma unroll
            for (int ai = 0; ai < 2; ++ai)
#pragma unroll
                for (int m = 0; m < 4; ++m) { const size_t off = (size_t)(row0 + ai * HALF + m * 16 + tok) * DM + col0;
#pragma unroll
                    for (int bj = 0; bj < 2; ++bj) {
                        if (MODE == 1) {
#pragma unroll
                            for (int n = 0; n < 2; ++n) XS(ai, bj, m, n, *(const f32x4*)(base + off + bj * HALF + 4 * n) + gv[bj][n] * XF(ai, bj, m, n));
                        } else {
                            const half8 b8 = *(const half8*)((const f16*)base + off + bj * HALF);
                            XS(ai, bj, m, 0, ((f32x4){(float)b8[0], (float)b8[1], (float)b8[2], (float)b8[3]} + gv[bj][0] * XF(ai, bj, m, 0)));
                            XS(ai, bj, m, 1, ((f32x4){(float)b8[4], (float)b8[5], (float)b8[6], (float)b8[7]} + gv[bj][1] * XF(ai, bj, m, 1)));
                        } }
                    asm volatile("" : "+v"(tok) : "v"(acc[ai][0][m][0].x), "v"(acc[ai][0][m][1].x), "v"(acc[ai][1][m][0].x), "v"(acc[ai][1][m][1].x) : "memory"); }
        }
#pragma unroll
        for (int ai = 0; ai < 2; ++ai)
#pragma unroll
            for (int m = 0; m < 4; ++m) { float q = 0.f;
#pragma unroll
                for (int bj = 0; bj < 2; ++bj)
#pragma unroll
                    for (int n = 0; n < 2; ++n) { const f32x4 x = XF(ai, bj, m, n); q += (x.x * x.x + x.y * x.y) + (x.z * x.z + x.w * x.w); }
                q += __shfl_xor(q, 16); q += __shfl_xor(q, 32);
                if (fq == 0) PT[(ai * HALF + wr * 64 + m * 16 + fr) * 4 + wc] = q; }
        if (MODE == 1) {
            LAS float* PT2 = (LAS float*)(lds + XTRA_OFF + 8192);
            float mxa[2][4];
#pragma unroll
            for (int ai = 0; ai < 2; ++ai)
#pragma unroll
                for (int m = 0; m < 4; ++m) mxa[ai][m] = 0.f;
#pragma unroll
            for (int bj = 0; bj < 2; ++bj) {
                f32x4 av[2];
#pragma unroll
                for (int n = 0; n < 2; ++n) { const int c = col0 + bj * HALF + 4 * n; av[n] = *(const f32x4*)(g + c) * (*(const f32x4*)(shsc + (size_t)bt * MODW + DM + c) + 1.f); }
#pragma unroll
                for (int ai = 0; ai < 2; ++ai)
#pragma unroll
                    for (int m = 0; m < 4; ++m)
#pragma unroll
                        for (int n = 0; n < 2; ++n) { const f32x4 t = __builtin_elementwise_abs(XF(ai, bj, m, n) * av[n]); mxa[ai][m] = fmaxf(mxa[ai][m], fmaxf(fmaxf(t.x, t.y), fmaxf(t.z, t.w))); }
            }
#pragma unroll
            for (int ai = 0; ai < 2; ++ai)
#pragma unroll
                for (int m = 0; m < 4; ++m) { float q = mxa[ai][m]; q = fmaxf(q, __shfl_xor(q, 16)); q = fmaxf(q, __shfl_xor(q, 32));
                    if (fq == 0) PT2[(ai * HALF + wr * 64 + m * 16 + fr) * 4 + wc] = q; }
        }
        __syncthreads();
        const int tid = threadIdx.x;
        float* slot = xch + ((size_t)u.pm * 8 + u.pn) * BM;
        if (tid < BM) { const f32x4 p4 = *(const LAS f32x4*)(PT + tid * 4); __hip_atomic_store(slot + tid, (p4.x + p4.y) + (p4.z + p4.w), __ATOMIC_RELAXED, __HIP_MEMORY_SCOPE_AGENT);
            if (MODE == 1) { const f32x4 m4 = *(const LAS f32x4*)((LAS float*)(lds + XTRA_OFF + 8192) + tid * 4);
                __hip_atomic_store(xch2 + ((size_t)u.pm * 8 + u.pn) * BM + tid, fmaxf(fmaxf(m4.x, m4.y), fmaxf(m4.z, m4.w)), __ATOMIC_RELAXED, __HIP_MEMORY_SCOPE_AGENT); } }
        asm volatile("s_waitcnt vmcnt(0)" ::: "memory");
        __syncthreads();
        if (tid == 0) {
            __hip_atomic_fetch_add(cnt + 64 * u.pm, 1u, __ATOMIC_RELAXED, __HIP_MEMORY_SCOPE_AGENT);
            unsigned sp = 0;
            while (__hip_atomic_load(cnt + 64 * u.pm, __ATOMIC_RELAXED, __HIP_MEMORY_SCOPE_AGENT) < 8u) { __builtin_amdgcn_s_sleep(1); if (++sp > (1u << 22)) break; }
        }
        __syncthreads();
        if (tid < BM) { const float* sp = xch + (size_t)u.pm * 8 * BM + tid; float tot = 0.f;
#pragma unroll
            for (int j = 0; j < 8; ++j) tot += __hip_atomic_load(sp + j * BM, __ATOMIC_RELAXED, __HIP_MEMORY_SCOPE_AGENT);
            const float rstd = rsqrtf(tot * (1.f / DM) + EPS); ST[tid] = rstd;
            if (MODE == 1) { const float* mp = xch2 + (size_t)u.pm * 8 * BM + tid; float mxr = 0.f;
#pragma unroll
                for (int j = 0; j < 8; ++j) mxr = fmaxf(mxr, __hip_atomic_load(mp + j * BM, __ATOMIC_RELAXED, __HIP_MEMORY_SCOPE_AGENT));
                const float bound = fmaxf(rstd * mxr + maxsh[bt], 1e-20f);
                ST[BM + tid] = 127.f / bound; if (u.pn == 0) sa[u.pm * BM + tid] = bound * (1.f / 127.f); } }
        __syncthreads();
#pragma unroll
        for (int bj = 0; bj < 2; ++bj) {
            f32x4 gg[2], sh[2], sc[2];
#pragma unroll
            for (int n = 0; n < 2; ++n) { const int c = col0 + bj * HALF + 4 * n; gg[n] = *(const f32x4*)(g + c);
                if (MODE == 1) { sh[n] = *(const f32x4*)(shsc + (size_t)bt * MODW + c); sc[n] = *(const f32x4*)(shsc + (size_t)bt * MODW + DM + c) + 1.f; } }
#pragma unroll
            for (int ai = 0; ai < 2; ++ai)
#pragma unroll
                for (int m = 0; m < 4; ++m) { const int rl = ai * HALF + wr * 64 + m * 16 + fr; const float rs = ST[rl]; const size_t off = (size_t)(u.pm * BM + rl) * DM + col0 + bj * HALF;
                    if (MODE == 0) {
#pragma unroll
                        for (int n = 0; n < 2; ++n) *(f32x4*)(xout + off + 4 * n) = (XF(ai, bj, m, n) * rs) * gg[n];
                    } else {
                        const f32x4 y0 = ((XF(ai, bj, m, 0) * rs) * gg[0]) * sc[0] + sh[0], y1 = ((XF(ai, bj, m, 1) * rs) * gg[1]) * sc[1] + sh[1];
                        { const f32x4 x0 = XF(ai, bj, m, 0), x1 = XF(ai, bj, m, 1); u32x4 xw; xw.x = pk_h2(x0.x, x0.y); xw.y = pk_h2(x0.z, x0.w); xw.z = pk_h2(x1.x, x1.y); xw.w = pk_h2(x1.z, x1.w);
                          *(u32x4*)((f16*)xout + off) = xw; }
                        {   const float qs = ST[BM + rl];
                            u32x2 w8; w8.x = q8x4(y0.x * qs, y0.y * qs, y0.z * qs, y0.w * qs); w8.y = q8x4(y1.x * qs, y1.y * qs, y1.z * qs, y1.w * qs);
                            *(u32x2*)((signed char*)h + off) = w8; }
                    }
                    asm volatile("" ::: "memory"); }
        }
    }
#undef XF
#undef XS
};
}


namespace att {
typedef float f32x2 __attribute__((ext_vector_type(2)));
typedef short v4i16_t __attribute__((ext_vector_type(4)));
__device__ __forceinline__ int sw16(int row) { return ((row & 3) << 2) | ((row >> 2) & 3); }
__device__ __forceinline__ int crow(int i, int h) { return (i & 3) + 8 * (i >> 2) + 4 * h; }
__device__ __forceinline__ half4 tr_read(LAS unsigned char* p) { return __builtin_bit_cast(half4, __builtin_amdgcn_ds_read_tr16_b64_v4i16((LAS v4i16_t*)p)); }
__device__ __forceinline__ half8 cat8(half4 a, half4 b) { return __builtin_shufflevector(a, b, 0, 1, 2, 3, 4, 5, 6, 7); }
__device__ __forceinline__ half8 cvt8(const f32x16& x, int s) {
    half8 r;
#pragma unroll
    for (int j = 0; j < 8; ++j) r[j] = (f16)x[8 * s + j];
    return r;
}
struct TileRegs { u32x4 v[8]; };
template <class RowOff> __device__ __forceinline__ void tile_fetch(TileRegs& t, const unsigned char* base, RowOff roff, int lane) {
#pragma unroll
    for (int i = 0; i < 8; ++i) { const int row = (lane >> 4) + 4 * i; const unsigned off = (unsigned)roff(row) + 16u * (unsigned)(lane & 15); t.v[i] = *(const u32x4*)(base + off); }
}
__device__ __forceinline__ void tile_put(const TileRegs& t, LAS unsigned char* tile, int lane) {
#pragma unroll
    for (int i = 0; i < 8; ++i) { const int row = (lane >> 4) + 4 * i; *(LAS u32x4*)(tile + 256 * row + 16 * ((lane & 15) ^ sw16(row))) = t.v[i]; }
}
__device__ __forceinline__ void fetch_rows8(TileRegs& t, const unsigned char* base, const unsigned (&offs)[8], int lane) {
#pragma unroll
    for (int i = 0; i < 8; ++i) t.v[i] = *(const u32x4*)(base + (offs[i] + 16u * (unsigned)(lane & 15)));
}
__device__ __forceinline__ void put_rows8(const TileRegs& t, LAS unsigned char* tile, int lane) {
#pragma unroll
    for (int i = 0; i < 8; ++i) { const int row = 8 * (lane >> 4) + i; *(LAS u32x4*)(tile + 256 * row + 16 * ((lane & 15) ^ sw16(row))) = t.v[i]; }
}
__device__ __forceinline__ void sel_offs8(unsigned (&offs)[8], const LAS unsigned short* sel, int j0, int cnt) {
    const u32x4 w = *(const LAS u32x4*)(sel + j0);
    const unsigned e[8] = {w.x & 0xffffu, w.x >> 16, w.y & 0xffffu, w.y >> 16, w.z & 0xffffu, w.z >> 16, w.w & 0xffffu, w.w >> 16};
#pragma unroll
    for (int i = 0; i < 8; ++i) offs[i] = e[i] << 8;
    (void)cnt;
}
__device__ __forceinline__ f32x16 qk_tile(LAS unsigned char* ktile, const half8 (&qf)[8], int lane) {
    const int r = lane & 31, h = lane >> 5, swr = sw16(r);
    f32x16 z;
#pragma unroll
    for (int i = 0; i < 16; ++i) z[i] = 0.f;
    half8 kf[8];
#pragma unroll
    for (int st = 0; st < 8; ++st) kf[st] = *(const LAS half8*)(ktile + 256 * r + 16 * ((2 * st + h) ^ swr));
#pragma unroll
    for (int st = 0; st < 8; ++st) z = __builtin_amdgcn_mfma_f32_32x32x16_f16(kf[st], qf[st], z, 0, 0, 0);
    __builtin_amdgcn_sched_group_barrier(0x100, 8, 0);
    __builtin_amdgcn_sched_group_barrier(0x008, 8, 0);
    return z;
}
__device__ __forceinline__ void tr_addrs(int (&va)[4][2], int lane) {
    const int q = (lane & 15) >> 2, p = lane & 3, g = lane >> 4, h = g >> 1, g1 = g & 1;
#pragma unroll
    for (int mt = 0; mt < 4; ++mt)
#pragma unroll
        for (int sec = 0; sec < 2; ++sec) { const int key = 8 * sec + 4 * h + q, sw = (q << 2) | (2 * sec + h), ch = 4 * mt + 2 * g1 + (p >> 1);
            va[mt][sec] = 256 * key + 16 * (ch ^ sw) + 8 * (p & 1); }
}
__device__ __forceinline__ void pv_tile(f32x16 (&o)[4], LAS unsigned char* vtile, const int (&va)[4][2], const half8 (&wf)[2]) {
#pragma unroll
    for (int ks = 0; ks < 2; ++ks) {
        half8 vf[4];
#pragma unroll
        for (int mt = 0; mt < 4; ++mt) vf[mt] = cat8(tr_read(vtile + va[mt][0] + 4096 * ks), tr_read(vtile + va[mt][1] + 4096 * ks));
#pragma unroll
        for (int mt = 0; mt < 4; ++mt) o[mt] = __builtin_amdgcn_mfma_f32_32x32x16_f16(vf[mt], wf[ks], o[mt], 0, 0, 0);
        __builtin_amdgcn_sched_group_barrier(0x100, 8, 0);
        __builtin_amdgcn_sched_group_barrier(0x008, 4, 0);
    }
}

__device__ __forceinline__ void sb_item(const f16* __restrict__ P, const f16* __restrict__ ksbc, const f16* __restrict__ vsbc, f16* __restrict__ merged, float* __restrict__ ssq, LAS unsigned char* reg, int b, int hd, int qb, int lane) {
    const int c = lane & 31, h = lane >> 5, t0 = 32 * qb;
    LAS unsigned char* ktile = reg; LAS unsigned char* vtile = reg + 8192;
    half8 qf[8];
    { const f16* qp = P + (size_t)(b * SEQ + t0 + c) * NINP + C_QSB + hd * HD + 8 * h;
#pragma unroll
      for (int st = 0; st < 8; ++st) qf[st] = *(const half8*)(qp + 16 * st); }
    half8 uf[2];
#pragma unroll
    for (int ks = 0; ks < 2; ++ks)
#pragma unroll
        for (int j = 0; j < 8; ++j) uf[ks][j] = (16 * ks + 8 * (j >> 2) + 4 * h + (j & 3)) > c ? (f16)1.f : (f16)0.f;
    int va[4][2]; tr_addrs(va, lane);
    f32x16 o[4];
#pragma unroll
    for (int mt = 0; mt < 4; ++mt)
#pragma unroll
        for (int i = 0; i < 16; ++i) o[mt][i] = 0.f;
    float R = 0.f;
    const unsigned char* kbase = (const unsigned char*)(ksbc + (size_t)(b * NH + hd) * SEQ * HD);
    const unsigned char* vbase = (const unsigned char*)(vsbc + (size_t)(b * NH + hd) * SEQ * HD);
    TileRegs tk, tv;
    tile_fetch(tk, kbase, [&](int row) { return (size_t)(32 * qb + row) * (HD * 2); }, lane);
    for (int kt = qb; kt >= 0; --kt) {
        const int s0 = 32 * kt;
        tile_put(tk, ktile, lane);
        tile_fetch(tv, vbase, [&](int row) { return (size_t)(s0 + row) * (HD * 2); }, lane);
        f32x16 z = qk_tile(ktile, qf, lane);
        f32x16 l, a;
        float lsum = 0.f;
        const bool diag = (kt == qb);
        if (diag) {
#pragma unroll
            for (int i = 0; i < 16; ++i) z[i] = crow(i, h) < c ? z[i] : -1.0e30f; }
#pragma unroll
        for (int i = 0; i < 16; ++i) { const float zi = z[i]; const float sp = fmaxf(zi, 0.f) + __builtin_amdgcn_logf(1.f + __builtin_amdgcn_exp2f(-fabsf(zi)));
            l[i] = -sp; a[i] = zi - sp; lsum -= sp; }
        half8 lf[2] = {cvt8(l, 0), cvt8(l, 1)};
        f32x16 cs;
#pragma unroll
        for (int i = 0; i < 16; ++i) cs[i] = 0.f;
        cs = __builtin_amdgcn_mfma_f32_32x32x16_f16(uf[0], lf[0], cs, 0, 0, 0);
        cs = __builtin_amdgcn_mfma_f32_32x32x16_f16(uf[1], lf[1], cs, 0, 0, 0);
        f32x16 w;
#pragma unroll
        for (int i = 0; i < 16; ++i) w[i] = __builtin_amdgcn_exp2f((a[i] + cs[i]) + R);
        half8 wf[2] = {cvt8(w, 0), cvt8(w, 1)};
        __builtin_amdgcn_sched_barrier(0);
        tile_put(tv, vtile, lane);
        { const int sn = 32 * (kt > 0 ? kt - 1 : 0); tile_fetch(tk, kbase, [&](int row) { return (size_t)(sn + row) * (HD * 2); }, lane); }
        pv_tile(o, vtile, va, wf);
        R += lsum + __shfl_xor(lsum, 32);
        if (__all(R < -150.1f)) {
        asm volatile("" :: "v"(tk.v[0]), "v"(tk.v[1]), "v"(tk.v[2]), "v"(tk.v[3]), "v"(tk.v[4]), "v"(tk.v[5]), "v"(tk.v[6]), "v"(tk.v[7])); break; }
    }
    float sq = 0.f;
#pragma unroll
    for (int mt = 0; mt < 4; ++mt)
#pragma unroll
        for (int gI = 0; gI < 4; ++gI) { const f32x16& x = o[mt]; const int i0 = 4 * gI;
            sq += (x[i0] * x[i0] + x[i0 + 1] * x[i0 + 1]) + (x[i0 + 2] * x[i0 + 2] + x[i0 + 3] * x[i0 + 3]);
            u32x2 w2; w2.x = pk_h2(x[i0], x[i0 + 1]); w2.y = pk_h2(x[i0 + 2], x[i0 + 3]);
            *(LAS u32x2*)(reg + 272 * c + 2 * (32 * mt + 8 * gI + 4 * h)) = w2; }
    sq += __shfl_xor(sq, 32);
    if (lane < 32) ssq[(size_t)(b * SEQ + t0 + c) * NH + hd] = sq;
#pragma unroll
    for (int it = 0; it < 8; ++it) { const int row = (lane >> 4) + 4 * it;
        const u32x4 v = *(const LAS u32x4*)(reg + 272 * row + 16 * (lane & 15));
        *(u32x4*)(merged + (size_t)(b * SEQ + t0 + row) * DM + hd * HD + 8 * (lane & 15)) = v; }
}

constexpr int X_HIST = 0, X_SEL = 16384, X_CVAL = 20480, X_CIDX = 22528, X_MM = 24576, X_WSM = 25600;
__device__ __forceinline__ int mbcnt64(unsigned long long m) { return __builtin_amdgcn_mbcnt_hi((unsigned)(m >> 32), __builtin_amdgcn_mbcnt_lo((unsigned)m, 0u)); }
__device__ __forceinline__ float wave_min(float v) {
#pragma unroll
    for (int o = 1; o < 64; o <<= 1) v = fminf(v, __shfl_xor(v, o));
    return v; }
__device__ __forceinline__ float wave_max(float v) {
#pragma unroll
    for (int o = 1; o < 64; o <<= 1) v = fmaxf(v, __shfl_xor(v, o));
    return v; }
__device__ __forceinline__ int binof(float v, float lo, float scale) { const int bq = (int)((v - lo) * scale); return bq > 1023 ? 1023 : bq; }
__device__ __forceinline__ bool topk_fast(const LAS float* sc, int n, float lo, float hi, LAS unsigned* hist, LAS unsigned short* sel, LAS float* cval, LAS unsigned short* cidx, LAS unsigned* ctr, int lane) {
    const float range = hi - lo;
    if (!(range > 1e-30f)) return false;
    const float scale = 512.f / range;
#pragma unroll
    for (int k = 0; k < 8; ++k) hist[lane * 8 + k] = 0u;
    if (lane < 2) ctr[lane] = 0u;
    const int nfull = n >> 8;
    for (int j = 0; j < nfull; ++j) { const f32x4 v4 = *(const LAS f32x4*)(sc + 256 * j + 4 * lane);
#pragma unroll
        for (int e = 0; e < 4; ++e) { int bq = (int)((v4[e] - lo) * scale); bq = bq > 511 ? 511 : bq; (void)__hip_atomic_fetch_add(hist + bq, 1u, __ATOMIC_RELAXED, __HIP_MEMORY_SCOPE_WORKGROUP); } }
    if ((nfull << 8) < n) { const int i0 = 256 * nfull + 4 * lane; const f32x4 v4 = *(const LAS f32x4*)(sc + i0);
#pragma unroll
        for (int e = 0; e < 4; ++e) if (i0 + e < n) { int bq = (int)((v4[e] - lo) * scale); bq = bq > 511 ? 511 : bq; (void)__hip_atomic_fetch_add(hist + bq, 1u, __ATOMIC_RELAXED, __HIP_MEMORY_SCOPE_WORKGROUP); } }
    unsigned wd[8]; int lsum = 0;
#pragma unroll
    for (int k = 0; k < 8; ++k) { wd[k] = hist[lane * 8 + k]; lsum += (int)wd[k]; }
    int incl = lsum;
#pragma unroll
    for (int d = 1; d < 64; d <<= 1) { const int t = __shfl_down(incl, d); if (lane + d < 64) incl += t; }
    const int excl = incl - lsum;
    const bool mine = (excl < TOPK) && (incl >= TOPK);
    int fb = 0, fabove = 0, fcnt = 0, run = excl; bool found = false;
#pragma unroll
    for (int k = 7; k >= 0; --k) { const int cb = (int)wd[k]; const bool hit = !found && (run + cb >= TOPK);
        if (hit) { fb = 8 * lane + k; fabove = run; fcnt = cb; found = true; } if (!found) run += cb; }
    const unsigned long long bm = __ballot(mine);
    const int src = bm ? __builtin_ctzll(bm) : 0;
    const int bstar = __shfl(fb, src), above = __shfl(fabove, src), cntb = __shfl(fcnt, src);
    const int need = TOPK - above;
    const bool all = (cntb == need);
    if (!all && cntb > 64) return false;
    const float T0 = (float)bstar, T1 = all ? T0 : (bstar == 511 ? 3.0e38f : (float)(bstar + 1));
    const unsigned selb = (unsigned)(size_t)sel, trash = (unsigned)(size_t)(cidx + 64 + lane);
    const int nblk = (n + 255) >> 8; int nsel = 0;
    for (int j = 0; j < nfull; ++j) { const int i0 = 256 * j + 4 * lane; const f32x4 v4 = *(const LAS f32x4*)(sc + i0);
        unsigned long long bt[4], bc[4]; bool tkb[4], c0b[4];
#pragma unroll
        for (int e = 0; e < 4; ++e) { const float xe = (v4[e] - lo) * scale; tkb[e] = xe >= T1; c0b[e] = xe >= T0; bt[e] = __ballot(tkb[e]); bc[e] = __ballot(c0b[e]) & ~bt[e]; }
#pragma unroll
        for (int e = 0; e < 4; ++e) {
            const unsigned addr = tkb[e] ? selb + 2u * (unsigned)(nsel + mbcnt64(bt[e])) : trash; *(LAS unsigned short*)(size_t)addr = (unsigned short)(i0 + e); nsel += __builtin_popcountll(bt[e]); }
        if ((bc[0] | bc[1]) | (bc[2] | bc[3])) {
#pragma unroll
            for (int e = 0; e < 4; ++e) if (c0b[e] && !tkb[e]) { const unsigned k = __hip_atomic_fetch_add(ctr + 1, 1u, __ATOMIC_RELAXED, __HIP_MEMORY_SCOPE_WORKGROUP); cval[k] = v4[e]; cidx[k] = (unsigned short)(i0 + e); } }
    }
    if (nfull < nblk) { const int j = nfull; const int i0 = 256 * j + 4 * lane; const f32x4 v4 = *(const LAS f32x4*)(sc + i0);
        float x[4]; unsigned tk[4]; bool cd[4]; bool anyc = false;
#pragma unroll
        for (int e = 0; e < 4; ++e) { x[e] = (v4[e] - lo) * scale; const bool in = i0 + e < n; tk[e] = (in && x[e] >= T1) ? 1u : 0u; cd[e] = in && !(x[e] >= T1) && x[e] >= T0; anyc = anyc || cd[e]; }
#pragma unroll
        for (int e = 0; e < 4; ++e) { const unsigned long long bt = __ballot(tk[e] != 0u);
            const unsigned addr = tk[e] ? selb + 2u * (unsigned)(nsel + mbcnt64(bt)) : trash; *(LAS unsigned short*)(size_t)addr = (unsigned short)(i0 + e); nsel += __builtin_popcountll(bt); }
        if (__any(anyc)) {
#pragma unroll
            for (int e = 0; e < 4; ++e) if (cd[e]) { const unsigned k = __hip_atomic_fetch_add(ctr + 1, 1u, __ATOMIC_RELAXED, __HIP_MEMORY_SCOPE_WORKGROUP); cval[k] = v4[e]; cidx[k] = (unsigned short)(i0 + e); } }
    }
    if (!all) {
        const float my = lane < cntb ? cval[lane] : 0.f; const int myi = lane < cntb ? (int)cidx[lane] : 0; int rank = 0;
        for (int k = 0; k < cntb; ++k) { const float o = __builtin_bit_cast(float, __builtin_amdgcn_readlane(__float_as_int(my), k)); const int oi = __builtin_amdgcn_readlane(myi, k); rank += (o > my || (o == my && oi < myi)) ? 1 : 0; }
        const bool take = lane < cntb && rank < need;
        const unsigned long long bt = __ballot(take);
        if (take) sel[above + mbcnt64(bt)] = (unsigned short)myi;
    }
    return true;
}
__device__ __forceinline__ void topk_select(const LAS float* sc, int n, float lo, float hi, LAS unsigned* hist, LAS unsigned short* sel, LAS float* cval, LAS unsigned short* cidx, int lane) {
    int need = TOPK, mode = 2, bstar = 0; float scale = 0.f;
    const int nit = (n + 255) >> 8;
    for (int level = 0; level < 8; ++level) {
        const float range = hi - lo;
        if (!(range > 1e-30f)) { mode = 2; bstar = 0; scale = 0.f; break; }
        scale = 1024.f / range;
#pragma unroll
        for (int k = 0; k < 8; ++k) hist[lane * 8 + k] = 0u;
        for (int j = 0; j < nit; ++j) { const int i0 = 256 * j + 4 * lane; const f32x4 v4 = *(const LAS f32x4*)(sc + i0);
#pragma unroll
            for (int e = 0; e < 4; ++e) { const float v = v4[e];
                if (i0 + e < n && v >= lo && v <= hi) { const int bq = binof(v, lo, scale); (void)__hip_atomic_fetch_add(hist + (bq >> 1), 1u << (16 * (bq & 1)), __ATOMIC_RELAXED, __HIP_MEMORY_SCOPE_WORKGROUP); } } }
        unsigned wd[8]; int lsum = 0;
#pragma unroll
        for (int k = 0; k < 8; ++k) { wd[k] = hist[lane * 8 + k]; lsum += (int)(wd[k] & 0xffffu) + (int)(wd[k] >> 16); }
        int incl = lsum;
#pragma unroll
        for (int d = 1; d < 64; d <<= 1) { const int t = __shfl_down(incl, d); if (lane + d < 64) incl += t; }
        const int excl = incl - lsum;
        const bool mine = (excl < need) && (incl >= need);
        int fb = 0, fabove = 0, fcnt = 0, run = excl; bool found = false;
#pragma unroll
        for (int k = 15; k >= 0; --k) { const int cb = (int)((wd[k >> 1] >> (16 * (k & 1))) & 0xffffu); const bool hit = !found && (run + cb >= need);
            if (hit) { fb = 16 * lane + k; fabove = run; fcnt = cb; found = true; } if (!found) run += cb; }
        const unsigned long long bm = __ballot(mine);
        const int src = bm ? __builtin_ctzll(bm) : 0;
        bstar = __shfl(fb, src); const int above = __shfl(fabove, src), cntb = __shfl(fcnt, src);
        need -= above;
        if (cntb == need) { mode = 1; break; }
        if (cntb <= 64) { mode = 0; break; }
        float cl = 3.0e38f, chh = -3.0e38f;
        for (int i = lane; i < n; i += 64) { const float v = sc[i]; if (v >= lo && v <= hi && binof(v, lo, scale) == bstar) { cl = fminf(cl, v); chh = fmaxf(chh, v); } }
        lo = wave_min(cl); hi = wave_max(chh); mode = 2; bstar = 0; scale = 0.f;
    }
    int nsel = 0, ncand = 0;
    if (mode == 2) {
        for (int i0 = 0; i0 < n; i0 += 64) {
            const int i = i0 + lane; const bool in = i < n; const float v = in ? sc[i] : 0.f;
            const bool inr = in && v >= lo && v <= hi; const int bq = binof(v, lo, scale);
            const bool cand = inr && bq == bstar;
            const unsigned long long bc = __ballot(cand);
            const bool take = (in && (v > hi || (inr && bq > bstar))) || (cand && (ncand + mbcnt64(bc)) < need);
            const unsigned long long bt = __ballot(take);
            if (take) sel[nsel + mbcnt64(bt)] = (unsigned short)i;
            nsel += __builtin_popcountll(bt); ncand += __builtin_popcountll(bc);
        }
        return;
    }
    for (int j = 0; j < nit; ++j) { const int i0 = 256 * j + 4 * lane; const f32x4 v4 = *(const LAS f32x4*)(sc + i0);
#pragma unroll
        for (int e = 0; e < 4; ++e) { const float v = v4[e]; const int i = i0 + e; const bool in = i < n;
            const bool inr = in && v >= lo && v <= hi; const int bq = binof(v, lo, scale);
            const bool cand = inr && bq == bstar;
            const bool take = (in && (v > hi || (inr && bq > bstar))) || (mode == 1 && cand);
            const unsigned long long bt = __ballot(take);
            if (take) sel[nsel + mbcnt64(bt)] = (unsigned short)i;
            nsel += __builtin_popcountll(bt);
            if (mode == 0) { const unsigned long long bc = __ballot(cand);
                if (cand) { const int k = ncand + mbcnt64(bc); cval[k] = v; cidx[k] = (unsigned short)i; }
                ncand += __builtin_popcountll(bc); } } }
    if (mode == 0) {
        const float my = lane < ncand ? cval[lane] : 0.f; const int myi = lane < ncand ? (int)cidx[lane] : 0; int rank = 0;
        for (int k = 0; k < ncand; ++k) { const float o = cval[k]; const int oi = (int)cidx[k]; rank += (o > my || (o == my && oi < myi)) ? 1 : 0; }
        const bool take = lane < ncand && rank < need;
        const unsigned long long bt = __ballot(take);
        if (take) sel[nsel + mbcnt64(bt)] = (unsigned short)myi;
    }
}
template <int VAR> __device__ __forceinline__ void dsa_round(const f16* __restrict__ P, const unsigned char* __restrict__ kds8, const float* __restrict__ ksc, const f16* __restrict__ vdsc, const f16* __restrict__ kix, const float* __restrict__ wix, const float* __restrict__ dsg, f16* __restrict__ merged,
                                          LAS unsigned char* lds, int b, int t0, int nb, int nt0, int wave, int lane_in, int flags) {
    int lane = lane_in; asm volatile("" : "+v"(lane));
    int c = lane & 31, h = lane >> 5;
    LAS float* MM = (LAS float*)(lds + XTRA_OFF + X_MM);
    LAS float* WSM = (LAS float*)(lds + XTRA_OFF + X_WSM);
    {
        LAS unsigned char* qfr = lds + XTRA_OFF + X_HIST;
#pragma unroll
        for (int e = 0; e < 2; ++e) { const int ps = 2 * wave + e, p = ps >> 2, st = ps & 3;
            const int query = t0 + 2 * p + ((c >> 2) & 1), head = (c & 3) + 4 * (c >> 3);
            *(LAS half8*)(qfr + (ps * 64 + lane) * 16) = *(const half8*)(P + (size_t)(b * SEQ + query) * NINP + C_QIX + head * IXD + 8 * h + 16 * st); }
        float wv[4][16];
#pragma unroll
        for (int p = 0; p < 4; ++p) { const float* wp = wix + (size_t)(b * SEQ + t0 + 2 * p + h) * 16;
#pragma unroll
            for (int i4 = 0; i4 < 4; ++i4) { const f32x4 w4 = *(const f32x4*)(wp + 4 * i4); wv[p][4 * i4] = 0.5f * w4.x; wv[p][4 * i4 + 1] = 0.5f * w4.y; wv[p][4 * i4 + 2] = 0.5f * w4.z; wv[p][4 * i4 + 3] = 0.5f * w4.w; } }
        float mn[4], mx[4];
#pragma unroll
        for (int p = 0; p < 4; ++p) { mn[p] = 3.0e38f; mx[p] = -3.0e38f; }
        const int ntile = (t0 + 8 + 31) >> 5, jlast = ntile - 1;
        const f16* kp0 = kix + (size_t)(b * (SEQ / 32)) * 2048 + (h * 32 + c) * 8;
        auto clampj = [&](int j) { return j < jlast ? j : jlast; };
        auto kload = [&](half8 (&dst)[4], int jt) {
#pragma unroll
            for (int st = 0; st < 4; ++st) dst[st] = *(const half8*)(kp0 + (unsigned)(jt * 2048 + st * 512)); };
        f32x16 acc[4];
        auto mseg = [&](const half8 (&kk)[4]) {
#pragma unroll
            for (int p = 0; p < 4; ++p)
#pragma unroll
                for (int i = 0; i < 16; ++i) acc[p][i] = 0.f;
            half8 af[2][4];
#pragma unroll
            for (int p = 0; p < 4; ++p) af[0][p] = *(const LAS half8*)(qfr + ((p * 4 + 0) * 64 + lane) * 16);
#pragma unroll
            for (int st = 0; st < 4; ++st) {
                if (st < 3) {
#pragma unroll
                    for (int p = 0; p < 4; ++p) af[(st + 1) & 1][p] = *(const LAS half8*)(qfr + ((p * 4 + st + 1) * 64 + lane) * 16); }
#pragma unroll
                for (int p = 0; p < 4; ++p) acc[p] = __builtin_amdgcn_mfma_f32_32x32x16_f16(af[st & 1][p], kk[st], acc[p], 0, 0, 0); }
            __builtin_amdgcn_sched_group_barrier(0x100, 8, 0);
            __builtin_amdgcn_sched_group_barrier(0x008, 4, 0);
            __builtin_amdgcn_sched_group_barrier(0x100, 4, 0);
            __builtin_amdgcn_sched_group_barrier(0x008, 4, 0);
            __builtin_amdgcn_sched_group_barrier(0x100, 4, 0);
            __builtin_amdgcn_sched_group_barrier(0x008, 8, 0); };
        auto vseg = [&](int jt) {
#pragma unroll
            for (int p = 0; p < 4; ++p) {
                float scv = 0.f;
#pragma unroll
                for (int i = 0; i < 16; ++i) scv = __builtin_fmaf(wv[p][i], acc[p][i] + __builtin_fabsf(acc[p][i]), scv);
                *(LAS float*)(lds + (2 * p + h) * 16384 + 4 * (32 * jt + c)) = scv;
                mn[p] = fminf(mn[p], scv); mx[p] = fmaxf(mx[p], scv);
            } };
        const int cntw = (ntile - wave + NWAVES - 1) / NWAVES;
        half8 kf[4], kn[4];
        __syncthreads();
        kload(kf, clampj(wave));
        if (!(flags & 16)) {
            for (int k = 0; k < cntw; k += 2) {
                const int jt = wave + NWAVES * k;
                kload(kn, clampj(jt + NWAVES));
                __builtin_amdgcn_sched_barrier(0);
                mseg(kf);
                __builtin_amdgcn_sched_barrier(0);
                vseg(jt);
                __builtin_amdgcn_sched_barrier(0);
                if (k + 1 < cntw) {
                    kload(kf, clampj(jt + 2 * NWAVES));
                    __builtin_amdgcn_sched_barrier(0);
                    mseg(kn);
                    __builtin_amdgcn_sched_barrier(0);
                    vseg(jt + NWAVES);
                    __builtin_amdgcn_sched_barrier(0);
                } else asm volatile("" :: "v"(kn[0]), "v"(kn[1]), "v"(kn[2]), "v"(kn[3]));
            }
        }
#pragma unroll
        for (int p = 0; p < 4; ++p) {
#pragma unroll
            for (int o = 1; o < 32; o <<= 1) { mn[p] = fminf(mn[p], __shfl_xor(mn[p], o)); mx[p] = fmaxf(mx[p], __shfl_xor(mx[p], o)); }
            if (c == 0) { MM[(wave * 8 + 2 * p + h) * 2] = mn[p]; MM[(wave * 8 + 2 * p + h) * 2 + 1] = mx[p]; }
        }
    }
    __syncthreads();
    if (flags & 8) { __syncthreads(); return; }
    const int t = t0 + wave, n = t + 1;
    half8 qf[4];
    { const int cc0 = lane & 15, g0 = lane >> 4; const f16* qp = P + (size_t)(b * SEQ + t) * NINP + C_QDS + (cc0 & 7) * HD + 16 * g0;
#pragma unroll
      for (int ks = 0; ks < 2; ++ks) { qf[2 * ks] = *(const half8*)(qp + 64 * ks); qf[2 * ks + 1] = *(const half8*)(qp + 64 * ks + 8); } }
    LAS unsigned char* reg = lds + wave * 16384;
    LAS unsigned short* sel = (LAS unsigned short*)(lds + XTRA_OFF + X_SEL + wave * 512);
    int cnt;
    if (n <= TOPK) { for (int i = lane; i < TOPK; i += 64) sel[i] = (unsigned short)(i < n ? i : 0); cnt = n; }
    else { cnt = TOPK;
        float lo = 3.0e38f, hi = -3.0e38f;
#pragma unroll
        for (int w = 0; w < NWAVES; ++w) { lo = fminf(lo, MM[(w * 8 + wave) * 2]); hi = fmaxf(hi, MM[(w * 8 + wave) * 2 + 1]); }
        LAS unsigned* hist = (LAS unsigned*)(lds + XTRA_OFF + X_HIST + wave * 2048); LAS float* cval = (LAS float*)(lds + XTRA_OFF + X_CVAL + wave * 256);
        LAS unsigned short* cidx = (LAS unsigned short*)(lds + XTRA_OFF + X_CIDX + wave * 256);
        if (!topk_fast((const LAS float*)reg, n, lo, hi, hist, sel, cval, cidx, (LAS unsigned*)(lds + XTRA_OFF + X_WSM + wave * 8), lane))
            topk_select((const LAS float*)reg, n, lo, hi, hist, sel, cval, cidx, lane); }
    if (flags & 4) { __syncthreads(); return; }
    LAS unsigned* soff = (LAS unsigned*)(lds + XTRA_OFF + X_HIST + wave * 2048);
    asm volatile("s_waitcnt lgkmcnt(0)" ::: "memory");
#pragma unroll
    for (int i = 0; i < TOPK / 64; ++i) soff[lane + 64 * i] = (unsigned)sel[lane + 64 * i] << 8;
    asm volatile("s_waitcnt lgkmcnt(0)" ::: "memory");
    asm volatile("" : "+v"(lane));
    const int cc = lane & 15, g = lane >> 4;
    LAS unsigned char* ktile = reg; LAS unsigned char* kstrip = reg + 4096; LAS unsigned char* vtile = reg + 8192;
    i32x4 qb[2]; float sqq;
    {   float qm = 0.f;
#pragma unroll
        for (int st = 0; st < 4; ++st)
#pragma unroll
            for (int j = 0; j < 8; ++j) qm = fmaxf(qm, fabsf((float)qf[st][j]));
        qm = fmaxf(qm, __shfl_xor(qm, 16)); qm = fmaxf(qm, __shfl_xor(qm, 32)); qm = fmaxf(qm, 1e-20f);
        const float qi = cc < 8 ? 127.f / qm : 0.f;
        sqq = qm * (1.f / 127.f);
#pragma unroll
        for (int ks = 0; ks < 2; ++ks) { const half8 a = qf[2 * ks], c2 = qf[2 * ks + 1];
            qb[ks].x = (int)q8x4((float)a[0] * qi, (float)a[1] * qi, (float)a[2] * qi, (float)a[3] * qi); qb[ks].y = (int)q8x4((float)a[4] * qi, (float)a[5] * qi, (float)a[6] * qi, (float)a[7] * qi);
            qb[ks].z = (int)q8x4((float)c2[0] * qi, (float)c2[1] * qi, (float)c2[2] * qi, (float)c2[3] * qi); qb[ks].w = (int)q8x4((float)c2[4] * qi, (float)c2[5] * qi, (float)c2[6] * qi, (float)c2[7] * qi); } }
    int ka[2], va[8];
    {
#pragma unroll
      for (int ks = 0; ks < 2; ++ks) ka[ks] = 128 * cc + 16 * ((4 * ks + g) ^ (cc & 7));
      const int q = cc >> 2, p = cc & 3, swk = (q << 2) | g;
#pragma unroll
      for (int mt = 0; mt < 8; ++mt) va[mt] = 256 * (4 * g + q) + 16 * ((2 * mt + (p >> 1)) ^ swk) + 8 * (p & 1); }
    f32x4 o[8];
#pragma unroll
    for (int mt = 0; mt < 8; ++mt) o[mt] = (f32x4){0.f, 0.f, 0.f, 0.f};
    float mrun = -1.0e30f, lrun = 0.f;
    const unsigned char* kbase = kds8 + (size_t)(b * SEQ) * HD;
    const unsigned char* ksbase = (const unsigned char*)(ksc + (size_t)(b * SEQ));
    const unsigned char* vbase = (const unsigned char*)(vdsc + (size_t)(b * SEQ) * HD);
    const int nch = (cnt + 31) >> 5;
    unsigned voff[8];
    unsigned lp[4];
    { const unsigned lp0 = 16u * (unsigned)((lane & 15) ^ (g << 2));
#pragma unroll
      for (int i = 0; i < 4; ++i) lp[i] = lp0 ^ (16u * (unsigned)i); }
    auto offs8 = [&](int j0) { const u32x4 a4 = *(const LAS u32x4*)(soff + j0), b4 = *(const LAS u32x4*)(soff + j0 + 4);
        voff[0] = a4.x | lp[0]; voff[1] = a4.y | lp[1]; voff[2] = a4.z | lp[2]; voff[3] = a4.w | lp[3]; voff[4] = b4.x | lp[0]; voff[5] = b4.y | lp[1]; voff[6] = b4.z | lp[2]; voff[7] = b4.w | lp[3]; };
    auto dma8 = [&](const unsigned char* base, LAS unsigned char* tile) {
#pragma unroll
        for (int i = 0; i < 8; ++i) __builtin_amdgcn_global_load_lds((const unsigned*)(base + voff[i]), (LAS unsigned*)(tile + 1024 * i), 16, 0, 0); };
    const int gl8 = lane >> 3, ksl0 = 8 * (gl8 & 3) + (gl8 >> 2), kcol = 16 * ((lane & 7) ^ gl8), ssl = 8 * (lane & 3) + ((lane & 31) >> 2);
    auto dmak = [&](int ch) {
#pragma unroll
        for (int i = 0; i < 4; ++i) { const unsigned off = (soff[32 * ch + ksl0 + 2 * i] >> 1) + (unsigned)kcol;
            __builtin_amdgcn_global_load_lds((const unsigned*)(kbase + off), (LAS unsigned*)(ktile + 1024 * i), 16, 0, 0); }
        __builtin_amdgcn_global_load_lds((const unsigned*)(ksbase + (soff[32 * ch + ssl] >> 6)), (LAS unsigned*)kstrip, 4, 0, 0); };
    dmak(0);
    for (int ch = 0; ch < nch; ++ch) {
        offs8(32 * ch + 8 * g);
        dma8(vbase, vtile);
        asm volatile("s_waitcnt vmcnt(8)" ::: "memory");
        f32x4 z0, z1;
        {   i32x4 kq[2][2]; i32x4 a0 = {0, 0, 0, 0}, a1 = a0;
#pragma unroll
            for (int ks = 0; ks < 2; ++ks) { kq[ks][0] = *(const LAS i32x4*)(ktile + ka[ks]); kq[ks][1] = *(const LAS i32x4*)(ktile + ka[ks] + 2048); }
            const f32x4 s0 = *(const LAS f32x4*)(kstrip + 16 * g), s1 = *(const LAS f32x4*)(kstrip + 64 + 16 * g);
#pragma unroll
            for (int ks = 0; ks < 2; ++ks) {
                a0 = __builtin_amdgcn_mfma_i32_16x16x64_i8(kq[ks][0], qb[ks], a0, 0, 0, 0);
                a1 = __builtin_amdgcn_mfma_i32_16x16x64_i8(kq[ks][1], qb[ks], a1, 0, 0, 0); }
#pragma unroll
            for (int r = 0; r < 4; ++r) { z0[r] = (float)a0[r] * (sqq * s0[r]); z1[r] = (float)a1[r] * (sqq * s1[r]); } }
        { const int chn = ch + 1 < nch ? ch + 1 : ch; dmak(chn); }
        if (32 * ch + 32 > cnt) {
#pragma unroll
            for (int r = 0; r < 4; ++r) { if (32 * ch + 8 * r + g >= cnt) z0[r] = -1.0e30f; if (32 * ch + 8 * r + 4 + g >= cnt) z1[r] = -1.0e30f; } }
        float mx;
        asm volatile("s_nop 15\n\tv_max3_f32 %0, %1, %2, %3" : "=v"(mx) : "v"(z0[0]), "v"(z0[1]), "v"(z0[2]));
        asm volatile("v_max3_f32 %0, %0, %1, %2" : "+v"(mx) : "v"(z0[3]), "v"(z1[0]));
        asm volatile("v_max3_f32 %0, %0, %1, %2" : "+v"(mx) : "v"(z1[1]), "v"(z1[2]));
        asm volatile("v_max_f32 %0, %0, %1" : "+v"(mx) : "v"(z1[3]));
        if (__any(mx > mrun + 11.5f)) {
            mx = fmaxf(mx, __shfl_xor(mx, 16)); mx = fmaxf(mx, __shfl_xor(mx, 32));
            const float mnew = fmaxf(mrun, mx), alpha = __builtin_amdgcn_exp2f(mrun - mnew);
            lrun *= alpha; mrun = mnew;
#pragma unroll
            for (int mt = 0; mt < 8; ++mt) o[mt] *= alpha;
        }
        half8 pf;
#pragma unroll
        for (int r = 0; r < 4; ++r) { const float p0 = __builtin_amdgcn_exp2f(z0[r] - mrun), p1 = __builtin_amdgcn_exp2f(z1[r] - mrun); lrun += p0 + p1; pf[r] = (f16)p0; pf[4 + r] = (f16)p1; }
        asm volatile("s_waitcnt vmcnt(5)" ::: "memory");
        {   half8 vq[8];
            __builtin_amdgcn_sched_barrier(0);
#pragma unroll
            for (int mt = 0; mt < 8; ++mt) vq[mt] = cat8(tr_read(vtile + va[mt]), tr_read(vtile + va[mt] + 4096));
#pragma unroll
            for (int mt = 0; mt < 8; ++mt) o[mt] = __builtin_amdgcn_mfma_f32_16x16x32_f16(vq[mt], pf, o[mt], 0, 0, 0);
            __builtin_amdgcn_sched_group_barrier(0x100, 16, 0);
            __builtin_amdgcn_sched_group_barrier(0x008, 8, 0);
            __builtin_amdgcn_sched_barrier(0); }
    }
    asm volatile("s_waitcnt vmcnt(0)" ::: "memory");
    lrun += __shfl_xor(lrun, 16); lrun += __shfl_xor(lrun, 32);
    const float inv = 1.f / lrun;
    float sq = 0.f;
#pragma unroll
    for (int mt = 0; mt < 8; ++mt) { o[mt] *= inv; sq += (o[mt].x * o[mt].x + o[mt].y * o[mt].y) + (o[mt].z * o[mt].z + o[mt].w * o[mt].w); }
    sq = cc < 8 ? sq : 0.f;
    const float rstd = rsqrtf(wave_sum(sq) * (1.f / 1024.f) + EPS);
    if (cc < 8) {
#pragma unroll
        for (int mt = 0; mt < 8; ++mt) { const int d = 16 * mt + 4 * g; const f32x4 gg = *(const f32x4*)(dsg + cc * HD + d);
            u32x2 w2; w2.x = pk_h2(o[mt].x * rstd * gg.x, o[mt].y * rstd * gg.y); w2.y = pk_h2(o[mt].z * rstd * gg.z, o[mt].w * rstd * gg.w);
            *(u32x2*)(merged + (size_t)(b * SEQ + t) * DM + 1024 + cc * HD + d) = w2; }
    }
    if (nt0 >= 0) {
        int nb2 = nb, nt2 = nt0; asm volatile("" : "+s"(nb2), "+s"(nt2));
        int tid2 = threadIdx.x; asm volatile("" : "+v"(tid2)); const f16* rowp = P + (size_t)(nb2 * SEQ + nt2 + (tid2 >> 5 & 7)) * NINP;
        const void* src = tid2 < 256 ? (const void*)(rowp + C_QIX + (tid2 & 31) * 32) : (const void*)(rowp + C_QDS + (tid2 & 31) * 32);
        __builtin_amdgcn_global_load_lds((const unsigned*)src, (LAS unsigned*)(lds + XTRA_OFF + 26624 + (tid2 >> 6) * 0), 4, 0, 0);
        if (tid2 < 32) __builtin_amdgcn_global_load_lds((const unsigned*)(wix + (size_t)(nb2 * SEQ + nt2) * 16 + tid2 * 4), (LAS unsigned*)(lds + XTRA_OFF + 26624 + 256), 4, 0, 0);
    }
    __syncthreads();
}
}

#define XB_TMO      128
#define XB_XCNT(j)  (256  + 64 * (j))
#define XB_XSUB(j)  (1280 + 64 * (j))
#define XB_XGEN(j)  (2304 + 64 * (j))
#define XB_TOP      3328
#define XB_TOPGEN   3392
#define XCD_BAR_WORDS 3456
#define XB_SPIN_CAP (1u << 18)
__device__ __forceinline__ unsigned xb_ld(unsigned* p)              { return __hip_atomic_load(p, __ATOMIC_RELAXED, __HIP_MEMORY_SCOPE_AGENT); }
__device__ __forceinline__ unsigned xb_add(unsigned* p, unsigned v) { return __hip_atomic_fetch_add(p, v, __ATOMIC_RELAXED, __HIP_MEMORY_SCOPE_AGENT); }
__device__ __forceinline__ unsigned xb_xcc_id() { return (unsigned)__builtin_amdgcn_s_getreg((3 << 11) | 20) & 0xFu; }
#define XB_SPIN(cond, bar) do { unsigned _sp = 0; while (cond) { __builtin_amdgcn_s_sleep(1); \
    if ((++_sp & 255u) == 0u) { if (xb_ld(&(bar)[XB_TMO])) break; if (_sp > XB_SPIN_CAP) { atomicAdd(&(bar)[XB_TMO], 1u); break; } } } } while (0)
struct XcdBarrier { unsigned* bar; unsigned x; volatile LAS unsigned* st; };
__device__ __forceinline__ XcdBarrier xcd_barrier_post(unsigned* bar, volatile LAS unsigned* st) {
    XcdBarrier b; b.bar = bar; b.x = xb_xcc_id(); b.st = st;
    if (threadIdx.x == 0) (void)xb_add(&bar[XB_XCNT(b.x)], 1u);
    return b;
}
__device__ __forceinline__ void xcd_barrier_complete(unsigned* bar, unsigned x, unsigned& nloc, unsigned& nx) {
    const unsigned G = gridDim.x * gridDim.y * gridDim.z;
    unsigned sum, cnt, mine, sp = 0u;
    for (;;) {
        sum = 0u; cnt = 0u; mine = 0u;
#pragma unroll
        for (unsigned j = 0; j < 16; ++j) { const unsigned c = xb_ld(&bar[XB_XCNT(j)]); sum += c; cnt += (c > 0u) ? 1u : 0u; mine = (j == x) ? c : mine; }
        if (sum == G) break;
        __builtin_amdgcn_s_sleep(1);
        if ((++sp & 255u) == 0u) { if (xb_ld(&bar[XB_TMO])) break; if (sp > XB_SPIN_CAP) { atomicAdd(&bar[XB_TMO], 1u); break; } }
    }
    nloc = mine > 0u ? mine : 1u; nx = cnt > 0u ? cnt : 1u;
}
__device__ __forceinline__ void xcd_barrier(const XcdBarrier& b) {
    asm volatile("s_waitcnt vmcnt(0)" ::: "memory");
    __syncthreads();
    if (threadIdx.x == 0) {
        unsigned* bar = b.bar;
        __builtin_amdgcn_s_waitcnt(0);
        unsigned nloc = b.st[0], nx = b.st[1];
        if (nloc == 0u) { xcd_barrier_complete(bar, b.x, nloc, nx); b.st[0] = nloc; b.st[1] = nx; }
        const unsigned old = xb_add(&bar[XB_XSUB(b.x)], 1u);
        const unsigned gen = old / nloc;
        if (old + 1u == (gen + 1u) * nloc) {
            __builtin_amdgcn_fence(__ATOMIC_RELEASE, "agent");
            asm volatile("s_waitcnt vmcnt(0)" ::: "memory");
            const unsigned og = xb_add(&bar[XB_TOP], 1u);
            const unsigned tg = og / nx;
            if (og + 1u == (tg + 1u) * nx) xb_add(&bar[XB_TOPGEN], 1u);
            else XB_SPIN(xb_ld(&bar[XB_TOPGEN]) == tg, bar);
            __builtin_amdgcn_fence(__ATOMIC_ACQUIRE, "agent");
            xb_add(&bar[XB_XGEN(b.x)], 1u);
            asm volatile("s_waitcnt vmcnt(0)" ::: "memory");
        } else {
            XB_SPIN(xb_ld(&bar[XB_XGEN(b.x)]) == gen, bar);
            asm volatile("buffer_inv sc0" ::: "memory");
            asm volatile("s_waitcnt vmcnt(0)" ::: "memory");
        }
    }
    __syncthreads();
}

struct Args {
    const float* x; const float* c; const int* pos; const float* w_ada; const float* b_ada; const float* n1g; const float* w_in; const float* sbg; const float* dsg;
    const float* w_out; const float* n2g; const float* w_up; const float* conv_w; const float* conv_b; const float* w_down; const float* fng;
    float* out; unsigned char* ws; int ph_lo, ph_hi, region, pad;
};

constexpr int TR_IN8_BASE = 1 << 20;
struct TrItem { const float* W; f16* WT; const float* gk; const float* q8; int K, N, k0, n0, up, pitch; };
__device__ __forceinline__ TrItem tr_decode(const Args& a, int r, bool fold) {
    constexpr int NB_IN = NINP / 32, I_IN = (DM / 64) * (NINP / 32 - IN8_NB), I_OUT = (DM / 64) * (DM / 32), I_UP = (DM / 64) * (NUP / 32);
    TrItem t; int nblk;
    t.gk = nullptr; t.q8 = nullptr; t.pitch = 0;
    if (r >= TR_IN8_BASE) {
        const int i = r - TR_IN8_BASE; t.W = a.w_in; t.WT = (f16*)(a.ws + WS_WTIN8); t.K = DM; t.N = NIN; t.up = 2; t.q8 = (const float*)((const unsigned*)(a.ws + WS_CTL) + CW_SIMAX) - IN8_LO;
        t.k0 = 64 * (i / IN8_NB); t.n0 = IN8_LO + 32 * (i % IN8_NB); return t; }
    if (r < I_IN) { t.W = a.w_in; t.WT = (f16*)(a.ws + WS_WTIN); t.K = DM; t.N = NIN; t.up = 0;
        constexpr int NBF = NB_IN - IN8_NB; const int nbi = r % NBF; t.k0 = 64 * (r / NBF); t.n0 = 32 * (nbi < IN8_LO / 32 ? nbi : nbi + IN8_NB); return t; }
    else if ((r -= I_IN) < I_OUT) { t.W = a.w_out; t.WT = (f16*)(a.ws + WS_WTOUT); t.K = DM; t.N = DM; nblk = DM / 32; t.up = 0; t.gk = fold ? a.sbg : nullptr; }
    else if ((r -= I_OUT) < I_UP) { t.W = a.w_up; t.WT = (f16*)(a.ws + WS_WTUP); t.K = DM; t.N = NUP; nblk = NUP / 32; t.up = 1; t.q8 = (const float*)((const unsigned*)(a.ws + WS_CTL) + CW_SBMAX); }
    else { r -= I_UP; t.W = a.w_down; t.WT = (f16*)(a.ws + WS_WTDN); t.K = DFF; t.N = DM; nblk = DM / 32; t.up = 0; t.q8 = (const float*)((const unsigned*)(a.ws + WS_CTL) + CW_SDMAX); t.pitch = DFFP; }
    t.k0 = 64 * (r / nblk); t.n0 = 32 * (r % nblk); return t;
}
__device__ __forceinline__ void tr_load(const TrItem& t, f32x4 (&v)[8], int lane) {
    const int n = t.n0 + 4 * (lane & 7); const bool ok = n < t.N;
    const float* p = t.W + (size_t)(t.k0 + (lane >> 3)) * t.N + (ok ? n : 0);
#pragma unroll
    for (int i = 0; i < 8; ++i) { const f32x4 x = __builtin_nontemporal_load((const f32x4*)(p + (size_t)(8 * i) * t.N)); v[i] = ok ? x : (f32x4){0.f, 0.f, 0.f, 0.f}; }
}
__device__ __forceinline__ void tr_store(const TrItem& t, const f32x4 (&v)[8], LAS float* scr, int lane) {
#pragma unroll
    for (int i = 0; i < 8; ++i) { LAS float* d = scr + ((lane >> 3) + 8 * i) * 33 + 4 * (lane & 7); d[0] = v[i].x; d[1] = v[i].y; d[2] = v[i].z; d[3] = v[i].w; }
    asm volatile("s_waitcnt lgkmcnt(0)" ::: "memory");
    const int c = lane & 7;
    f32x4 g0 = {1.f, 1.f, 1.f, 1.f}, g1 = g0;
    if (t.gk && t.k0 < 1024) { g0 = *(const f32x4*)(t.gk + t.k0 + 8 * c); g1 = *(const f32x4*)(t.gk + t.k0 + 8 * c + 4); }
#pragma unroll
    for (int j = 0; j < 4; ++j) { const int nn = (lane >> 3) + 8 * j; const LAS float* sp = scr + (8 * c) * 33 + nn;
        int n = t.n0 + nn;
        if (t.q8) {
            const float inv = 63.5f * __builtin_amdgcn_rcpf(fmaxf(__hip_atomic_load(t.q8 + n, __ATOMIC_RELAXED, __HIP_MEMORY_SCOPE_AGENT), 1e-20f));
            u32x2 o; o.x = q8x4(sp[0 * 33] * inv, sp[1 * 33] * inv, sp[2 * 33] * inv, sp[3 * 33] * inv); o.y = q8x4(sp[4 * 33] * inv, sp[5 * 33] * inv, sp[6 * 33] * inv, sp[7 * 33] * inv);
            if (t.up == 2) n -= IN8_LO; else if (t.up) n = n < DFF ? (n / 128) * 256 + (n % 128) : ((n - DFF) / 128) * 256 + 128 + ((n - DFF) % 128);
            *(u32x2*)((unsigned char*)t.WT + (size_t)n * (t.pitch ? t.pitch : t.K) + t.k0 + 8 * c) = o;
        } else {
        u32x4 o; o.x = pk_h2(sp[0 * 33] * g0.x, sp[1 * 33] * g0.y); o.y = pk_h2(sp[2 * 33] * g0.z, sp[3 * 33] * g0.w); o.z = pk_h2(sp[4 * 33] * g1.x, sp[5 * 33] * g1.y); o.w = pk_h2(sp[6 * 33] * g1.z, sp[7 * 33] * g1.w);
        if (t.up) n = n < DFF ? (n / 128) * 256 + (n % 128) : ((n - DFF) / 128) * 256 + 128 + ((n - DFF) % 128);
        *(u32x4*)(t.WT + (size_t)n * t.K + t.k0 + 8 * c) = o; } }
    asm volatile("s_waitcnt lgkmcnt(0)" ::: "memory");
}
constexpr int ADA_KC = 32, ADA_ROWS = DM / ADA_KC;
__device__ __forceinline__ void p0_ada_item(const float* __restrict__ w_ada, const float* __restrict__ b_ada, const LAS float* sil, float* __restrict__ modp, float* __restrict__ mod, unsigned* cnt, int item, int lane) {
    const int kc = item / 48, jc = item % 48, j0 = jc * 256 + lane * 4;
    f32x4 a0 = {0.f, 0.f, 0.f, 0.f}, a1 = {0.f, 0.f, 0.f, 0.f};
    const float* wp = w_ada + (size_t)(kc * ADA_ROWS) * MODW + j0;
#pragma unroll 32
    for (int k = 0; k < ADA_ROWS; ++k) { const f32x4 w = __builtin_nontemporal_load((const f32x4*)(wp + (size_t)k * MODW)); const float s0 = sil[kc * ADA_ROWS + k], s1 = sil[DM + kc * ADA_ROWS + k]; a0 += w * s0; a1 += w * s1; }
    { float* p0 = modp + (size_t)(kc * 2 + 0) * MODW + j0; float* p1 = modp + (size_t)(kc * 2 + 1) * MODW + j0;
#pragma unroll
      for (int e = 0; e < 4; ++e) { __hip_atomic_store(p0 + e, a0[e], __ATOMIC_RELAXED, __HIP_MEMORY_SCOPE_AGENT); __hip_atomic_store(p1 + e, a1[e], __ATOMIC_RELAXED, __HIP_MEMORY_SCOPE_AGENT); } }
    asm volatile("s_waitcnt vmcnt(0)" ::: "memory");
    unsigned old = 0u;
    if (lane == 0) old = __hip_atomic_fetch_add(cnt + 64 * jc, 1u, __ATOMIC_RELAXED, __HIP_MEMORY_SCOPE_AGENT);
    old = (unsigned)__builtin_amdgcn_readfirstlane((int)old);
    if (old == (unsigned)(ADA_KC - 1)) {
        const f32x4 bias = *(const f32x4*)(b_ada + j0);
        f32x4 s0 = bias, s1 = bias;
#pragma unroll 4
        for (int k2 = 0; k2 < ADA_KC; ++k2) { const float* p0 = modp + (size_t)(k2 * 2 + 0) * MODW + j0; const float* p1 = modp + (size_t)(k2 * 2 + 1) * MODW + j0;
#pragma unroll
            for (int e = 0; e < 4; ++e) { s0[e] += __hip_atomic_load(p0 + e, __ATOMIC_RELAXED, __HIP_MEMORY_SCOPE_AGENT); s1[e] += __hip_atomic_load(p1 + e, __ATOMIC_RELAXED, __HIP_MEMORY_SCOPE_AGENT); } }
        if (jc < 16) {
#pragma unroll
            for (int e = 0; e < 4; ++e) { __hip_atomic_store(mod + j0 + e, s0[e], __ATOMIC_RELAXED, __HIP_MEMORY_SCOPE_AGENT); __hip_atomic_store(mod + MODW + j0 + e, s1[e], __ATOMIC_RELAXED, __HIP_MEMORY_SCOPE_AGENT); }
            asm volatile("s_waitcnt vmcnt(0)" ::: "memory");
            if (lane == 0) (void)__hip_atomic_fetch_add(cnt + 64 * 48, 1u, __ATOMIC_RELAXED, __HIP_MEMORY_SCOPE_AGENT);
        } else { *(f32x4*)(mod + j0) = s0; *(f32x4*)(mod + MODW + j0) = s1; }
    }
}
__device__ __forceinline__ void tr_run(const Args& a, LAS float* scr, int base, int it0, int stride, int cnt, int lane, bool fold) {
    if (cnt <= 0) return;
    f32x4 v0[8], v1[8], v2[8];
    TrItem c0 = tr_decode(a, base + it0, fold), c1 = c0, c2 = c0;
    tr_load(c0, v0, lane);
    if (cnt > 1) { c1 = tr_decode(a, base + it0 + stride, fold); tr_load(c1, v1, lane); }
    for (int q = 0; q < cnt; ++q) {
        if (q + 2 < cnt) { c2 = tr_decode(a, base + it0 + (q + 2) * stride, fold); tr_load(c2, v2, lane); }
        tr_store(c0, v0, scr, lane);
        c0 = c1; c1 = c2;
#pragma unroll
        for (int i = 0; i < 8; ++i) { v0[i] = v1[i]; v1[i] = v2[i]; }
    }
}
constexpr int UP_DEFER = 4992;
constexpr int TR_I_IN8 = (DM / 64) * IN8_NB;
constexpr int TR_I_IN = (DM / 64) * (NINP / 32 - IN8_NB), TR_I_OUT = (DM / 64) * (DM / 32), TR_I_UP = (DM / 64) * (NUP / 32), TR_I_DN = (DFF / 64) * (DM / 32);
__device__ __forceinline__ void tr_deferred(const Args& a, LAS unsigned char* lds, int base, int nitems, int nwg, int G, int wave, int lane) {
    const int busy = nwg % G;
    const int nidle = busy ? G - busy : G, me = busy ? (int)blockIdx.x - busy : (int)blockIdx.x;
    if (me < 0) return;
    const int it0 = me * NWAVES + wave, stride = nidle * NWAVES;
    tr_run(a, (LAS float*)(lds + wave * 16384), base, it0, stride, (nitems - it0 + stride - 1) / stride, lane, false);
}
__device__ __forceinline__ void phase0(const Args& a, LAS unsigned char* lds, int vcu, int G, int wave, int lane, bool fold) {
    unsigned char* ws = a.ws;
    LAS float* sil = (LAS float*)(lds + XTRA_OFF);
    for (int e = threadIdx.x; e < BATCH * DM; e += NWAVES * 64) sil[e] = silu_f(a.c[e]);
    __syncthreads();
    LAS float* scr = (LAS float*)(lds + wave * 16384);
    const int gw = vcu * NWAVES + wave, NGW = G * NWAVES;
    float* modp = (float*)(ws + WS_MODP);
    constexpr int NADA = ADA_KC * 48, HW = 6, HS = 1, NITEMS = TR_I_IN;
    if (wave < HW) for (int it = vcu * HW + wave; it < NADA; it += G * HW) p0_ada_item(a.w_ada, a.b_ada, sil, modp, (float*)(ws + WS_MOD), (unsigned*)(ws + WS_CTL) + CW_ADA, it, lane);
    const int nheavy = G * HW, nlight = G * (NWAVES - HW);
    const int nh_items = nheavy * HS < NITEMS ? nheavy * HS : NITEMS;
    int it0, stride, cnt;
    if (wave < HW) { it0 = (NITEMS - nh_items) + (vcu * HW + wave) * HS; stride = 1; cnt = HS; if (it0 + cnt > NITEMS) cnt = NITEMS - it0 > 0 ? NITEMS - it0 : 0; }
    else { it0 = vcu * (NWAVES - HW) + (wave - HW); stride = nlight; cnt = (NITEMS - nh_items - it0 + stride - 1) / stride; if (cnt < 0) cnt = 0; }
    tr_run(a, scr, 0, it0, stride, cnt, lane, fold);
    { unsigned* sbmax = (unsigned*)(ws + WS_CTL) + CW_SBMAX;
      for (int e = (vcu * NWAVES + wave) * 64 + lane; e < NUP * 16; e += NGW * 64) { const int n = e % NUP, rg = e / NUP; float mx = 0.f;
#pragma unroll
          for (int k = 0; k < 8; ++k) mx = fmaxf(mx, fabsf(a.w_up[(size_t)(rg * 8 + k) * NUP + n]));
          (void)__hip_atomic_fetch_max(sbmax + n, __builtin_bit_cast(unsigned, mx), __ATOMIC_RELAXED, __HIP_MEMORY_SCOPE_AGENT); } }
    { unsigned* sdmax = (unsigned*)(ws + WS_CTL) + CW_SDMAX;
      for (int e = (vcu * NWAVES + wave) * 64 + lane; e < DM * 16; e += NGW * 64) { const int n = e % DM, rg = e / DM; float mx = 0.f;
#pragma unroll
          for (int k = 0; k < 8; ++k) mx = fmaxf(mx, fabsf(a.w_down[(size_t)(rg * 8 + k) * DM + n]));
          (void)__hip_atomic_fetch_max(sdmax + n, __builtin_bit_cast(unsigned, mx), __ATOMIC_RELAXED, __HIP_MEMORY_SCOPE_AGENT); } }
    { unsigned* simax = (unsigned*)(ws + WS_CTL) + CW_SIMAX;
      for (int e = (vcu * NWAVES + wave) * 64 + lane; e < (IN8_HI - IN8_LO) * 16; e += NGW * 64) { const int n = e % (IN8_HI - IN8_LO), rg = e / (IN8_HI - IN8_LO); float mx = 0.f;
#pragma unroll
          for (int k = 0; k < 8; ++k) mx = fmaxf(mx, fabsf(a.w_in[(size_t)(rg * 8 + k) * NIN + IN8_LO + n]));
          (void)__hip_atomic_fetch_max(simax + n, __builtin_bit_cast(unsigned, mx), __ATOMIC_RELAXED, __HIP_MEMORY_SCOPE_AGENT); } }
    { float* cws = (float*)(ws + WS_CWS);
      for (int e = (vcu * NWAVES + wave) * 64 + lane; e < 4 * NUP; e += NGW * 64) { const int rrow = e / NUP, ch = e % NUP; const float sc = ch < DFF ? -1.4426950408889634f : -0.6931471805599453f;
          cws[e] = (rrow < 3 ? a.conv_w[(size_t)rrow * NUP + ch] : a.conv_b[ch]) * sc; } }
    float* rope = (float*)(ws + WS_ROPE);
    for (int idx = (vcu * NWAVES + wave) * 64 + lane; idx < MTOK * 24; idx += NGW * 64) {
        const int m = idx / 24, i = idx % 24;
        const float inv = i < 16 ? INV128[i] : INV64[i - 16];
        const float ang = (float)a.pos[m] * inv;
        const double rev = (double)ang * 0.15915494309189535;
        const float r = (float)((rev - floor(rev)) * 6.283185307179586);
        *(float2*)(rope + (size_t)idx * 2) = make_float2(cosf(r), sinf(r));
    }
    asm volatile("s_waitcnt vmcnt(0)" ::: "memory");
    __syncthreads();
    if (threadIdx.x == 0) (void)__hip_atomic_fetch_add((unsigned*)(ws + WS_CTL) + CW_ADA + 64 * 49, 1u, __ATOMIC_RELAXED, __HIP_MEMORY_SCOPE_AGENT);
}
__device__ __forceinline__ void hrows(const float* __restrict__ x, const float* __restrict__ g, const LAS float* S1, f16* __restrict__ H, unsigned char* __restrict__ H8, float* __restrict__ sah, int gw, int NGW, int lane) {
    for (int m0 = gw; m0 < MTOK; m0 += 2 * NGW) {
        const int m1 = m0 + NGW < MTOK ? m0 + NGW : m0;
        f32x4 v[2][8];
#pragma unroll
        for (int r = 0; r < 2; ++r) { const f32x4* xr = (const f32x4*)(x + (size_t)(r ? m1 : m0) * DM) + lane;
#pragma unroll
            for (int j = 0; j < 8; ++j) v[r][j] = __builtin_nontemporal_load(xr + 64 * j); }
#pragma unroll
        for (int r = 0; r < 2; ++r) {
            const int m = r ? m1 : m0; const int b = m / SEQ;
            float ss = 0.f;
#pragma unroll
            for (int j = 0; j < 8; ++j) ss += (v[r][j].x * v[r][j].x + v[r][j].y * v[r][j].y) + (v[r][j].z * v[r][j].z + v[r][j].w * v[r][j].w);
            const float rstd = rsqrtf(wave_sum(ss) * (1.f / DM) + EPS);
            u32x2* o8 = (u32x2*)(H + (size_t)m * DM) + lane;
            float mx = 0.f;
#pragma unroll
            for (int j = 0; j < 8; ++j) { const int k = 4 * (lane + 64 * j);
                const f32x4 gg = *(const f32x4*)(g + k); const f32x4 sh = *(const LAS f32x4*)(S1 + b * 4096 + k), sc = *(const LAS f32x4*)(S1 + b * 4096 + 2048 + k);
                const f32x4 y = ((v[r][j] * rstd) * gg) * (sc + 1.f) + sh; v[r][j] = y;
                mx = fmaxf(fmaxf(mx, fmaxf(fabsf(y.x), fabsf(y.y))), fmaxf(fabsf(y.z), fabsf(y.w)));
                u32x2 w; w.x = pk_h2(y.x, y.y); w.y = pk_h2(y.z, y.w); o8[64 * j] = w; }
#pragma unroll
            for (int o = 1; o < 64; o <<= 1) mx = fmaxf(mx, __shfl_xor(mx, o));
            mx = fmaxf(mx, 1e-20f);
            const float inv = 127.f * __builtin_amdgcn_rcpf(mx);
            unsigned* q8p = (unsigned*)(H8 + (size_t)m * DM) + lane;
#pragma unroll
            for (int j = 0; j < 8; ++j) q8p[64 * j] = q8x4(v[r][j].x * inv, v[r][j].y * inv, v[r][j].z * inv, v[r][j].w * inv);
            if (lane == 0) sah[m] = mx * (1.f / 127.f);
        }
    }
}
__device__ __forceinline__ void hrows1(const float* __restrict__ x, const float* __restrict__ g, const LAS float* S1, f16* __restrict__ H, int gw, int NGW, int lane) {
    for (int m = gw; m < MTOK; m += NGW) {
        const int b = m / SEQ;
        const f32x4* xr = (const f32x4*)(x + (size_t)m * DM) + lane;
        f32x4 v[8]; float ss = 0.f;
#pragma unroll
        for (int j = 0; j < 8; ++j) { v[j] = xr[64 * j]; ss += (v[j].x * v[j].x + v[j].y * v[j].y) + (v[j].z * v[j].z + v[j].w * v[j].w); }
        const float rstd = rsqrtf(wave_sum(ss) * (1.f / DM) + EPS);
        u32x2* o8 = (u32x2*)(H + (size_t)m * DM) + lane;
#pragma unroll
        for (int j = 0; j < 8; ++j) { const int k = 4 * (lane + 64 * j);
            const f32x4 gg = *(const f32x4*)(g + k); const f32x4 sh = *(const LAS f32x4*)(S1 + b * 4096 + k), sc = *(const LAS f32x4*)(S1 + b * 4096 + 2048 + k);
            const f32x4 y = ((v[j] * rstd) * gg) * (sc + 1.f) + sh;
            u32x2 w; w.x = pk_h2(y.x, y.y); w.y = pk_h2(y.z, y.w); o8[64 * j] = w; }
    }
}
__device__ __forceinline__ void phase1(const Args& a, LAS unsigned char* lds, int vcu, int G, int wave, int lane) {
    unsigned char* ws = a.ws;
    const float* mod = (const float*)(ws + WS_MOD);
    LAS float* S1 = (LAS float*)lds;
    for (int e = threadIdx.x; e < 2 * 4096; e += NWAVES * 64) { const int b = e >> 12, j = e & 4095; S1[e] = __hip_atomic_load(mod + (size_t)b * MODW + j, __ATOMIC_RELAXED, __HIP_MEMORY_SCOPE_AGENT); }
    __syncthreads();
    hrows(a.x, a.n1g, S1, (f16*)(ws + WS_H), ws + WS_H8IN, (float*)(ws + WS_SAH), vcu * NWAVES + wave, G * NWAVES, lane);
    { int l2 = threadIdx.x; asm volatile("" : "+v"(l2)); l2 &= 63;
      const int it0 = vcu * NWAVES + wave, stride = G * NWAVES;
      tr_run(a, (LAS float*)(lds + 32768 + wave * 8448), TR_IN8_BASE, it0, stride, (TR_I_IN8 - it0 + stride - 1) / stride, l2, false); }
}

__global__ void __launch_bounds__(NWAVES * 64, 2) mega(Args a) {
    extern __shared__ __attribute__((aligned(16))) unsigned char lds_raw[];
    LAS unsigned char* lds = (LAS unsigned char*)lds_raw;
    volatile LAS unsigned* MISC = (volatile LAS unsigned*)(lds + MISC_OFF);
    int tid = threadIdx.x; const int wave = __builtin_amdgcn_readfirstlane(tid >> 6); int lane = tid & 63;
#define FRESH() do { tid = threadIdx.x; asm volatile("" : "+v"(tid)); lane = tid & 63; } while (0)
    const int G = gridDim.x; const bool fuse = true;
    const int vcu = (G % 8 == 0) ? (blockIdx.x % 8) * (G / 8) + blockIdx.x / 8 : blockIdx.x;
    if (tid < 64) MISC[tid] = 0u;
    __syncthreads();
    unsigned* ctl = (unsigned*)(a.ws + WS_CTL);
    XcdBarrier bar = xcd_barrier_post(ctl + CW_BAR + a.region * XCD_BAR_WORDS, MISC + 8);
    const int lo = a.ph_lo, hi = a.ph_hi;
#define IN(k) (lo <= (k) && (k) < hi)
#define SEAM(k) do { if (IN(k) && IN((k) + 1)) xcd_barrier(bar); } while (0)
    if (IN(0)) { FRESH(); phase0(a, lds, vcu, G, wave, lane, fuse); }
    if (IN(0) && IN(1)) {
        if (threadIdx.x == 0) { unsigned sp = 0;
            while (__hip_atomic_load(ctl + CW_ADA + 64 * 48, __ATOMIC_RELAXED, __HIP_MEMORY_SCOPE_AGENT) < 16u || __hip_atomic_load(ctl + CW_ADA + 64 * 49, __ATOMIC_RELAXED, __HIP_MEMORY_SCOPE_AGENT) < (unsigned)G) {
                __builtin_amdgcn_s_sleep(1); if (++sp > (1u << 22)) break; } }
        __syncthreads();
    }
    if (IN(1)) { FRESH(); phase1(a, lds, vcu, G, wave, lane); } SEAM(1);
    if (IN(2)) { FRESH();
        {   pg8::Gemm g{(const f16*)(a.ws + WS_H), (const f16*)(a.ws + WS_WTIN), MTOK, NINP, DM}; pg8::InOrder S; S.init(MTOK, 5, (int)blockIdx.x, 0);
            pg8::EpiProjT<false> E{(f16*)(a.ws + WS_PROJ), (f16*)(a.ws + WS_KIX), (float*)(a.ws + WS_WIX), (const float*)(a.ws + WS_ROPE), (f16*)(a.ws + WS_KSBC), (f16*)(a.ws + WS_VSBC), (f16*)(a.ws + WS_KDSC), (f16*)(a.ws + WS_VDSC), nullptr, nullptr, nullptr, nullptr, nullptr};
            pg8::gemm_phase<pg8::EpiProjT<false>, pg8::InOrder, true, true>(lds, g, S, E); }
        {   FRESH();
            pg8::Gemm g{(const f16*)(a.ws + WS_H8IN), (const f16*)(a.ws + WS_WTIN8 - (size_t)(IN8_LO / 256) * 256 * DM), MTOK, NINP, DM / 2}; pg8::InOrder S; S.init(MTOK, 17, (int)blockIdx.x, 1);
            pg8::EpiProjT<true> E{(f16*)(a.ws + WS_PROJ), (f16*)(a.ws + WS_KIX), (float*)(a.ws + WS_WIX), (const float*)(a.ws + WS_ROPE), (f16*)(a.ws + WS_KSBC), (f16*)(a.ws + WS_VSBC), (f16*)(a.ws + WS_KDSC), (f16*)(a.ws + WS_VDSC),
                                  (const float*)(a.ws + WS_SAH), (const float*)((const unsigned*)(a.ws + WS_CTL) + CW_SIMAX), a.ws + WS_KDS8, (float*)(a.ws + WS_KSC), (LAS float*)(lds + XTRA_OFF)};
            pg8::gemm_phase<pg8::EpiProjT<true>, pg8::InOrder, true, true>(lds, g, S, E); }
        FRESH(); if ((int)blockIdx.x >= 96) {
            constexpr int NA = UP_DEFER / 2;
            const bool l1 = (int)blockIdx.x < 160;
            const int base = l1 ? 0 : NA, n = l1 ? NA : UP_DEFER - NA, it0 = ((int)blockIdx.x - (l1 ? 96 : 160)) * NWAVES + wave, stride = (l1 ? 64 : 96) * NWAVES;
            tr_run(a, (LAS float*)(lds + wave * 16384), TR_I_IN + TR_I_OUT + base, it0, stride, (n - it0 + stride - 1) / stride, lane, false); }
        if (blockIdx.x == 255 && wave == 0) {
            const float* mod = (const float*)(a.ws + WS_MOD);
#pragma unroll
            for (int b = 0; b < BATCH; ++b) { float mx = 0.f;
                for (int j = lane; j < DM; j += 64) mx = fmaxf(mx, fabsf(mod[(size_t)b * MODW + 3 * DM + j]));
#pragma unroll
                for (int o = 1; o < 64; o <<= 1) mx = fmaxf(mx, __shfl_xor(mx, o));
                if (lane == 0) ((float*)(a.ws + WS_MAXSH))[b] = mx; } }
    } SEAM(2);
    if (IN(3)) { FRESH();
        const f16* P = (const f16*)(a.ws + WS_PROJ);
        auto up_share = [&]() {
            int l2 = threadIdx.x; asm volatile("" : "+v"(l2)); l2 &= 63;
            const int it0 = vcu * NWAVES + wave, stride = G * NWAVES, nit = TR_I_UP - UP_DEFER;
            tr_run(a, (LAS float*)(lds + wave * 16384), TR_I_IN + TR_I_OUT + UP_DEFER, it0, stride, (nit - it0 + stride - 1) / stride, l2, false);
            tr_run(a, (LAS float*)(lds + wave * 16384), TR_I_IN, it0, stride, (TR_I_OUT - it0 + stride - 1) / stride, l2, fuse); };
        if (wave < 4) up_share();
        if (!(a.pad & 1)) for (int it = vcu * NWAVES + wave; it < BATCH * NH * (SEQ / 32); it += G * NWAVES) {
            const int qb = it % (SEQ / 32), hd = (it / (SEQ / 32)) % NH, b = it / ((SEQ / 32) * NH);
            att::sb_item(P, (const f16*)(a.ws + WS_KSBC), (const f16*)(a.ws + WS_VSBC), (f16*)(a.ws + WS_MERGED), (float*)(a.ws + WS_SSQ), lds + wave * 16384, b, hd, qb, lane);
        }
        if (wave >= 4) up_share();
        __syncthreads();
        if (!(a.pad & 2)) for (int k = vcu; k < BATCH * (SEQ / 8); k += G) {
            auto decode = [&](int kk, int& bb, int& tt0) { bb = kk / (SEQ / 8); const int r = kk % (SEQ / 8); tt0 = 8 * (r < SEQ / 16 ? r : (SEQ / 8 - 1) - (r - SEQ / 16)); };
            int b, t0, nb = 0, nt0 = -1; decode(k, b, t0);
            if (k + G < BATCH * (SEQ / 8)) decode(k + G, nb, nt0);
            att::dsa_round<0>(P, (const unsigned char*)(a.ws + WS_KDS8), (const float*)(a.ws + WS_KSC), (const f16*)(a.ws + WS_VDSC), (const f16*)(a.ws + WS_KIX), (const float*)(a.ws + WS_WIX), a.dsg, (f16*)(a.ws + WS_MERGED), lds, b, t0, nb, nt0, wave, lane, a.pad);
        }
    } SEAM(3);
    if (IN(5)) { FRESH();
        pg8::Gemm g{(const f16*)(a.ws + WS_MERGED), (const f16*)(a.ws + WS_WTOUT), MTOK, DM, DM}; pg8::StaticOrder S; S.init(MTOK, DM, G, (int)blockIdx.x);
        const float* mod = (const float*)(a.ws + WS_MOD);
        pg8::EpiResidNorm<1> E{a.x, mod + 2 * DM, a.n2g, mod + 3 * DM, (float*)(a.ws + WS_X1), (f16*)(a.ws + WS_H), (float*)(a.ws + WS_XCH), ctl + CW_XCNT, (const float*)(a.ws + WS_SSQ), (float*)(a.ws + WS_XCH2), (float*)(a.ws + WS_SA), (const float*)(a.ws + WS_MAXSH)};
        pg8::gemm_phase<pg8::EpiResidNorm<1>, pg8::StaticOrder, false, true>(lds, g, S, E);
    } SEAM(6);
    if (IN(7)) { FRESH();
        pg8::Gemm g{(const f16*)(a.ws + WS_H), (const f16*)(a.ws + WS_WTUP), MTOK, NUP, DM / 2}; pg8::StaticOrder S; S.init(MTOK, NUP, G, (int)blockIdx.x);
        pg8::EpiUpConv E{(const float*)(a.ws + WS_CWS), (const float*)(a.ws + WS_CWS) + 3 * NUP, (f16*)(a.ws + WS_ACT), (float*)(a.ws + WS_UH), (const float*)(a.ws + WS_SA), (const float*)((const unsigned*)(a.ws + WS_CTL) + CW_SBMAX)};
        pg8::gemm_phase<pg8::EpiUpConv, pg8::StaticOrder, true, true>(lds, g, S, E);
        FRESH(); tr_deferred(a, lds, TR_I_IN + TR_I_OUT + TR_I_UP, TR_I_DN, (MTOK / 256) * (NUP / 256), G, wave, lane);
        for (int e = blockIdx.x * (NWAVES * 64) + tid; e < DM * 8; e += G * NWAVES * 64) *(u32x4*)(a.ws + WS_WTDN + (size_t)(e >> 3) * DFFP + DFF + 16 * (e & 7)) = (u32x4){0u, 0u, 0u, 0u};
    } SEAM(7);
    if (IN(8)) { FRESH();
        const float* uh = (const float*)(a.ws + WS_UH); f16* act = (f16*)(a.ws + WS_ACT); unsigned char* act8 = (unsigned char*)(a.ws + WS_ACT8); float* sact = (float*)(a.ws + WS_SACT);
        for (int blk = vcu; blk < MTOK / 32; blk += G) {
            const int mb = blk * 32;
            if ((mb & 63) == 0) {
                const int chunk = mb >> 6; const bool first = (chunk % (SEQ / 64)) == 0;
                for (int e = tid; e < DFF / 4; e += NWAVES * 64) { const int ch = 4 * e;
                    f32x4 r0, r1;
#pragma unroll
                    for (int gv = 0; gv < 2; ++gv) { const int c = gv * DFF + ch; const f32x4 z4 = {0.f, 0.f, 0.f, 0.f};
                        const f32x4 um2 = first ? z4 : *(const f32x4*)(uh + (size_t)((chunk - 1) * 4 + 2) * NUP + c), um1 = first ? z4 : *(const f32x4*)(uh + (size_t)((chunk - 1) * 4 + 3) * NUP + c);
                        const f32x4 u0 = *(const f32x4*)(uh + (size_t)(chunk * 4 + 0) * NUP + c), u1 = *(const f32x4*)(uh + (size_t)(chunk * 4 + 1) * NUP + c);
                        const f32x4 k0 = *(const f32x4*)(a.conv_w + c), k1 = *(const f32x4*)(a.conv_w + NUP + c), k2 = *(const f32x4*)(a.conv_w + 2 * NUP + c), bz = *(const f32x4*)(a.conv_b + c);
                        const f32x4 y0 = bz + k0 * um2 + k1 * um1 + k2 * u0, y1 = bz + k0 * um1 + k1 * u0 + k2 * u1;
                        if (gv == 0) {
#pragma unroll
                            for (int j = 0; j < 4; ++j) { r0[j] = pg8::silu_fast(y0[j]); r1[j] = pg8::silu_fast(y1[j]); }
                        } else { r0 *= y0; r1 *= y1; } }
                    u32x2 w0, w1; w0.x = pk_h2(r0.x, r0.y); w0.y = pk_h2(r0.z, r0.w); w1.x = pk_h2(r1.x, r1.y); w1.y = pk_h2(r1.z, r1.w);
                    *(u32x2*)(act + (size_t)mb * DFF + ch) = w0; *(u32x2*)(act + (size_t)(mb + 1) * DFF + ch) = w1; }
                asm volatile("s_waitcnt vmcnt(0)" ::: "memory");
            }
            __syncthreads();
#pragma unroll 1
            for (int pr = 0; pr < 2; ++pr) {
                const int m0 = mb + wave * 4 + 2 * pr;
                half8 v[2][11]; float mx[2] = {0.f, 0.f};
#pragma unroll
                for (int r = 0; r < 2; ++r)
#pragma unroll
                    for (int j = 0; j < 11; ++j) { const int cidx = lane + 64 * j;
                        v[r][j] = cidx < DFF / 8 ? *(const half8*)(act + (size_t)(m0 + r) * DFF + 8 * cidx) : (half8){0, 0, 0, 0, 0, 0, 0, 0}; }
#pragma unroll
                for (int r = 0; r < 2; ++r) {
#pragma unroll
                    for (int j = 0; j < 11; ++j)
#pragma unroll
                        for (int e = 0; e < 8; ++e) mx[r] = fmaxf(mx[r], fabsf((float)v[r][j][e]));
#pragma unroll
                    for (int o = 1; o < 64; o <<= 1) mx[r] = fmaxf(mx[r], __shfl_xor(mx[r], o));
                    mx[r] = fmaxf(mx[r], 1e-20f); const float qs = 127.f / mx[r];
                    unsigned char* orow = act8 + (size_t)(m0 + r) * DFFP;
#pragma unroll
                    for (int j = 0; j < 11; ++j) { const int cidx = lane + 64 * j;
                        if (cidx < DFF / 8) { u32x2 w; w.x = q8x4((float)v[r][j][0] * qs, (float)v[r][j][1] * qs, (float)v[r][j][2] * qs, (float)v[r][j][3] * qs);
                            w.y = q8x4((float)v[r][j][4] * qs, (float)v[r][j][5] * qs, (float)v[r][j][6] * qs, (float)v[r][j][7] * qs); *(u32x2*)(orow + 8 * cidx) = w; } }
                    if (lane < 8) *(u32x4*)(orow + DFF + 16 * lane) = (u32x4){0u, 0u, 0u, 0u};
                    if (lane == 0) sact[m0 + r] = mx[r] * (1.f / 127.f);
                }
            }
            __syncthreads();
        }
    } SEAM(8);
    if (IN(9)) { FRESH();
        pg8::Gemm g{(const f16*)(a.ws + WS_ACT8), (const f16*)(a.ws + WS_WTDN), MTOK, DM, DFFP / 2}; pg8::StaticOrder S; S.init(MTOK, DM, G, (int)blockIdx.x);
        const float* mod = (const float*)(a.ws + WS_MOD);
        pg8::EpiResidNorm<0> E{(const float*)(a.ws + WS_X1), mod + 5 * DM, a.fng, nullptr, a.out, nullptr, (float*)(a.ws + WS_XCH) + 32 * 8 * 256, ctl + CW_XCNT + 32 * 64, nullptr, nullptr, (float*)(a.ws + WS_SACT), (const float*)((const unsigned*)(a.ws + WS_CTL) + CW_SDMAX)};
        pg8::gemm_phase<pg8::EpiResidNorm<0>, pg8::StaticOrder, false, true>(lds, g, S, E);
    }
#undef IN
#undef SEAM
}

extern "C" void kernel_launch(void* const* d_in, const int* in_sizes, int n_in, void* d_out, int out_size, void* d_ws, size_t ws_size, hipStream_t stream) {
    if (n_in != 16 || ws_size < WS_END) { fprintf(stderr, "kernel_launch: unexpected n_in %d / ws %zu\n", n_in, ws_size); return; }
    const float* x = (const float*)d_in[0]; const float* c = (const float*)d_in[1]; const int* pos = (const int*)d_in[2];
    const float* w_ada = (const float*)d_in[3]; const float* b_ada = (const float*)d_in[4]; const float* n1g = (const float*)d_in[5];
    const float* w_in = (const float*)d_in[6]; const float* sbg = (const float*)d_in[7]; const float* dsg = (const float*)d_in[8];
    const float* w_out = (const float*)d_in[9]; const float* n2g = (const float*)d_in[10]; const float* w_up = (const float*)d_in[11];
    const float* conv_w = (const float*)d_in[12]; const float* conv_b = (const float*)d_in[13]; const float* w_down = (const float*)d_in[14];
    const float* fng = (const float*)d_in[15];
    unsigned char* ws = (unsigned char*)d_ws; float* out = (float*)d_out;
    static int grid = 0;
    if (grid == 0) {
        int dev = 0, cus = 0;
        if (hipGetDevice(&dev) != hipSuccess || hipDeviceGetAttribute(&cus, hipDeviceAttributeMultiprocessorCount, dev) != hipSuccess) { fprintf(stderr, "kernel_launch: device query failed\n"); grid = -1; return; }
        if (hipFuncSetAttribute((const void*)mega, hipFuncAttributeMaxDynamicSharedMemorySize, LDS_BYTES) != hipSuccess) { fprintf(stderr, "kernel_launch: hipFuncSetAttribute failed\n"); grid = -1; return; }
        int per_cu = 0; (void)hipOccupancyMaxActiveBlocksPerMultiprocessor(&per_cu, (const void*)mega, NWAVES * 64, LDS_BYTES); (void)hipGetLastError();
        if (per_cu < 1) fprintf(stderr, "kernel_launch: occupancy query reports %d blocks/CU\n", per_cu);
        grid = cus;
        if (cus != (MTOK / 256) * (DM / 256)) { fprintf(stderr, "kernel_launch: built for a %d-CU device (one out-projection / down-projection unit per workgroup); found %d CUs; nothing launched\n", (MTOK / 256) * (DM / 256), cus); grid = -1; }
    }
    if (grid < 0) return;
    (void)hipMemsetAsync(ws + WS_CTL, 0, 1 * MiB, stream);
    Args a{};
    a.x = x; a.c = c; a.pos = pos; a.w_ada = w_ada; a.b_ada = b_ada; a.n1g = n1g; a.w_in = w_in; a.sbg = sbg; a.dsg = dsg; a.w_out = w_out; a.n2g = n2g; a.w_up = w_up;
    a.conv_w = conv_w; a.conv_b = conv_b; a.w_down = w_down; a.fng = fng; a.out = out; a.ws = ws;
    auto run = [&](int lo, int hi, int region) { a.ph_lo = lo; a.ph_hi = hi; a.region = region; hipLaunchKernelGGL(mega, dim3(grid), dim3(NWAVES * 64), LDS_BYTES, stream, a); };
    run(0, 11, 0);
#ifdef PROBE_LO
    a.pad = PROBE_FLAGS; run(PROBE_LO, PROBE_HI, 1);
#endif
}
```
